# Optimizing an MI355X kernel written in HIP

```python
import math
import jax, jax.numpy as jnp
from jax import lax
import numpy as np

D_MODEL = 4096
BATCH = 2
SEQ = 4096
DEPTH = 1
DEC_BATCH = 1
DEC_SEQ = 16384
PAST_LEN = 128

HEAD_DIM = 128
ROT_DIM = HEAD_DIM // 4
ROPE_THETA = 500000.0
DIL_GROUPS = ((128, 1), (512, 4), (2048, 16))
N_DIL = len(DIL_GROUPS)
A_HEADS = 8
A_BLOCK = 64
A_WIDTH = A_HEADS * HEAD_DIM
B_Q_HEADS = 16
B_KV_HEADS = 4
B_WINDOW = 128
B_Q_WIDTH = B_Q_HEADS * HEAD_DIM
B_KV_WIDTH = B_KV_HEADS * HEAD_DIM
D_FF = 11008
EPS = 1e-6
NEG_INF = -1e30
IN_SPLITS = (N_DIL * A_WIDTH, N_DIL * A_WIDTH, N_DIL * A_WIDTH,
             B_Q_WIDTH, B_KV_WIDTH, B_KV_WIDTH, D_MODEL, D_MODEL)
IN_WIDTH = sum(IN_SPLITS)

kernel_name = "hybrid_dilated_swa_gqa_sink_encoder"


def rmsnorm(x, g):
    xf = x.astype(jnp.float32)
    var = jnp.mean(xf * xf, axis=-1, keepdims=True)
    return (xf * lax.rsqrt(var + EPS)).astype(x.dtype) * g


def swiglu(x, w_gate, w_up, w_down):
    return (jax.nn.silu(x @ w_gate) * (x @ w_up)) @ w_down


def partial_rope(x, pos):
    half = ROT_DIM // 2
    inv = ROPE_THETA ** (-jnp.arange(half, dtype=jnp.float32) / half)
    ang = pos.astype(jnp.float32)[:, None] * inv[None, :]
    cos = jnp.cos(ang)[None, :, None, :]
    sin = jnp.sin(ang)[None, :, None, :]
    xr = x[..., :ROT_DIM].astype(jnp.float32)
    x1, x2 = xr[..., :half], xr[..., half:]
    rot = jnp.concatenate([x1 * cos - x2 * sin, x2 * cos + x1 * sin], axis=-1)
    return jnp.concatenate([rot.astype(x.dtype), x[..., ROT_DIM:]], axis=-1)


def banded_attention(q, k, v, half_window, blk, sink_logit=None):
    b, L, hq, dh = q.shape
    hk = k.shape[2]
    grp = hq // hk
    nb = -(-L // blk)
    pad = nb * blk - L
    qp = jnp.pad(q, ((0, 0), (0, pad), (0, 0), (0, 0)))
    kp = jnp.pad(k, ((0, 0), (blk, pad + blk), (0, 0), (0, 0)))
    vp = jnp.pad(v, ((0, 0), (blk, pad + blk), (0, 0), (0, 0)))
    qb = qp.reshape(b, nb, blk, hk, grp, dh)
    kb = kp.reshape(b, nb + 2, blk, hk, dh)
    vb = vp.reshape(b, nb + 2, blk, hk, dh)
    kn = jnp.concatenate([kb[:, :-2], kb[:, 1:-1], kb[:, 2:]], axis=2)
    vn = jnp.concatenate([vb[:, :-2], vb[:, 1:-1], vb[:, 2:]], axis=2)
    scale = 1.0 / math.sqrt(dh)
    s = jnp.einsum('bnqhgd,bnkhd->bnhgqk', qb, kn,
                   preferred_element_type=jnp.float32) * scale
    qpos = jnp.arange(nb)[:, None] * blk + jnp.arange(blk)[None, :]
    kpos = (jnp.arange(nb) * blk - blk)[:, None] + jnp.arange(3 * blk)[None, :]
    rel = kpos[:, None, :] - qpos[:, :, None]
    valid = (jnp.abs(rel) <= half_window) & (kpos[:, None, :] >= 0) & (kpos[:, None, :] < L)
    s = jnp.where(valid[None, :, None, None], s, NEG_INF)
    m = jnp.max(s, axis=-1, keepdims=True)
    if sink_logit is not None:
        sk = sink_logit.astype(jnp.float32).reshape(hk, grp)[None, None, :, :, None, None]
        m = jnp.maximum(m, sk)
    p = jnp.exp(s - m)
    den = jnp.sum(p, axis=-1, keepdims=True)
    if sink_logit is not None:
        den = den + jnp.exp(sk - m)
    o = jnp.einsum('bnhgqk,bnkhd->bnqhgd', p.astype(v.dtype), vn,
                   preferred_element_type=jnp.float32)
    den_t = jnp.transpose(den[..., 0], (0, 1, 4, 2, 3))[..., None]
    o = (o / den_t).astype(q.dtype).reshape(b, nb * blk, hq, dh)[:, :L]
    lse = jnp.transpose((m + jnp.log(den))[..., 0], (0, 1, 4, 2, 3)).reshape(b, nb * blk, hq)[:, :L]
    return o, lse


def dilated_attention(q, k, v, window, dilation):
    b, S, h, dh = q.shape
    L = S // dilation

    def to_sub(t):
        return t.reshape(b, L, dilation, h, dh).transpose(0, 2, 1, 3, 4).reshape(b * dilation, L, h, dh)

    o, lse = banded_attention(to_sub(q), to_sub(k), to_sub(v), (window // 2) // dilation, A_BLOCK)
    o = o.reshape(b, dilation, L, h, dh).transpose(0, 2, 1, 3, 4).reshape(b, S, h, dh)
    lse = lse.reshape(b, dilation, L, h).transpose(0, 2, 1, 3).reshape(b, S, h)
    return o, lse


def encoder_layer(x, g_ffn1, w1_gate, w1_up, w1_down, g_mix, w_in, sink_b,
                  w_branch_a, w_branch_b, w_out, g_ffn2, w2_gate, w2_up, w2_down):
    b, S, _ = x.shape
    pos = jnp.arange(S)
    h = x + 0.5 * swiglu(rmsnorm(x, g_ffn1), w1_gate, w1_up, w1_down)
    n = rmsnorm(h, g_mix)
    proj = n @ w_in
    qa, ka, va, qb, kb, vb, ga, gb = jnp.split(proj, np.cumsum(IN_SPLITS)[:-1].tolist(), axis=-1)
    qa = partial_rope(qa.reshape(b, S, N_DIL * A_HEADS, HEAD_DIM), pos).reshape(b, S, N_DIL, A_HEADS, HEAD_DIM)
    ka = partial_rope(ka.reshape(b, S, N_DIL * A_HEADS, HEAD_DIM), pos).reshape(b, S, N_DIL, A_HEADS, HEAD_DIM)
    va = va.reshape(b, S, N_DIL, A_HEADS, HEAD_DIM)
    outs, lses = [], []
    for gi, (win, dil) in enumerate(DIL_GROUPS):
        o, l = dilated_attention(qa[:, :, gi], ka[:, :, gi], va[:, :, gi], win, dil)
        outs.append(o)
        lses.append(l)
    alpha = jax.nn.softmax(jnp.stack(lses, axis=0), axis=0)
    ya = jnp.sum(alpha[..., None] * jnp.stack(outs, axis=0).astype(jnp.float32), axis=0)
    ya = ya.astype(x.dtype).reshape(b, S, A_WIDTH)
    qb = partial_rope(qb.reshape(b, S, B_Q_HEADS, HEAD_DIM), pos)
    kb = partial_rope(kb.reshape(b, S, B_KV_HEADS, HEAD_DIM), pos)
    vb = vb.reshape(b, S, B_KV_HEADS, HEAD_DIM)
    yb, _ = banded_attention(qb, kb, vb, B_WINDOW, B_WINDOW, sink_logit=sink_b)
    yb = yb.reshape(b, S, B_Q_WIDTH)
    merged = jax.nn.sigmoid(ga) * (ya @ w_branch_a) + jax.nn.sigmoid(gb) * (yb @ w_branch_b)
    h2 = h + merged @ w_out
    return h2 + 0.5 * swiglu(rmsnorm(h2, g_ffn2), w2_gate, w2_up, w2_down)


def trunk(x, g_ffn1, w1_gate, w1_up, w1_down, g_mix, w_in, sink_b, w_branch_a, w_branch_b,
          w_out, g_ffn2, w2_gate, w2_up, w2_down, g_final):
    for l in range(DEPTH):
        x = encoder_layer(x, g_ffn1[l], w1_gate[l], w1_up[l], w1_down[l], g_mix[l], w_in[l], sink_b[l],
                          w_branch_a[l], w_branch_b[l], w_out[l], g_ffn2[l], w2_gate[l], w2_up[l], w2_down[l])
    return rmsnorm(x, g_final)


def setup_inputs(seed: int = 0) -> dict:
    key = jax.random.key(seed)
    ks = jax.random.split(key, 20)
    f32 = jnp.float32

    def w(k, shape, fan_in):
        return jax.random.normal(k, shape, f32) * (fan_in ** -0.5)

    def gain(k, shape):
        return 1.0 + 0.05 * jax.random.normal(k, shape, f32)

    return {
        "x_prompt": jax.random.normal(ks[0], (BATCH, SEQ, D_MODEL), f32),
        "x_sample": jax.random.normal(ks[1], (DEC_BATCH, DEC_SEQ, D_MODEL), f32),
        "g_ffn1": gain(ks[2], (DEPTH, D_MODEL)),
        "w1_gate": w(ks[3], (DEPTH, D_MODEL, D_FF), D_MODEL),
        "w1_up": w(ks[4], (DEPTH, D_MODEL, D_FF), D_MODEL),
        "w1_down": w(ks[5], (DEPTH, D_FF, D_MODEL), D_FF),
        "g_mix": gain(ks[6], (DEPTH, D_MODEL)),
        "w_in": w(ks[7], (DEPTH, D_MODEL, IN_WIDTH), D_MODEL),
        "sink_b": 0.5 * jax.random.normal(ks[8], (DEPTH, B_Q_HEADS), f32),
        "w_branch_a": w(ks[9], (DEPTH, A_WIDTH, D_MODEL), A_WIDTH),
        "w_branch_b": w(ks[10], (DEPTH, B_Q_WIDTH, D_MODEL), B_Q_WIDTH),
        "w_out": w(ks[11], (DEPTH, D_MODEL, D_MODEL), D_MODEL),
        "g_ffn2": gain(ks[12], (DEPTH, D_MODEL)),
        "w2_gate": w(ks[13], (DEPTH, D_MODEL, D_FF), D_MODEL),
        "w2_up": w(ks[14], (DEPTH, D_MODEL, D_FF), D_MODEL),
        "w2_down": w(ks[15], (DEPTH, D_FF, D_MODEL), D_FF),
        "g_final": gain(ks[16], (D_MODEL,)),
    }


def reference(x_prompt, x_sample, g_ffn1, w1_gate, w1_up, w1_down, g_mix, w_in, sink_b,
              w_branch_a, w_branch_b, w_out, g_ffn2, w2_gate, w2_up, w2_down, g_final):
    y_prompt = trunk(x_prompt, g_ffn1, w1_gate, w1_up, w1_down, g_mix, w_in, sink_b, w_branch_a,
                     w_branch_b, w_out, g_ffn2, w2_gate, w2_up, w2_down, g_final)
    y_sample = trunk(x_sample, g_ffn1, w1_gate, w1_up, w1_down, g_mix, w_in, sink_b, w_branch_a,
                     w_branch_b, w_out, g_ffn2, w2_gate, w2_up, w2_down, g_final)
    return (y_prompt, y_sample)
```

```cpp
#include <hip/hip_runtime.h>
#include <cstdio>
#include <cstdint>

#ifndef MK_N_LAUNCHES
#define MK_N_LAUNCHES 10
#endif

namespace pg8 {
#define PG8_LAS __attribute__((address_space(3)))
typedef unsigned short bf16_t;
typedef short bf16x8 __attribute__((ext_vector_type(8)));
typedef float f32x4 __attribute__((ext_vector_type(4)));
typedef unsigned u32x4 __attribute__((ext_vector_type(4)));
constexpr int BM = 256, BK = 64, HALF = 128, HTB = HALF * BK * 2, STAGE_BYTES = 8 * HTB, NXCD = 8, WGM = 8;

__host__ __device__ __forceinline__ int lds_byte(int r, int c) { const int st = (r >> 4) * 2 + (c >> 5), rr = r & 15, cc = c & 31, ob = rr * 64 + cc * 2; return st * 1024 + (ob ^ (((ob >> 9) & 1) << 5)); }
__host__ __device__ __forceinline__ void stage_rc(int b, int& R, int& C) { const int st = b / 1024, sb = b % 1024, swz = sb ^ (((sb >> 9) & 1) << 5); R = (st >> 1) * 16 + swz / 64; C = (st & 1) * 32 + (swz % 64) / 2; }
__host__ __device__ __forceinline__ int perm32(int rho) { const int n = rho >> 4, i = rho & 15; return 8 * (i >> 2) + 4 * n + (i & 3); }

struct Unit { int pm, pn; };
struct Gemm { const bf16_t* A; const bf16_t* Bt; int M, N, K; };

struct StaticOrder {
    int nM, nN, nwg, G, c;
    __host__ __device__ void init(int M, int N, int G_, int c_) { nM = M / BM; nN = N / BM; nwg = nM * nN; G = G_; c = c_; }
    __host__ __device__ bool next(int i, Unit& u) const {
        const long L = (long)i * G + c; if (L >= nwg) return false;
        int wgid = (int)L; { const int q = nwg / NXCD, r = nwg % NXCD, xcd = wgid % NXCD, off = wgid / NXCD; wgid = (xcd < r ? xcd * (q + 1) : r * (q + 1) + (xcd - r) * q) + off; }
        const int nig = WGM * nN, gid = wgid / nig, fm = gid * WGM, gsz = (nM - fm) < WGM ? (nM - fm) : WGM;
        u.pm = fm + ((wgid % nig) % gsz); u.pn = (wgid % nig) / gsz; return true;
    }
    __device__ __forceinline__ void a_ready(const Unit&) const {}
    __device__ __forceinline__ void done(const Unit&) const {}
};

__device__ __forceinline__ unsigned cvt_pk_bf16(float lo, float hi) { unsigned r; asm volatile("v_cvt_pk_bf16_f32 %0, %1, %2" : "=v"(r) : "v"(lo), "v"(hi)); return r; }
__device__ __forceinline__ float bf_lo(unsigned w) { return __uint_as_float(w << 16); }
__device__ __forceinline__ float bf_hi(unsigned w) { return __uint_as_float(w & 0xffff0000u); }
__device__ __forceinline__ float sigmoid_f(float x) { return __builtin_amdgcn_rcpf(1.0f + __builtin_amdgcn_exp2f(-1.44269504089f * x)); }


struct EpiSwiglu {
    static constexpr bool PERM = true, AFTER_DRAIN = false, HAS_MID = false; static constexpr int MID_T = 0;
    bf16_t* O; int ldc; const float* ss;
    __device__ __forceinline__ void mid(f32x4 (&)[2][2][4][2], const Unit&, int, int, int, int) const {}
    __device__ __forceinline__ void operator()(const f32x4 (&acc)[2][2][4][2], const Unit& u, int wr, int wc, int fr, int fq) const {
        const int row0 = u.pm * BM + wr * 64 + fr, col0 = u.pn * HALF + wc * 32 + 8 * fq;
#pragma unroll
        for (int ai = 0; ai < 2; ++ai)
#pragma unroll
            for (int m = 0; m < 4; ++m) { const int r = row0 + ai * HALF + m * 16; const float rs = __builtin_amdgcn_rsqf(ss[r] * (1.0f / 4096.0f) + 1e-6f);
                float o[8];
#pragma unroll
                for (int n = 0; n < 2; ++n)
#pragma unroll
                    for (int j = 0; j < 4; ++j) { const float g = acc[ai][0][m][n][j] * rs, up = acc[ai][1][m][n][j] * rs; o[4 * n + j] = g * sigmoid_f(g) * up; }
                u32x4 w; w.x = cvt_pk_bf16(o[0], o[1]); w.y = cvt_pk_bf16(o[2], o[3]); w.z = cvt_pk_bf16(o[4], o[5]); w.w = cvt_pk_bf16(o[6], o[7]);
                *(u32x4*)(O + (size_t)r * ldc + col0) = w; }
    }
};

template <bool HAS_OB> struct EpiResid {
    static constexpr bool PERM = true, AFTER_DRAIN = false, HAS_MID = false; static constexpr int MID_T = 0;
    const float* base_lo; const float* base_hi; int split_row; float* out; bf16_t* ob; float* ss; float scale;
    __device__ __forceinline__ void mid(f32x4 (&)[2][2][4][2], const Unit&, int, int, int, int) const {}
    __device__ __forceinline__ void operator()(const f32x4 (&acc)[2][2][4][2], const Unit& u, int wr, int wc, int fr, int fq) const {
        const int row0 = u.pm * BM + wr * 64 + fr, col0 = u.pn * BM + wc * 32 + 8 * fq;
        const float* bb = (u.pm * BM < split_row) ? base_lo : base_hi - (size_t)split_row * 4096;
#pragma unroll
        for (int ai = 0; ai < 2; ++ai)
#pragma unroll
            for (int m = 0; m < 4; ++m) { const int r = row0 + ai * HALF + m * 16; const size_t off = (size_t)r * 4096 + col0; float sq = 0.f;
#pragma unroll
                for (int bj = 0; bj < 2; ++bj) { const f32x4 b0 = *(const f32x4*)(bb + off + bj * HALF), b1 = *(const f32x4*)(bb + off + bj * HALF + 4);
                    const f32x4 v0 = b0 + acc[ai][bj][m][0] * scale, v1 = b1 + acc[ai][bj][m][1] * scale;
                    *(f32x4*)(out + off + bj * HALF) = v0; *(f32x4*)(out + off + bj * HALF + 4) = v1;
                    sq += (v0[0] * v0[0] + v0[1] * v0[1]) + (v0[2] * v0[2] + v0[3] * v0[3]) + (v1[0] * v1[0] + v1[1] * v1[1]) + (v1[2] * v1[2] + v1[3] * v1[3]);
                    if (HAS_OB) { u32x4 w; w.x = cvt_pk_bf16(v0[0], v0[1]); w.y = cvt_pk_bf16(v0[2], v0[3]); w.z = cvt_pk_bf16(v1[0], v1[1]); w.w = cvt_pk_bf16(v1[2], v1[3]); *(u32x4*)(ob + off + bj * HALF) = w; } }
                sq += __shfl_xor(sq, 16); sq += __shfl_xor(sq, 32);
                if (fq == 0) __hip_atomic_fetch_add(ss + r, sq, __ATOMIC_RELAXED, __HIP_MEMORY_SCOPE_AGENT); }
    }
};

struct EpiProj {
    static constexpr bool PERM = true, AFTER_DRAIN = false, HAS_MID = false; static constexpr int MID_T = 0;
    bf16_t* qkv; bf16_t* gates; const float* ss; const float* rope;
    __device__ __forceinline__ void mid(f32x4 (&)[2][2][4][2], const Unit&, int, int, int, int) const {}
    __device__ __forceinline__ void operator()(const f32x4 (&acc)[2][2][4][2], const Unit& u, int wr, int wc, int fr, int fq) const {
        const int pn = u.pn; const bool is_gate = pn >= 48, is_rope = (pn < 24) || (pn >= 36 && pn < 46);
        const int row0 = u.pm * BM + wr * 64 + fr, cw = wc * 32 + 8 * fq;
        bf16_t* dst = is_gate ? gates + (pn - 48) * BM + cw : qkv + pn * BM + cw; const int ld = is_gate ? 8192 : 12288;
        const bool do_rope = is_rope && (wc == 0); const float sgn = fq < 2 ? -1.0f : 1.0f;
#pragma unroll
        for (int ai = 0; ai < 2; ++ai)
#pragma unroll
            for (int m = 0; m < 4; ++m) { const int r = row0 + ai * HALF + m * 16; const float rs = __builtin_amdgcn_rsqf(ss[r] * (1.0f / 4096.0f) + 1e-6f);
                const int pos = r < 8192 ? (r & 4095) : r - 8192;
                f32x4 c0 = {1.f, 1.f, 1.f, 1.f}, c1 = c0, s0 = {0.f, 0.f, 0.f, 0.f}, s1 = s0;
                if (do_rope) { const float* tp = rope + (size_t)pos * 32 + 8 * (fq & 1); c0 = *(const f32x4*)tp; c1 = *(const f32x4*)(tp + 4); s0 = *(const f32x4*)(tp + 16); s1 = *(const f32x4*)(tp + 20); }
#pragma unroll
                for (int bj = 0; bj < 2; ++bj) { f32x4 v0 = acc[ai][bj][m][0] * rs, v1 = acc[ai][bj][m][1] * rs;
                    if (do_rope) {
#pragma unroll
                        for (int j = 0; j < 4; ++j) { const float p0 = __shfl_xor(v0[j], 32), p1 = __shfl_xor(v1[j], 32); v0[j] = v0[j] * c0[j] + sgn * p0 * s0[j]; v1[j] = v1[j] * c1[j] + sgn * p1 * s1[j]; } }
                    if (is_gate) {
#pragma unroll
                        for (int j = 0; j < 4; ++j) { v0[j] = sigmoid_f(v0[j]); v1[j] = sigmoid_f(v1[j]); } }
                    u32x4 w; w.x = cvt_pk_bf16(v0[0], v0[1]); w.y = cvt_pk_bf16(v0[2], v0[3]); w.z = cvt_pk_bf16(v1[0], v1[1]); w.w = cvt_pk_bf16(v1[2], v1[3]);
                    *(u32x4*)(dst + (size_t)r * ld + bj * HALF) = w; } }
    }
};

struct EpiMerge {
    static constexpr bool PERM = true, AFTER_DRAIN = false, HAS_MID = true; static constexpr int MID_T = 16;
    const bf16_t* gates; bf16_t* O;
    __device__ __forceinline__ void mid(f32x4 (&acc)[2][2][4][2], const Unit& u, int wr, int wc, int fr, int fq) const {
        const int row0 = u.pm * BM + wr * 64 + fr, col0 = u.pn * BM + wc * 32 + 8 * fq;
#pragma unroll
        for (int ai = 0; ai < 2; ++ai)
#pragma unroll
            for (int m = 0; m < 4; ++m) { int r = row0 + ai * HALF + m * 16; asm volatile("" : "+v"(r));
                const bf16_t* gp = gates + (size_t)r * 8192 + col0;
#pragma unroll
                for (int bj = 0; bj < 2; ++bj) { const u32x4 a = *(const u32x4*)(gp + bj * HALF), b = *(const u32x4*)(gp + 4096 + bj * HALF);
                    f32x4 r0, r1;
                    r0[0] = bf_lo(a.x) * __builtin_amdgcn_rcpf(fmaxf(bf_lo(b.x), 1e-20f)); r0[1] = bf_hi(a.x) * __builtin_amdgcn_rcpf(fmaxf(bf_hi(b.x), 1e-20f));
                    r0[2] = bf_lo(a.y) * __builtin_amdgcn_rcpf(fmaxf(bf_lo(b.y), 1e-20f)); r0[3] = bf_hi(a.y) * __builtin_amdgcn_rcpf(fmaxf(bf_hi(b.y), 1e-20f));
                    r1[0] = bf_lo(a.z) * __builtin_amdgcn_rcpf(fmaxf(bf_lo(b.z), 1e-20f)); r1[1] = bf_hi(a.z) * __builtin_amdgcn_rcpf(fmaxf(bf_hi(b.z), 1e-20f));
                    r1[2] = bf_lo(a.w) * __builtin_amdgcn_rcpf(fmaxf(bf_lo(b.w), 1e-20f)); r1[3] = bf_hi(a.w) * __builtin_amdgcn_rcpf(fmaxf(bf_hi(b.w), 1e-20f));
                    acc[ai][bj][m][0] *= r0; acc[ai][bj][m][1] *= r1; }
                asm volatile("" ::: "memory"); }
    }
    __device__ __forceinline__ void operator()(const f32x4 (&acc)[2][2][4][2], const Unit& u, int wr, int wc, int fr, int fq) const {
        const int row0 = u.pm * BM + wr * 64 + fr, col0 = u.pn * BM + wc * 32 + 8 * fq;
#pragma unroll
        for (int ai = 0; ai < 2; ++ai)
#pragma unroll
            for (int m = 0; m < 4; ++m) { const int r = row0 + ai * HALF + m * 16; const bf16_t* gp = gates + (size_t)r * 8192 + 4096 + col0;
#pragma unroll
                for (int bj = 0; bj < 2; ++bj) { const u32x4 b = *(const u32x4*)(gp + bj * HALF); const f32x4 a0 = acc[ai][bj][m][0], a1 = acc[ai][bj][m][1];
                    u32x4 w;
                    w.x = cvt_pk_bf16(a0[0] * fmaxf(bf_lo(b.x), 1e-20f), a0[1] * fmaxf(bf_hi(b.x), 1e-20f)); w.y = cvt_pk_bf16(a0[2] * fmaxf(bf_lo(b.y), 1e-20f), a0[3] * fmaxf(bf_hi(b.y), 1e-20f));
                    w.z = cvt_pk_bf16(a1[0] * fmaxf(bf_lo(b.z), 1e-20f), a1[1] * fmaxf(bf_hi(b.z), 1e-20f)); w.w = cvt_pk_bf16(a1[2] * fmaxf(bf_lo(b.w), 1e-20f), a1[3] * fmaxf(bf_hi(b.w), 1e-20f));
                    *(u32x4*)(O + (size_t)r * 4096 + col0 + bj * HALF) = w; } }
    }
};

template <class Epi, class Sched, bool ALIGN_EPI = false, bool SP2 = false>
__device__ __forceinline__ void gemm_phase(PG8_LAS unsigned char* lds, const Gemm g, const Sched& S, const Epi& E) {
    const int tid = threadIdx.x, wid = __builtin_amdgcn_readfirstlane(tid >> 6), lane = tid & 63, wr = wid >> 2, wc = wid & 3, fr = lane & 15, fq = lane >> 4;
    const int K = g.K, nt = K / BK;
    unsigned voffA[2], voffB[2];
#pragma unroll
    for (int i = 0; i < 2; ++i) { int R, C; stage_rc(tid * 16 + i * 8192, R, C); const int Rb = Epi::PERM ? ((R & ~31) + perm32(R & 31)) : R;
        voffA[i] = (unsigned)(R * K + C) * 2u; voffB[i] = (unsigned)(Rb * K + C) * 2u; }
    const size_t kstep = (size_t)(BK * 2);
    const size_t hstep = (size_t)HALF * K * 2;
    const size_t tstep = 2 * hstep;
    const unsigned ldsw = (unsigned)wid * 1024u;
    const int aoff = lds_byte(wr * 64 + fr, fq * 8), boff = lds_byte(wc * 32 + fr, fq * 8);
#define PG8_SA(b, h) (((b) * 2 + (h)) * HTB)
#define PG8_SB(b, h) ((4 + (b) * 2 + (h)) * HTB)
#define PG8_STAGE(bufoff, gbase, voff) do { _Pragma("unroll") for (int _i = 0; _i < 2; ++_i) \
        __builtin_amdgcn_global_load_lds((const unsigned*)((const char*)(gbase) + (voff)[_i]), (PG8_LAS unsigned*)(lds + (bufoff) + ldsw + _i * 8192), 16, 0, 0); } while (0)
#define PG8_LDA(dst, b, h) do { _Pragma("unroll") for (int m = 0; m < 4; ++m) _Pragma("unroll") for (int k = 0; k < 2; ++k) dst[m][k] = *(const PG8_LAS bf16x8*)(lds + PG8_SA(b, h) + aoff + m * 2048 + k * 1024); } while (0)
#define PG8_LDB(dst, b, h) do { _Pragma("unroll") for (int n = 0; n < 2; ++n) _Pragma("unroll") for (int k = 0; k < 2; ++k) dst[n][k] = *(const PG8_LAS bf16x8*)(lds + PG8_SB(b, h) + boff + n * 2048 + k * 1024); } while (0)
#define PG8_MMA(ai, bj, At, Bt) do { __builtin_amdgcn_s_setprio(1); _Pragma("unroll") for (int m = 0; m < 4; ++m) _Pragma("unroll") for (int n = 0; n < 2; ++n) _Pragma("unroll") for (int k = 0; k < 2; ++k) \
        acc[ai][bj][m][n] = __builtin_amdgcn_mfma_f32_16x16x32_bf16(Bt[n][k], At[m][k], acc[ai][bj][m][n], 0, 0, 0); __builtin_amdgcn_s_setprio(0); } while (0)
#define PG8_WAIT_V(n) asm volatile("s_waitcnt vmcnt(" #n ")" ::: "memory")
#define PG8_WAIT_L(n) asm volatile("s_waitcnt lgkmcnt(" #n ")" ::: "memory")
#define PG8_BAR __builtin_amdgcn_s_barrier()
#define PG8_SCHED __builtin_amdgcn_sched_barrier(0)
    Unit cur, nxt; int ui = 0;
    if (!S.next(0, cur)) return;
    f32x4 acc[2][2][4][2];
#pragma unroll
    for (int a = 0; a < 2; ++a)
#pragma unroll
        for (int b = 0; b < 2; ++b)
#pragma unroll
            for (int m = 0; m < 4; ++m)
#pragma unroll
                for (int n = 0; n < 2; ++n) acc[a][b][m][n] = (f32x4){0.f, 0.f, 0.f, 0.f};
    bf16x8 At[4][2], B0[2][2], B1[2][2];
    const char* cA = (const char*)g.A + (size_t)cur.pm * tstep; const char* cB = (const char*)g.Bt + (size_t)cur.pn * tstep;
    S.a_ready(cur);
    if constexpr (SP2) {
        PG8_STAGE(PG8_SB(0, 0), cB, voffB); PG8_STAGE(PG8_SB(0, 1), cB + hstep, voffB); PG8_STAGE(PG8_SA(0, 0), cA, voffA); PG8_STAGE(PG8_SA(0, 1), cA + hstep, voffA);
        if (wr == 1) PG8_BAR;
        PG8_WAIT_V(2); PG8_BAR;
        PG8_STAGE(PG8_SB(1, 0), cB + kstep, voffB); PG8_STAGE(PG8_SA(1, 0), cA + kstep, voffA); PG8_STAGE(PG8_SB(1, 1), cB + hstep + kstep, voffB);
        PG8_WAIT_V(6); PG8_BAR;
    } else {
        PG8_STAGE(PG8_SB(0, 0), cB, voffB); PG8_STAGE(PG8_SA(0, 0), cA, voffA); PG8_STAGE(PG8_SB(0, 1), cB + hstep, voffB); PG8_STAGE(PG8_SA(0, 1), cA + hstep, voffA);
        if (wr == 1) PG8_BAR;
        PG8_WAIT_V(4); PG8_BAR;
        PG8_STAGE(PG8_SB(1, 0), cB + kstep, voffB); PG8_STAGE(PG8_SA(1, 0), cA + kstep, voffA); PG8_STAGE(PG8_SB(1, 1), cB + hstep + kstep, voffB);
        PG8_WAIT_V(6); PG8_BAR;
    }
    for (;;) {
        const bool has_next = S.next(ui + 1, nxt);
        const char* nA = has_next ? (const char*)g.A + (size_t)nxt.pm * tstep : cA; const char* nB = has_next ? (const char*)g.Bt + (size_t)nxt.pn * tstep : cB;
        for (int t = 0; t < nt; t += 2) {
            const bool last = (t == nt - 2);
            const char* a1 = cA + (size_t)(t + 1) * kstep;
            const char* a2 = last ? nA : cA + (size_t)(t + 2) * kstep; const char* b2 = last ? nB : cB + (size_t)(t + 2) * kstep;
            const char* a3 = a2 + kstep; const char* b3 = b2 + kstep;
            if (last && has_next) S.a_ready(nxt);
            if constexpr (Epi::HAS_MID) { if (t == Epi::MID_T) E.mid(acc, cur, wr, wc, fr, fq); }
            if constexpr (SP2) {
            PG8_LDB(B0, 0, 0); PG8_LDB(B1, 0, 1); PG8_SCHED; PG8_LDA(At, 0, 0); PG8_STAGE(PG8_SA(1, 1), a1 + hstep, voffA);
            PG8_WAIT_V(8); PG8_WAIT_L(0); PG8_BAR; PG8_MMA(0, 0, At, B0); PG8_MMA(0, 1, At, B1); PG8_BAR; PG8_SCHED;
            PG8_LDA(At, 0, 1); PG8_STAGE(PG8_SB(0, 0), b2, voffB); PG8_STAGE(PG8_SB(0, 1), b2 + hstep, voffB); PG8_STAGE(PG8_SA(0, 0), a2, voffA);
            PG8_WAIT_V(8); PG8_WAIT_L(0); PG8_BAR; PG8_MMA(1, 0, At, B0); PG8_MMA(1, 1, At, B1); PG8_BAR; PG8_SCHED;
            PG8_LDB(B0, 1, 0); PG8_LDB(B1, 1, 1); PG8_SCHED; PG8_LDA(At, 1, 0); PG8_STAGE(PG8_SA(0, 1), a2 + hstep, voffA);
            PG8_WAIT_V(8); PG8_WAIT_L(0); PG8_BAR; PG8_MMA(0, 0, At, B0); PG8_MMA(0, 1, At, B1); PG8_BAR; PG8_SCHED;
            PG8_LDA(At, 1, 1); PG8_STAGE(PG8_SB(1, 0), b3, voffB); PG8_STAGE(PG8_SB(1, 1), b3 + hstep, voffB); PG8_STAGE(PG8_SA(1, 0), a3, voffA);
            PG8_WAIT_V(8); PG8_WAIT_L(0); PG8_BAR; PG8_MMA(1, 0, At, B0); PG8_MMA(1, 1, At, B1); PG8_BAR; PG8_SCHED;
            } else {
            PG8_LDB(B0, 0, 0); PG8_SCHED; PG8_LDA(At, 0, 0); PG8_STAGE(PG8_SA(1, 1), a1 + hstep, voffA);
            PG8_WAIT_L(8); PG8_BAR; PG8_WAIT_L(0); PG8_MMA(0, 0, At, B0); PG8_BAR; PG8_SCHED;
            PG8_LDB(B1, 0, 1); PG8_STAGE(PG8_SB(0, 0), b2, voffB);
            PG8_BAR; PG8_WAIT_L(0); PG8_MMA(0, 1, At, B1); PG8_BAR;
            PG8_LDA(At, 0, 1); PG8_STAGE(PG8_SA(0, 0), a2, voffA);
            PG8_BAR; PG8_WAIT_L(0); PG8_MMA(1, 0, At, B0); PG8_BAR; PG8_SCHED;
            PG8_STAGE(PG8_SB(0, 1), b2 + hstep, voffB);
            PG8_WAIT_V(6); PG8_BAR; PG8_MMA(1, 1, At, B1); PG8_BAR;
            PG8_LDB(B0, 1, 0); PG8_SCHED; PG8_LDA(At, 1, 0); PG8_STAGE(PG8_SA(0, 1), a2 + hstep, voffA);
            PG8_WAIT_L(8); PG8_BAR; PG8_WAIT_L(0); PG8_MMA(0, 0, At, B0); PG8_BAR; PG8_SCHED;
            PG8_LDB(B1, 1, 1); PG8_STAGE(PG8_SB(1, 0), b3, voffB);
            PG8_BAR; PG8_WAIT_L(0); PG8_MMA(0, 1, At, B1); PG8_BAR;
            PG8_LDA(At, 1, 1); PG8_STAGE(PG8_SA(1, 0), a3, voffA);
            PG8_BAR; PG8_WAIT_L(0); PG8_MMA(1, 0, At, B0); PG8_BAR; PG8_SCHED;
            PG8_STAGE(PG8_SB(1, 1), b3 + hstep, voffB);
            PG8_WAIT_V(6); PG8_BAR; PG8_MMA(1, 1, At, B1); PG8_BAR;
            }
        }
        if constexpr (ALIGN_EPI) { if (wr == 0) PG8_BAR; }
        if constexpr (!Epi::AFTER_DRAIN) { E(acc, cur, wr, wc, fr, fq); S.done(cur); }
        if (!has_next) break;
#pragma unroll
        for (int a = 0; a < 2; ++a)
#pragma unroll
            for (int b = 0; b < 2; ++b)
#pragma unroll
                for (int m = 0; m < 4; ++m)
#pragma unroll
                    for (int n = 0; n < 2; ++n) acc[a][b][m][n] = (f32x4){0.f, 0.f, 0.f, 0.f};
        cur = nxt; cA = nA; cB = nB; ++ui;
        if constexpr (ALIGN_EPI) { if (wr == 1) PG8_BAR; }
    }
    PG8_WAIT_V(0);
    if constexpr (!ALIGN_EPI) { if (wr == 0) PG8_BAR; }
    PG8_BAR;
#undef PG8_SA
#undef PG8_SB
#undef PG8_STAGE
#undef PG8_LDA
#undef PG8_LDB
#undef PG8_MMA
#undef PG8_WAIT_V
#undef PG8_WAIT_L
#undef PG8_BAR
#undef PG8_SCHED
}
}

#ifndef PG8_SP2
#define PG8_SP2 true
#endif
#ifndef PG8_ALIGN
#define PG8_ALIGN true
#endif

constexpr int NWAVES = 8;
constexpr int N_LAUNCHES = MK_N_LAUNCHES;
constexpr int PER_PHASE = 10;
constexpr int D = 4096, FF = 11008, NIN = 20480, QKVW = 12288, GATEW = 8192, YABW = 3072;
constexpr int M_P = 8192, M_S = 16384, M = M_P + M_S;
constexpr float QSCALE = 0.08838834764831845f * 1.4426950408889634f;

constexpr size_t MiB = 1u << 20;
constexpr size_t WS_CTL = 0, CTL_ZERO_BYTES = 1 * MiB;
constexpr size_t WS_SS0 = 1 * MiB;
constexpr size_t WS_ROPE = 2 * MiB;
constexpr size_t WS_WIN = 4 * MiB;
constexpr size_t WS_WAB = WS_WIN + (size_t)NIN * D * 2;
constexpr size_t WS_WOUT = WS_WAB + (size_t)D * YABW * 2;
constexpr size_t WS_WGU = WS_WOUT + (size_t)D * D * 2;
constexpr size_t WS_WD = WS_WGU + (size_t)2 * FF * D * 2;
constexpr size_t WS_AB1 = WS_WD + (size_t)D * FF * 2;
constexpr size_t WS_ACT = WS_AB1 + (size_t)M * D * 2;
constexpr size_t WS_QKV = WS_ACT + (size_t)M * FF * 2;
constexpr size_t WS_END = WS_QKV + (size_t)M * QKVW * 2;
constexpr int CW_BAR = 4096;
constexpr int CW_SS1 = 16384, CW_SS2 = CW_SS1 + M, CW_SS3 = CW_SS2 + M;
static_assert((size_t)(CW_SS3 + M) * 4 <= CTL_ZERO_BYTES, "CTL words inside the memset region");
static_assert(WS_SS0 + (size_t)M * 4 <= WS_ROPE && WS_ROPE + (size_t)16384 * 32 * 4 <= WS_WIN, "ws map");

constexpr int RING_OFF = 0, RING_BYTES = 131072;
constexpr int LDSCTL_OFF = RING_BYTES, MISC_OFF = LDSCTL_OFF + 320;
constexpr int LDS_BYTES = 147456;

#define GAS __attribute__((address_space(1)))
#define LAS __attribute__((address_space(3)))
typedef unsigned short bf16;
typedef unsigned v4u __attribute__((ext_vector_type(4)));
typedef unsigned v2u __attribute__((ext_vector_type(2)));
typedef float f32x4 __attribute__((ext_vector_type(4)));
typedef short bf16x8 __attribute__((ext_vector_type(8)));
typedef short s16x4 __attribute__((ext_vector_type(4)));
typedef GAS unsigned gu32;
#define RLX_AGENT __ATOMIC_RELAXED, __HIP_MEMORY_SCOPE_AGENT
#define LDS_WAIT() asm volatile("s_waitcnt lgkmcnt(0)" ::: "memory")
#define VM_WAIT() asm volatile("s_waitcnt vmcnt(0)" ::: "memory")
__device__ __forceinline__ unsigned pk2(float lo, float hi) { return pg8::cvt_pk_bf16(lo, hi); }

#define XB_TMO      128
#define XB_XCNT(j)  (256  + 64 * (j))
#define XB_XSUB(j)  (1280 + 64 * (j))
#define XB_XGEN(j)  (2304 + 64 * (j))
#define XB_TOP      3328
#define XB_TOPGEN   3392
#define XCD_BAR_WORDS 3456
#define XB_SPIN_CAP (1u << 18)

__device__ __forceinline__ unsigned xb_ld(unsigned* p)              { return __hip_atomic_load(p, __ATOMIC_RELAXED, __HIP_MEMORY_SCOPE_AGENT); }
__device__ __forceinline__ unsigned xb_add(unsigned* p, unsigned v) { return __hip_atomic_fetch_add(p, v, __ATOMIC_RELAXED, __HIP_MEMORY_SCOPE_AGENT); }
__device__ __forceinline__ unsigned xb_xcc_id() { return (unsigned)__builtin_amdgcn_s_getreg((3 << 11) | 20) & 0xFu; }
#define XB_SPIN(cond, bar) do { unsigned _sp = 0; while (cond) { __builtin_amdgcn_s_sleep(1); \
    if ((++_sp & 255u) == 0u) { if (xb_ld(&(bar)[XB_TMO])) break; if (_sp > XB_SPIN_CAP) { atomicAdd(&(bar)[XB_TMO], 1u); break; } } } } while (0)

struct XcdBarrier {
    unsigned* bar; unsigned x;
    volatile LAS unsigned* st;
};
__device__ __forceinline__ XcdBarrier xcd_barrier_post(unsigned* bar, volatile LAS unsigned* st) {
    XcdBarrier b; b.bar = bar; b.x = xb_xcc_id(); b.st = st;
    if (threadIdx.x == 0) (void)xb_add(&bar[XB_XCNT(b.x)], 1u);
    return b;
}
__device__ __forceinline__ void xcd_barrier_complete(unsigned* bar, unsigned x, unsigned& nloc, unsigned& nx) {
    const unsigned G = gridDim.x * gridDim.y * gridDim.z;
    unsigned sum, cnt, mine, sp = 0u;
    for (;;) {
        sum = 0u; cnt = 0u; mine = 0u;
#pragma unroll
        for (unsigned j = 0; j < 16; ++j) { const unsigned c = xb_ld(&bar[XB_XCNT(j)]); sum += c; cnt += (c > 0u) ? 1u : 0u; mine = (j == x) ? c : mine; }
        if (sum == G) break;
        __builtin_amdgcn_s_sleep(1);
        if ((++sp & 255u) == 0u) { if (xb_ld(&bar[XB_TMO])) break; if (sp > XB_SPIN_CAP) { atomicAdd(&bar[XB_TMO], 1u); break; } }
    }
    nloc = mine > 0u ? mine : 1u; nx = cnt > 0u ? cnt : 1u;
}
__device__ __forceinline__ void xcd_barrier(const XcdBarrier& b) {
    asm volatile("s_waitcnt vmcnt(0)" ::: "memory");
    __syncthreads();
    if (threadIdx.x == 0) {
        unsigned* bar = b.bar;
        __builtin_amdgcn_s_waitcnt(0);
        unsigned nloc = b.st[0], nx = b.st[1];
        if (nloc == 0u) { xcd_barrier_complete(bar, b.x, nloc, nx); b.st[0] = nloc; b.st[1] = nx; }
        const unsigned old = xb_add(&bar[XB_XSUB(b.x)], 1u);
        const unsigned gen = old / nloc;
        if (old + 1u == (gen + 1u) * nloc) {
            __builtin_amdgcn_fence(__ATOMIC_RELEASE, "agent");
            asm volatile("s_waitcnt vmcnt(0)" ::: "memory");
            const unsigned og = xb_add(&bar[XB_TOP], 1u);
            const unsigned tg = og / nx;
            if (og + 1u == (tg + 1u) * nx) xb_add(&bar[XB_TOPGEN], 1u);
            else XB_SPIN(xb_ld(&bar[XB_TOPGEN]) == tg, bar);
            __builtin_amdgcn_fence(__ATOMIC_ACQUIRE, "agent");
            xb_add(&bar[XB_XGEN(b.x)], 1u);
            asm volatile("s_waitcnt vmcnt(0)" ::: "memory");
        } else {
            XB_SPIN(xb_ld(&bar[XB_XGEN(b.x)]) == gen, bar);
            __builtin_amdgcn_fence(__ATOMIC_ACQUIRE, "agent");
            asm volatile("s_waitcnt vmcnt(0)" ::: "memory");
        }
    }
    __syncthreads();
}

struct Frame {
    LAS unsigned char* lds;
    volatile LAS unsigned* MISC;
    gu32* ctl;
    int tid, lane, wave;
    int vcu, G;
};

__device__ __forceinline__ float wave_sum(float v) {
#pragma unroll
    for (int o = 1; o < 64; o <<= 1) v += __shfl_xor(v, o);
    return v;
}

__device__ __forceinline__ void p0_transpose_item(const float* W, int K, int N, const float* gain, bf16* WT, int ldT, int koff, int mode, LAS float* scr, int item, int lane) {
    const int nblk = N / 32, kb = item / nblk, nb = item % nblk, k0 = 64 * kb, n0 = 32 * nb;
    float cs = 1.0f; if (mode == 3 && (n0 < 3072 || (n0 >= 9216 && n0 < 11264))) cs = QSCALE;
    int drow = n0; if (mode == 1 || mode == 2) drow = 256 * (n0 >> 7) + (n0 & 127) + (mode == 2 ? 128 : 0);
#pragma unroll 8
    for (int i = 0; i < 32; ++i) { const int kk = 2 * i + (lane >> 5); const float gk = gain ? gain[k0 + kk] * cs : cs; scr[kk * 33 + (lane & 31)] = W[(size_t)(k0 + kk) * N + n0 + (lane & 31)] * gk; }
    LDS_WAIT(); asm volatile("" ::: "memory");
    const int c = lane & 7;
#pragma unroll
    for (int j = 0; j < 4; ++j) { const int n = (lane >> 3) + 8 * j; const LAS float* s = scr + (8 * c) * 33 + n;
        v4u o; o.x = pk2(s[0 * 33], s[1 * 33]); o.y = pk2(s[2 * 33], s[3 * 33]); o.z = pk2(s[4 * 33], s[5 * 33]); o.w = pk2(s[6 * 33], s[7 * 33]);
        *(GAS v4u*)(WT + (size_t)(drow + n) * ldT + koff + k0 + 8 * c) = o; }
    LDS_WAIT(); asm volatile("" ::: "memory");
}

__device__ __forceinline__ void sincos_acc(float a, float& s, float& c) {
    const double x = (double)a;
    const double kq = __builtin_rint(x * 0.63661977236758134308);
    double r = __builtin_fma(-kq, 1.57079632679489655800e+00, x);
    r = __builtin_fma(-kq, 6.12323399573676603587e-17, r);
    const int q = (int)((long long)kq) & 3;
    const double r2 = r * r;
    const double sp = r * (1.0 + r2 * (-1.0 / 6.0 + r2 * (1.0 / 120.0 + r2 * (-1.0 / 5040.0 + r2 * (1.0 / 362880.0 + r2 * (-1.0 / 39916800.0 + r2 * (1.0 / 6227020800.0)))))));
    const double cp = 1.0 + r2 * (-0.5 + r2 * (1.0 / 24.0 + r2 * (-1.0 / 720.0 + r2 * (1.0 / 40320.0 + r2 * (-1.0 / 3628800.0 + r2 * (1.0 / 479001600.0))))));
    const double ss = (q & 1) ? cp : sp, cc = (q & 1) ? sp : cp;
    s = (float)((q & 2) ? -ss : ss);
    c = (float)(((q + 1) & 2) ? -cc : cc);
}

struct Ptrs {
    const float* xp; const float* xs; const float* g1; const float* w1g; const float* w1u; const float* w1d; const float* gmix; const float* win; const float* sink;
    const float* wa; const float* wb; const float* wout; const float* g2; const float* w2g; const float* w2u; const float* w2d; const float* gfin;
    float* out; unsigned char* ws;
};

__device__ __forceinline__ void p0_prologue(Frame& F, const Ptrs& P) {
    LAS float* scr = (LAS float*)(F.lds + RING_OFF + F.wave * 16384);
    const int gw = F.vcu * NWAVES + F.wave, NGW = F.G * NWAVES;
    bf16* WGU = (bf16*)(P.ws + WS_WGU); bf16* WD = (bf16*)(P.ws + WS_WD); bf16* WIN = (bf16*)(P.ws + WS_WIN); bf16* WAB = (bf16*)(P.ws + WS_WAB); bf16* WOUT = (bf16*)(P.ws + WS_WOUT);
    { float* tab = (float*)(P.ws + WS_ROPE);
      const float inv[16] = {1.000000000e+00f, 4.403665960e-01f, 1.939227432e-01f, 8.539710194e-02f, 3.760603070e-02f, 1.656044088e-02f, 7.292664610e-03f, 3.211446106e-03f,
                             1.414213562e-03f, 6.227724371e-04f, 2.742481884e-04f, 1.207697351e-04f, 5.318295734e-05f, 2.341999971e-05f, 1.031338525e-05f, 4.541670478e-06f};
      for (int pos = gw * 64 + F.lane; pos < 16384; pos += NGW * 64) {
#pragma unroll
          for (int i = 0; i < 16; ++i) { const float ang = (float)pos * inv[i]; float s, c; sincos_acc(ang, s, c); tab[(size_t)pos * 32 + i] = c; tab[(size_t)pos * 32 + 16 + i] = s; } } }
    { bf16* XB = (bf16*)(P.ws + WS_AB1); float* ss0 = (float*)(P.ws + WS_SS0);
      for (int m = gw; m < M; m += NGW) { const float* xrow = (m < M_P) ? P.xp + (size_t)m * D : P.xs + (size_t)(m - M_P) * D;
          const GAS f32x4* xr = (const GAS f32x4*)xrow + F.lane; GAS v2u* o8 = (GAS v2u*)(XB + (size_t)m * D) + F.lane; float s = 0.f;
#pragma unroll
          for (int j = 0; j < 16; ++j) { const f32x4 v = xr[64 * j]; s += (v.x * v.x + v.y * v.y) + (v.z * v.z + v.w * v.w); v2u w; w.x = pk2(v.x, v.y); w.y = pk2(v.z, v.w); o8[64 * j] = w; }
          s = wave_sum(s); if (F.lane == 0) ss0[m] = s; } }
    constexpr int I_GU = (D / 64) * (FF / 32), I_D = (FF / 64) * (D / 32), I_IN = (D / 64) * (NIN / 32), I_A = (1024 / 64) * (D / 32), I_B = (2048 / 64) * (D / 32), I_O = (D / 64) * (D / 32);
    constexpr int NITEMS = 2 * I_GU + I_D + I_IN + I_A + I_B + I_O;
    for (int it = gw; it < NITEMS; it += NGW) {
        int r = it;
        if (r < I_GU) { p0_transpose_item(P.w1g, D, FF, P.g1, WGU, D, 0, 1, scr, r, F.lane); continue; } r -= I_GU;
        if (r < I_GU) { p0_transpose_item(P.w1u, D, FF, P.g1, WGU, D, 0, 2, scr, r, F.lane); continue; } r -= I_GU;
        if (r < I_D)  { p0_transpose_item(P.w1d, FF, D, nullptr, WD, FF, 0, 0, scr, r, F.lane); continue; } r -= I_D;
        if (r < I_IN) { p0_transpose_item(P.win, D, NIN, P.gmix, WIN, D, 0, 3, scr, r, F.lane); continue; } r -= I_IN;
        if (r < I_A)  { p0_transpose_item(P.wa, 1024, D, nullptr, WAB, YABW, 0, 0, scr, r, F.lane); continue; } r -= I_A;
        if (r < I_B)  { p0_transpose_item(P.wb, 2048, D, nullptr, WAB, YABW, 1024, 0, scr, r, F.lane); continue; } r -= I_B;
        p0_transpose_item(P.wout, D, D, nullptr, WOUT, D, 0, 0, scr, r, F.lane);
    }
}
__device__ __forceinline__ void p4_convert_w2(Frame& F, const Ptrs& P) {
    LAS float* scr = (LAS float*)(F.lds + RING_OFF + F.wave * 16384);
    const int gw = F.vcu * NWAVES + F.wave, NGW = F.G * NWAVES;
    bf16* WGU = (bf16*)(P.ws + WS_WGU); bf16* WD = (bf16*)(P.ws + WS_WD);
    constexpr int I_GU = (D / 64) * (FF / 32), I_D = (FF / 64) * (D / 32);
    constexpr int NITEMS = 2 * I_GU + I_D;
    for (int it = gw; it < NITEMS; it += NGW) {
        int r = it;
        if (r < I_GU) { p0_transpose_item(P.w2g, D, FF, P.g2, WGU, D, 0, 1, scr, r, F.lane); continue; } r -= I_GU;
        if (r < I_GU) { p0_transpose_item(P.w2u, D, FF, P.g2, WGU, D, 0, 2, scr, r, F.lane); continue; } r -= I_GU;
        p0_transpose_item(P.w2d, FF, D, nullptr, WD, FF, 0, 0, scr, r, F.lane);
    }
}

__device__ __forceinline__ unsigned off_b(unsigned row, unsigned ch) { return 256u * row + 16u * (ch ^ (((row & 3) << 2) | ((row >> 2) & 3))); }
struct AttState { float m, l; f32x4 O[8]; };

__device__ __forceinline__ void attn_keys(AttState& st, const bf16x8 (&qf)[4], const bf16* Kb, const bf16* Vb, int S, int tq, int kstart, int dil, int ntiles, int W, LAS unsigned char* vl, int lane) {
    const int i = lane & 15, g = lane >> 4;
    const int kk_a = 8 * (i >> 2) + (i & 3);
    for (int tile = 0; tile < ntiles; ++tile) {
        const int tb = kstart + tile * 32 * dil;
        v4u vreg[8];
#pragma unroll
        for (int c = 0; c < 8; ++c) { int tk = tb + dil * (4 * c + g); tk = tk < 0 ? 0 : (tk > S - 1 ? S - 1 : tk); vreg[c] = *(const v4u*)(Vb + (size_t)tk * QKVW + 8 * i); }
        bf16x8 kf[2][4];
#pragma unroll
        for (int t = 0; t < 2; ++t) { int tk = tb + dil * (kk_a + 4 * t); tk = tk < 0 ? 0 : (tk > S - 1 ? S - 1 : tk); const bf16* kp = Kb + (size_t)tk * QKVW + 32 * g;
#pragma unroll
            for (int s = 0; s < 4; ++s) kf[t][s] = *(const bf16x8*)(kp + 8 * s); }
#pragma unroll
        for (int c = 0; c < 8; ++c) *(LAS v4u*)(vl + off_b(4 * c + g, i)) = vreg[c];
        f32x4 sc[2];
#pragma unroll
        for (int t = 0; t < 2; ++t) { sc[t] = (f32x4){0.f, 0.f, 0.f, 0.f};
#pragma unroll
            for (int s = 0; s < 4; ++s) sc[t] = __builtin_amdgcn_mfma_f32_16x16x32_bf16(kf[t][s], qf[s], sc[t], 0, 0, 0); }
        float mx = -1e30f;
#pragma unroll
        for (int t = 0; t < 2; ++t)
#pragma unroll
            for (int r = 0; r < 4; ++r) { const int tk = tb + dil * (8 * g + 4 * t + r); const int d = tk - tq; const bool ok = (d <= W) && (d >= -W) && (tk >= 0) && (tk < S);
                sc[t][r] = ok ? sc[t][r] : -__builtin_inff(); mx = fmaxf(mx, sc[t][r]); }
        mx = fmaxf(mx, __shfl_xor(mx, 16)); mx = fmaxf(mx, __shfl_xor(mx, 32));
        const float mn = fmaxf(st.m, mx), alpha = __builtin_amdgcn_exp2f(st.m - mn);
        float ps = 0.f; float p[8];
#pragma unroll
        for (int t = 0; t < 2; ++t)
#pragma unroll
            for (int r = 0; r < 4; ++r) { p[4 * t + r] = __builtin_amdgcn_exp2f(sc[t][r] - mn); ps += p[4 * t + r]; }
        st.l = st.l * alpha + ps; st.m = mn;
#pragma unroll
        for (int dt = 0; dt < 8; ++dt) st.O[dt] *= alpha;
        v4u pw; pw.x = pk2(p[0], p[1]); pw.y = pk2(p[2], p[3]); pw.z = pk2(p[4], p[5]); pw.w = pk2(p[6], p[7]);
        const bf16x8 pf = __builtin_bit_cast(bf16x8, pw);
#pragma unroll
        for (int dt = 0; dt < 8; ++dt) {
            const unsigned q = (lane & 15) >> 2, pp = lane & 3;
            const unsigned a0 = off_b(8 * g + q, 2 * dt + (pp >> 1)) + 8 * (pp & 1), a1 = off_b(8 * g + 4 + q, 2 * dt + (pp >> 1)) + 8 * (pp & 1);
            const s16x4 lo = __builtin_bit_cast(s16x4, __builtin_amdgcn_ds_read_tr16_b64_v4i16((LAS s16x4*)(vl + a0)));
            const s16x4 hi = __builtin_bit_cast(s16x4, __builtin_amdgcn_ds_read_tr16_b64_v4i16((LAS s16x4*)(vl + a1)));
            const bf16x8 vf = __builtin_shufflevector(lo, hi, 0, 1, 2, 3, 4, 5, 6, 7);
            st.O[dt] = __builtin_amdgcn_mfma_f32_16x16x32_bf16(vf, pf, st.O[dt], 0, 0, 0);
        }
    }
}

__device__ __forceinline__ void attn_phase(Frame& F, const Ptrs& P) {
    const bf16* QKV = (const bf16*)(P.ws + WS_QKV); bf16* YAB = (bf16*)(P.ws + WS_AB1);
    LAS unsigned char* vl = F.lds + RING_OFF + F.wave * 16384;
    const int gw = F.vcu * NWAVES + F.wave, NGW = F.G * NWAVES, lane = F.lane, i = lane & 15, g = lane >> 4;
    { constexpr int NT = (M / 256) * 8 * 16; const int chunk = (NT + NGW - 1) / NGW;
      for (int id = gw * chunk; id < NT && id < (gw + 1) * chunk; ++id) {
          const int r16 = id & 15, h = (id >> 4) & 7, rb = id >> 7;
          const int row_blk = rb * 256; const int seq0 = row_blk < 4096 ? 0 : (row_blk < 8192 ? 4096 : 8192); const int S = row_blk < 8192 ? 4096 : 16384;
          const int t0 = row_blk - seq0 + r16; const int tq = t0 + 16 * i;
          AttState st; st.m = -1e30f; st.l = 0.f;
#pragma unroll
          for (int dt = 0; dt < 8; ++dt) st.O[dt] = (f32x4){0.f, 0.f, 0.f, 0.f};
          const bf16* seqbase = QKV + (size_t)seq0 * QKVW;
#pragma unroll 1
          for (int grp = 0; grp < 3; ++grp) {
              const int dil = grp == 0 ? 1 : (grp == 1 ? 4 : 16); const int ntiles = grp == 0 ? 12 : (grp == 1 ? 6 : 5);
              const int hc = grp * 1024 + h * 128;
              bf16x8 qf[4]; { const bf16* qp = seqbase + (size_t)tq * QKVW + hc + 32 * g;
#pragma unroll
                  for (int s = 0; s < 4; ++s) qf[s] = *(const bf16x8*)(qp + 8 * s); }
              attn_keys(st, qf, seqbase + 3072 + hc, seqbase + 6144 + hc, S, tq, t0 - 64 * dil, dil, ntiles, 64 * dil, vl, lane);
          }
          float l = st.l; l += __shfl_xor(l, 16); l += __shfl_xor(l, 32); const float rl = 1.0f / l;
          bf16* op = YAB + (size_t)(seq0 + tq) * YABW + h * 128 + 4 * g;
#pragma unroll
          for (int dt = 0; dt < 8; ++dt) { const f32x4 o = st.O[dt] * rl; v2u w; w.x = pk2(o[0], o[1]); w.y = pk2(o[2], o[3]); *(v2u*)(op + 16 * dt) = w; }
      } }
    { constexpr int NT = (M / 16) * 16; const int chunk = (NT + NGW - 1) / NGW;
      for (int id = gw * chunk; id < NT && id < (gw + 1) * chunk; ++id) {
          const int qh = id & 15, blk = id >> 4; const int row0 = blk * 16;
          const int seq0 = row0 < 4096 ? 0 : (row0 < 8192 ? 4096 : 8192); const int S = row0 < 8192 ? 4096 : 16384;
          const int t0 = row0 - seq0; const int tq = t0 + i;
          AttState st; st.m = -1e30f; st.l = 0.f;
#pragma unroll
          for (int dt = 0; dt < 8; ++dt) st.O[dt] = (f32x4){0.f, 0.f, 0.f, 0.f};
          const bf16* seqbase = QKV + (size_t)seq0 * QKVW; const int kvh = qh >> 2;
          bf16x8 qf[4]; { const bf16* qp = seqbase + (size_t)tq * QKVW + 9216 + qh * 128 + 32 * g;
#pragma unroll
              for (int s = 0; s < 4; ++s) qf[s] = *(const bf16x8*)(qp + 8 * s); }
          attn_keys(st, qf, seqbase + 11264 + kvh * 128, seqbase + 11776 + kvh * 128, S, tq, t0 - 128, 1, 9, 128, vl, lane);
          float l = st.l; l += __shfl_xor(l, 16); l += __shfl_xor(l, 32);
          const float sk = P.sink[qh] * 1.4426950408889634f; const float m2 = fmaxf(st.m, sk); const float e1 = __builtin_amdgcn_exp2f(st.m - m2);
          const float den = l * e1 + __builtin_amdgcn_exp2f(sk - m2); const float rl = e1 / den;
          bf16* op = YAB + (size_t)(seq0 + tq) * YABW + 1024 + qh * 128 + 4 * g;
#pragma unroll
          for (int dt = 0; dt < 8; ++dt) { const f32x4 o = st.O[dt] * rl; v2u w; w.x = pk2(o[0], o[1]); w.y = pk2(o[2], o[3]); *(v2u*)(op + 16 * dt) = w; }
      } }
}

__device__ __forceinline__ void final_norm(Frame& F, const Ptrs& P) {
    const int gw = F.vcu * NWAVES + F.wave, NGW = F.G * NWAVES; const float* ss3 = (const float*)(F.ctl + CW_SS3);
    f32x4 gv[16];
#pragma unroll
    for (int j = 0; j < 16; ++j) gv[j] = ((const f32x4*)P.gfin)[F.lane + 64 * j];
    for (int m = gw; m < M; m += NGW) { const float rs = __builtin_amdgcn_rsqf(ss3[m] * (1.0f / 4096.0f) + 1e-6f); GAS f32x4* o = (GAS f32x4*)(P.out + (size_t)m * D) + F.lane;
#pragma unroll
        for (int j = 0; j < 16; ++j) { const f32x4 v = o[64 * j]; o[64 * j] = v * rs * gv[j]; } }
}

struct Args { const float* in[17]; float* out; unsigned char* ws; int ph_lo, ph_hi, li, pad; };
__global__ void __launch_bounds__(NWAVES * 64, 2) mk_fwd(Args args) {
    extern __shared__ __attribute__((aligned(16))) unsigned char lds[];
    Frame F;
    F.lds = (LAS unsigned char*)lds;
    F.MISC = (volatile LAS unsigned*)(F.lds + MISC_OFF);
    F.tid = threadIdx.x; F.lane = F.tid & 63; F.wave = __builtin_amdgcn_readfirstlane(F.tid >> 6);
    F.G = gridDim.x; { const int bx = blockIdx.x; F.vcu = (F.G % 8 == 0) ? (bx % 8) * (F.G / 8) + bx / 8 : bx; }
    unsigned char* ws = args.ws;
    F.ctl = (gu32*)(ws + WS_CTL);
    Ptrs P;
    P.xp = args.in[0]; P.xs = args.in[1]; P.g1 = args.in[2]; P.w1g = args.in[3]; P.w1u = args.in[4]; P.w1d = args.in[5]; P.gmix = args.in[6]; P.win = args.in[7]; P.sink = args.in[8];
    P.wa = args.in[9]; P.wb = args.in[10]; P.wout = args.in[11]; P.g2 = args.in[12]; P.w2g = args.in[13]; P.w2u = args.in[14]; P.w2d = args.in[15]; P.gfin = args.in[16];
    P.out = args.out; P.ws = ws;
    for (int u = F.tid; u < (LDS_BYTES - LDSCTL_OFF) / 4; u += NWAVES * 64) ((LAS unsigned*)(F.lds + LDSCTL_OFF))[u] = 0u;
    __syncthreads();
    XcdBarrier bar; bar.bar = (unsigned*)(F.ctl + CW_BAR); bar.x = 0; bar.st = nullptr;
    if (N_LAUNCHES != PER_PHASE) bar = xcd_barrier_post((unsigned*)(F.ctl + CW_BAR), F.MISC + 8);
#define GRID_BAR(seam) do { if (N_LAUNCHES != PER_PHASE) xcd_barrier(bar); } while (0)
    const int lo = args.ph_lo, hi = args.ph_hi;
#define IN(k) (lo <= (k) && (k) < hi)
#define BOTH(k) (IN(k) && IN((k) + 1))
    bf16* AB1 = (bf16*)(ws + WS_AB1); bf16* ACT = (bf16*)(ws + WS_ACT); bf16* QKVB = (bf16*)(ws + WS_QKV);
    bf16* WGU = (bf16*)(ws + WS_WGU); bf16* WDN = (bf16*)(ws + WS_WD); bf16* WIN = (bf16*)(ws + WS_WIN); bf16* WAB = (bf16*)(ws + WS_WAB); bf16* WOUT = (bf16*)(ws + WS_WOUT);
    float* ss0 = (float*)(ws + WS_SS0); float* ss1 = (float*)(F.ctl + CW_SS1); float* ss2 = (float*)(F.ctl + CW_SS2); float* ss3 = (float*)(F.ctl + CW_SS3);
    const float* rope = (const float*)(ws + WS_ROPE);

    if (IN(0)) { p0_prologue(F, P); if (BOTH(0)) GRID_BAR(0); }
    if (IN(1)) { pg8::Gemm g{AB1, WGU, M, 2 * FF, D}; pg8::StaticOrder S; S.init(M, 2 * FF, F.G, (int)blockIdx.x);
        pg8::EpiSwiglu E{ACT, FF, ss0};
        pg8::gemm_phase<pg8::EpiSwiglu, pg8::StaticOrder, PG8_ALIGN, PG8_SP2>(F.lds + RING_OFF, g, S, E);
        if (BOTH(1)) GRID_BAR(1); }
    if (IN(2)) { pg8::Gemm g{ACT, WDN, M, D, FF}; pg8::StaticOrder S; S.init(M, D, F.G, (int)blockIdx.x);
        pg8::EpiResid<true> E{P.xp, P.xs, M_P, P.out, AB1, ss1, 0.5f};
        pg8::gemm_phase<pg8::EpiResid<true>, pg8::StaticOrder, PG8_ALIGN, PG8_SP2>(F.lds + RING_OFF, g, S, E);
        if (BOTH(2)) GRID_BAR(2); }
    if (IN(3)) { pg8::Gemm g{AB1, WIN, M, NIN, D}; pg8::StaticOrder S; S.init(M, NIN, F.G, (int)blockIdx.x);
        pg8::EpiProj E{QKVB, ACT, ss1, rope};
        pg8::gemm_phase<pg8::EpiProj, pg8::StaticOrder, PG8_ALIGN, PG8_SP2>(F.lds + RING_OFF, g, S, E);
        if (BOTH(3)) GRID_BAR(3); }
    if (IN(4)) { attn_phase(F, P); p4_convert_w2(F, P); if (BOTH(4)) GRID_BAR(4); }
    if (IN(5)) { pg8::Gemm g{AB1, WAB, M, D, YABW}; pg8::StaticOrder S; S.init(M, D, F.G, (int)blockIdx.x);
        pg8::EpiMerge E{ACT, QKVB};
        pg8::gemm_phase<pg8::EpiMerge, pg8::StaticOrder, PG8_ALIGN, PG8_SP2>(F.lds + RING_OFF, g, S, E);
        if (BOTH(5)) GRID_BAR(5); }
    if (IN(6)) { pg8::Gemm g{QKVB, WOUT, M, D, D}; pg8::StaticOrder S; S.init(M, D, F.G, (int)blockIdx.x);
        pg8::EpiResid<true> E{P.out, P.out, M, P.out, AB1, ss2, 1.0f};
        pg8::gemm_phase<pg8::EpiResid<true>, pg8::StaticOrder, PG8_ALIGN, PG8_SP2>(F.lds + RING_OFF, g, S, E);
        if (BOTH(6)) GRID_BAR(6); }
    if (IN(7)) { pg8::Gemm g{AB1, WGU, M, 2 * FF, D}; pg8::StaticOrder S; S.init(M, 2 * FF, F.G, (int)blockIdx.x);
        pg8::EpiSwiglu E{ACT, FF, ss2};
        pg8::gemm_phase<pg8::EpiSwiglu, pg8::StaticOrder, PG8_ALIGN, PG8_SP2>(F.lds + RING_OFF, g, S, E);
        if (BOTH(7)) GRID_BAR(7); }
    if (IN(8)) { pg8::Gemm g{ACT, WDN, M, D, FF}; pg8::StaticOrder S; S.init(M, D, F.G, (int)blockIdx.x);
        pg8::EpiResid<false> E{P.out, P.out, M, P.out, nullptr, ss3, 0.5f};
        pg8::gemm_phase<pg8::EpiResid<false>, pg8::StaticOrder, PG8_ALIGN, PG8_SP2>(F.lds + RING_OFF, g, S, E);
        if (BOTH(8)) GRID_BAR(8); }
    if (IN(9)) { final_norm(F, P); }
#undef IN
#undef BOTH
#undef GRID_BAR
}

extern "C" void kernel_launch(void* const* d_in, const int* in_sizes, int n_in, void* d_out, int out_size, void* d_ws, size_t ws_size, hipStream_t stream) {
    static int grid = 0;
    if (grid == 0) {
        if (n_in != 17 || out_size != M * D || ws_size < WS_END) { fprintf(stderr, "kernel_launch: unexpected shapes (n_in %d, out %d, ws %zu, need %zu)\n", n_in, out_size, ws_size, (size_t)WS_END); grid = -1; return; }
        int dev = 0, cus = 0, per_cu = 0;
        if (hipGetDevice(&dev) != hipSuccess || hipDeviceGetAttribute(&cus, hipDeviceAttributeMultiprocessorCount, dev) != hipSuccess) { grid = -1; return; }
        if (hipFuncSetAttribute((const void*)mk_fwd, hipFuncAttributeMaxDynamicSharedMemorySize, LDS_BYTES) != hipSuccess) { fprintf(stderr, "kernel_launch: hipFuncSetAttribute failed\n"); grid = -1; return; }
        if (hipOccupancyMaxActiveBlocksPerMultiprocessor(&per_cu, (const void*)mk_fwd, NWAVES * 64, LDS_BYTES) != hipSuccess || per_cu < 1) { fprintf(stderr, "kernel_launch: occupancy query says %d\n", per_cu); }
        (void)hipGetLastError();
        grid = cus;
    }
    if (grid < 0) return;
    (void)hipMemsetAsync((char*)d_ws + WS_CTL, 0, CTL_ZERO_BYTES, stream);
    Args a{};
    for (int i = 0; i < 17; ++i) a.in[i] = (const float*)d_in[i];
    a.out = (float*)d_out; a.ws = (unsigned char*)d_ws; a.pad = 0;
    for (int li = 0; li < N_LAUNCHES; ++li) {
        a.ph_lo = (N_LAUNCHES == PER_PHASE) ? li : 0; a.ph_hi = (N_LAUNCHES == PER_PHASE) ? li + 1 : PER_PHASE; a.li = li;
        hipLaunchKernelGGL(mk_fwd, dim3(grid), dim3(NWAVES * 64), LDS_BYTES, stream, a);
    }
}
```

```cpp
#include <hip/hip_runtime.h>
#include <cstdio>
#include <cstdint>

#ifndef MK_N_LAUNCHES
#define MK_N_LAUNCHES 1
#endif

namespace pg8 {
#define PG8_LAS __attribute__((address_space(3)))
typedef unsigned short bf16_t;
typedef short bf16x8 __attribute__((ext_vector_type(8)));
typedef float f32x4 __attribute__((ext_vector_type(4)));
typedef unsigned u32x4 __attribute__((ext_vector_type(4)));
constexpr int BM = 256, BK = 64, HALF = 128, HTB = HALF * BK * 2, STAGE_BYTES = 8 * HTB, NXCD = 8, WGM = 8;

__host__ __device__ __forceinline__ int lds_byte(int r, int c) { const int st = (r >> 4) * 2 + (c >> 5), rr = r & 15, cc = c & 31, ob = rr * 64 + cc * 2; return st * 1024 + (ob ^ (((ob >> 9) & 1) << 5)); }
__host__ __device__ __forceinline__ void stage_rc(int b, int& R, int& C) { const int st = b / 1024, sb = b % 1024, swz = sb ^ (((sb >> 9) & 1) << 5); R = (st >> 1) * 16 + swz / 64; C = (st & 1) * 32 + (swz % 64) / 2; }
__host__ __device__ __forceinline__ int perm32(int rho) { const int n = rho >> 4, i = rho & 15; return 8 * (i >> 2) + 4 * n + (i & 3); }

struct Unit { int pm, pn; };
struct Gemm { const bf16_t* A; const bf16_t* Bt; int M, N, K; };

struct StaticOrder {
    int nM, nN, nwg, G, c;
    __host__ __device__ void init(int M, int N, int G_, int c_) { nM = M / BM; nN = N / BM; nwg = nM * nN; G = G_; c = c_; }
    __host__ __device__ bool next(int i, Unit& u) const {
        const long L = (long)i * G + c; if (L >= nwg) return false;
        int wgid = (int)L; { const int q = nwg / NXCD, r = nwg % NXCD, xcd = wgid % NXCD, off = wgid / NXCD; wgid = (xcd < r ? xcd * (q + 1) : r * (q + 1) + (xcd - r) * q) + off; }
        const int nig = WGM * nN, gid = wgid / nig, fm = gid * WGM, gsz = (nM - fm) < WGM ? (nM - fm) : WGM;
        u.pm = fm + ((wgid % nig) % gsz); u.pn = (wgid % nig) / gsz; return true;
    }
    __device__ __forceinline__ void a_ready(const Unit&) const {}
    __device__ __forceinline__ void done(const Unit&) const {}
};

__device__ __forceinline__ unsigned cvt_pk_bf16(float lo, float hi) { unsigned r; asm volatile("v_cvt_pk_bf16_f32 %0, %1, %2" : "=v"(r) : "v"(lo), "v"(hi)); return r; }
__device__ __forceinline__ float bf_lo(unsigned w) { return __uint_as_float(w << 16); }
__device__ __forceinline__ float bf_hi(unsigned w) { return __uint_as_float(w & 0xffff0000u); }
__device__ __forceinline__ float sigmoid_f(float x) { return __builtin_amdgcn_rcpf(1.0f + __builtin_amdgcn_exp2f(-1.44269504089f * x)); }


struct EpiSwiglu {
    static constexpr bool PERM = true, AFTER_DRAIN = false, HAS_MID = false; static constexpr int MID_T = 0;
    bf16_t* O; int ldc; const float* ss;
    __device__ __forceinline__ void mid(f32x4 (&)[2][2][4][2], const Unit&, int, int, int, int) const {}
    __device__ __forceinline__ void operator()(const f32x4 (&acc)[2][2][4][2], const Unit& u, int wr, int wc, int fr, int fq) const {
        const int row0 = u.pm * BM + wr * 64 + fr, col0 = u.pn * HALF + wc * 32 + 8 * fq;
#pragma unroll
        for (int ai = 0; ai < 2; ++ai)
#pragma unroll
            for (int m = 0; m < 4; ++m) { const int r = row0 + ai * HALF + m * 16; const float rs = __builtin_amdgcn_rsqf(ss[r] * (1.0f / 4096.0f) + 1e-6f);
                float o[8];
#pragma unroll
                for (int n = 0; n < 2; ++n)
#pragma unroll
                    for (int j = 0; j < 4; ++j) { const float g = acc[ai][0][m][n][j] * rs, up = acc[ai][1][m][n][j] * rs; o[4 * n + j] = g * sigmoid_f(g) * up; }
                u32x4 w; w.x = cvt_pk_bf16(o[0], o[1]); w.y = cvt_pk_bf16(o[2], o[3]); w.z = cvt_pk_bf16(o[4], o[5]); w.w = cvt_pk_bf16(o[6], o[7]);
                *(u32x4*)(O + (size_t)r * ldc + col0) = w; }
    }
};

template <bool HAS_OB> struct EpiResid {
    static constexpr bool PERM = true, AFTER_DRAIN = false, HAS_MID = false; static constexpr int MID_T = 0;
    const float* base_lo; const float* base_hi; int split_row; float* out; bf16_t* ob; float* ss; float scale;
    __device__ __forceinline__ void mid(f32x4 (&)[2][2][4][2], const Unit&, int, int, int, int) const {}
    __device__ __forceinline__ void operator()(const f32x4 (&acc)[2][2][4][2], const Unit& u, int wr, int wc, int fr, int fq) const {
        const int row0 = u.pm * BM + wr * 64 + fr, col0 = u.pn * BM + wc * 32 + 8 * fq;
        const float* bb = (u.pm * BM < split_row) ? base_lo : base_hi - (size_t)split_row * 4096;
#pragma unroll
        for (int ai = 0; ai < 2; ++ai)
#pragma unroll
            for (int m = 0; m < 4; ++m) { const int r = row0 + ai * HALF + m * 16; const size_t off = (size_t)r * 4096 + col0; float sq = 0.f;
#pragma unroll
                for (int bj = 0; bj < 2; ++bj) { const f32x4 b0 = *(const f32x4*)(bb + off + bj * HALF), b1 = *(const f32x4*)(bb + off + bj * HALF + 4);
                    const f32x4 v0 = b0 + acc[ai][bj][m][0] * scale, v1 = b1 + acc[ai][bj][m][1] * scale;
                    *(f32x4*)(out + off + bj * HALF) = v0; *(f32x4*)(out + off + bj * HALF + 4) = v1;
                    sq += (v0[0] * v0[0] + v0[1] * v0[1]) + (v0[2] * v0[2] + v0[3] * v0[3]) + (v1[0] * v1[0] + v1[1] * v1[1]) + (v1[2] * v1[2] + v1[3] * v1[3]);
                    if (HAS_OB) { u32x4 w; w.x = cvt_pk_bf16(v0[0], v0[1]); w.y = cvt_pk_bf16(v0[2], v0[3]); w.z = cvt_pk_bf16(v1[0], v1[1]); w.w = cvt_pk_bf16(v1[2], v1[3]); *(u32x4*)(ob + off + bj * HALF) = w; } }
                sq += __shfl_xor(sq, 16); sq += __shfl_xor(sq, 32);
                if (fq == 0) __hip_atomic_fetch_add(ss + r, sq, __ATOMIC_RELAXED, __HIP_MEMORY_SCOPE_AGENT); }
    }
};

struct EpiProj {
    static constexpr bool PERM = true, AFTER_DRAIN = false, HAS_MID = false; static constexpr int MID_T = 0;
    bf16_t* qkv; bf16_t* gates; const float* ss; const float* rope;
    __device__ __forceinline__ void mid(f32x4 (&)[2][2][4][2], const Unit&, int, int, int, int) const {}
    __device__ __forceinline__ void operator()(const f32x4 (&acc)[2][2][4][2], const Unit& u, int wr, int wc, int fr, int fq) const {
        const int pn = u.pn; const bool is_gate = pn >= 48, is_rope = (pn < 24) || (pn >= 36 && pn < 46);
        const int row0 = u.pm * BM + wr * 64 + fr, cw = wc * 32 + 8 * fq;
        bf16_t* dst = is_gate ? gates + (pn - 48) * BM + cw : qkv + pn * BM + cw; const int ld = is_gate ? 8192 : 12288;
        const bool do_rope = is_rope && (wc == 0); const float sgn = fq < 2 ? -1.0f : 1.0f;
#pragma unroll
        for (int ai = 0; ai < 2; ++ai)
#pragma unroll
            for (int m = 0; m < 4; ++m) { const int r = row0 + ai * HALF + m * 16; const float rs = __builtin_amdgcn_rsqf(ss[r] * (1.0f / 4096.0f) + 1e-6f);
                const int pos = r < 8192 ? (r & 4095) : r - 8192;
                f32x4 c0 = {1.f, 1.f, 1.f, 1.f}, c1 = c0, s0 = {0.f, 0.f, 0.f, 0.f}, s1 = s0;
                if (do_rope) { const float* tp = rope + (size_t)pos * 32 + 8 * (fq & 1); c0 = *(const f32x4*)tp; c1 = *(const f32x4*)(tp + 4); s0 = *(const f32x4*)(tp + 16); s1 = *(const f32x4*)(tp + 20); }
#pragma unroll
                for (int bj = 0; bj < 2; ++bj) { f32x4 v0 = acc[ai][bj][m][0] * rs, v1 = acc[ai][bj][m][1] * rs;
                    if (do_rope) {
#pragma unroll
                        for (int j = 0; j < 4; ++j) { const float p0 = __shfl_xor(v0[j], 32), p1 = __shfl_xor(v1[j], 32); v0[j] = v0[j] * c0[j] + sgn * p0 * s0[j]; v1[j] = v1[j] * c1[j] + sgn * p1 * s1[j]; } }
                    if (is_gate) {
#pragma unroll
                        for (int j = 0; j < 4; ++j) { v0[j] = sigmoid_f(v0[j]); v1[j] = sigmoid_f(v1[j]); } }
                    u32x4 w; w.x = cvt_pk_bf16(v0[0], v0[1]); w.y = cvt_pk_bf16(v0[2], v0[3]); w.z = cvt_pk_bf16(v1[0], v1[1]); w.w = cvt_pk_bf16(v1[2], v1[3]);
                    *(u32x4*)(dst + (size_t)r * ld + bj * HALF) = w; } }
    }
};

struct EpiMerge {
    static constexpr bool PERM = true, AFTER_DRAIN = false, HAS_MID = true; static constexpr int MID_T = 16;
    const bf16_t* gates; bf16_t* O;
    __device__ __forceinline__ void mid(f32x4 (&acc)[2][2][4][2], const Unit& u, int wr, int wc, int fr, int fq) const {
        const int row0 = u.pm * BM + wr * 64 + fr, col0 = u.pn * BM + wc * 32 + 8 * fq;
#pragma unroll
        for (int ai = 0; ai < 2; ++ai)
#pragma unroll
            for (int m = 0; m < 4; ++m) { int r = row0 + ai * HALF + m * 16; asm volatile("" : "+v"(r));
                const bf16_t* gp = gates + (size_t)r * 8192 + col0;
#pragma unroll
                for (int bj = 0; bj < 2; ++bj) { const u32x4 a = *(const u32x4*)(gp + bj * HALF), b = *(const u32x4*)(gp + 4096 + bj * HALF);
                    f32x4 r0, r1;
                    r0[0] = bf_lo(a.x) * __builtin_amdgcn_rcpf(fmaxf(bf_lo(b.x), 1e-20f)); r0[1] = bf_hi(a.x) * __builtin_amdgcn_rcpf(fmaxf(bf_hi(b.x), 1e-20f));
                    r0[2] = bf_lo(a.y) * __builtin_amdgcn_rcpf(fmaxf(bf_lo(b.y), 1e-20f)); r0[3] = bf_hi(a.y) * __builtin_amdgcn_rcpf(fmaxf(bf_hi(b.y), 1e-20f));
                    r1[0] = bf_lo(a.z) * __builtin_amdgcn_rcpf(fmaxf(bf_lo(b.z), 1e-20f)); r1[1] = bf_hi(a.z) * __builtin_amdgcn_rcpf(fmaxf(bf_hi(b.z), 1e-20f));
                    r1[2] = bf_lo(a.w) * __builtin_amdgcn_rcpf(fmaxf(bf_lo(b.w), 1e-20f)); r1[3] = bf_hi(a.w) * __builtin_amdgcn_rcpf(fmaxf(bf_hi(b.w), 1e-20f));
                    acc[ai][bj][m][0] *= r0; acc[ai][bj][m][1] *= r1; }
                asm volatile("" ::: "memory"); }
    }
    __device__ __forceinline__ void operator()(const f32x4 (&acc)[2][2][4][2], const Unit& u, int wr, int wc, int fr, int fq) const {
        const int row0 = u.pm * BM + wr * 64 + fr, col0 = u.pn * BM + wc * 32 + 8 * fq;
#pragma unroll
        for (int ai = 0; ai < 2; ++ai)
#pragma unroll
            for (int m = 0; m < 4; ++m) { const int r = row0 + ai * HALF + m * 16; const bf16_t* gp = gates + (size_t)r * 8192 + 4096 + col0;
#pragma unroll
                for (int bj = 0; bj < 2; ++bj) { const u32x4 b = *(const u32x4*)(gp + bj * HALF); const f32x4 a0 = acc[ai][bj][m][0], a1 = acc[ai][bj][m][1];
                    u32x4 w;
                    w.x = cvt_pk_bf16(a0[0] * fmaxf(bf_lo(b.x), 1e-20f), a0[1] * fmaxf(bf_hi(b.x), 1e-20f)); w.y = cvt_pk_bf16(a0[2] * fmaxf(bf_lo(b.y), 1e-20f), a0[3] * fmaxf(bf_hi(b.y), 1e-20f));
                    w.z = cvt_pk_bf16(a1[0] * fmaxf(bf_lo(b.z), 1e-20f), a1[1] * fmaxf(bf_hi(b.z), 1e-20f)); w.w = cvt_pk_bf16(a1[2] * fmaxf(bf_lo(b.w), 1e-20f), a1[3] * fmaxf(bf_hi(b.w), 1e-20f));
                    *(u32x4*)(O + (size_t)r * 4096 + col0 + bj * HALF) = w; } }
    }
};

template <class Epi, class Sched, bool ALIGN_EPI = false, bool SP2 = false>
__device__ __forceinline__ void gemm_phase(PG8_LAS unsigned char* lds, const Gemm g, const Sched& S, const Epi& E) {
    const int tid = threadIdx.x, wid = __builtin_amdgcn_readfirstlane(tid >> 6), lane = tid & 63, wr = wid >> 2, wc = wid & 3, fr = lane & 15, fq = lane >> 4;
    const int K = g.K, nt = K / BK;
    unsigned voffA[2], voffB[2];
#pragma unroll
    for (int i = 0; i < 2; ++i) { int R, C; stage_rc(tid * 16 + i * 8192, R, C); const int Rb = Epi::PERM ? ((R & ~31) + perm32(R & 31)) : R;
        voffA[i] = (unsigned)(R * K + C) * 2u; voffB[i] = (unsigned)(Rb * K + C) * 2u; }
    const size_t kstep = (size_t)(BK * 2);
    const size_t hstep = (size_t)HALF * K * 2;
    const size_t tstep = 2 * hstep;
    const unsigned ldsw = (unsigned)wid * 1024u;
    const int aoff = lds_byte(wr * 64 + fr, fq * 8), boff = lds_byte(wc * 32 + fr, fq * 8);
#define PG8_SA(b, h) (((b) * 2 + (h)) * HTB)
#define PG8_SB(b, h) ((4 + (b) * 2 + (h)) * HTB)
#define PG8_STAGE(bufoff, gbase, voff) do { _Pragma("unroll") for (int _i = 0; _i < 2; ++_i) \
        __builtin_amdgcn_global_load_lds((const unsigned*)((const char*)(gbase) + (voff)[_i]), (PG8_LAS unsigned*)(lds + (bufoff) + ldsw + _i * 8192), 16, 0, 0); } while (0)
#define PG8_LDA(dst, b, h) do { _Pragma("unroll") for (int m = 0; m < 4; ++m) _Pragma("unroll") for (int k = 0; k < 2; ++k) dst[m][k] = *(const PG8_LAS bf16x8*)(lds + PG8_SA(b, h) + aoff + m * 2048 + k * 1024); } while (0)
#define PG8_LDB(dst, b, h) do { _Pragma("unroll") for (int n = 0; n < 2; ++n) _Pragma("unroll") for (int k = 0; k < 2; ++k) dst[n][k] = *(const PG8_LAS bf16x8*)(lds + PG8_SB(b, h) + boff + n * 2048 + k * 1024); } while (0)
#define PG8_MMA(ai, bj, At, Bt) do { __builtin_amdgcn_s_setprio(1); _Pragma("unroll") for (int m = 0; m < 4; ++m) _Pragma("unroll") for (int n = 0; n < 2; ++n) _Pragma("unroll") for (int k = 0; k < 2; ++k) \
        acc[ai][bj][m][n] = __builtin_amdgcn_mfma_f32_16x16x32_bf16(Bt[n][k], At[m][k], acc[ai][bj][m][n], 0, 0, 0); __builtin_amdgcn_s_setprio(0); } while (0)
#define PG8_WAIT_V(n) asm volatile("s_waitcnt vmcnt(" #n ")" ::: "memory")
#define PG8_WAIT_L(n) asm volatile("s_waitcnt lgkmcnt(" #n ")" ::: "memory")
#define PG8_BAR __builtin_amdgcn_s_barrier()
#define PG8_SCHED __builtin_amdgcn_sched_barrier(0)
    Unit cur, nxt; int ui = 0;
    if (!S.next(0, cur)) return;
    f32x4 acc[2][2][4][2];
#pragma unroll
    for (int a = 0; a < 2; ++a)
#pragma unroll
        for (int b = 0; b < 2; ++b)
#pragma unroll
            for (int m = 0; m < 4; ++m)
#pragma unroll
                for (int n = 0; n < 2; ++n) acc[a][b][m][n] = (f32x4){0.f, 0.f, 0.f, 0.f};
    bf16x8 At[4][2], B0[2][2], B1[2][2];
    const char* cA = (const char*)g.A + (size_t)cur.pm * tstep; const char* cB = (const char*)g.Bt + (size_t)cur.pn * tstep;
    S.a_ready(cur);
    if constexpr (SP2) {
        PG8_STAGE(PG8_SB(0, 0), cB, voffB); PG8_STAGE(PG8_SB(0, 1), cB + hstep, voffB); PG8_STAGE(PG8_SA(0, 0), cA, voffA); PG8_STAGE(PG8_SA(0, 1), cA + hstep, voffA);
        if (wr == 1) PG8_BAR;
        PG8_WAIT_V(2); PG8_BAR;
        PG8_STAGE(PG8_SB(1, 0), cB + kstep, voffB); PG8_STAGE(PG8_SA(1, 0), cA + kstep, voffA); PG8_STAGE(PG8_SB(1, 1), cB + hstep + kstep, voffB);
        PG8_WAIT_V(6); PG8_BAR;
    } else {
        PG8_STAGE(PG8_SB(0, 0), cB, voffB); PG8_STAGE(PG8_SA(0, 0), cA, voffA); PG8_STAGE(PG8_SB(0, 1), cB + hstep, voffB); PG8_STAGE(PG8_SA(0, 1), cA + hstep, voffA);
        if (wr == 1) PG8_BAR;
        PG8_WAIT_V(4); PG8_BAR;
        PG8_STAGE(PG8_SB(1, 0), cB + kstep, voffB); PG8_STAGE(PG8_SA(1, 0), cA + kstep, voffA); PG8_STAGE(PG8_SB(1, 1), cB + hstep + kstep, voffB);
        PG8_WAIT_V(6); PG8_BAR;
    }
    for (;;) {
        const bool has_next = S.next(ui + 1, nxt);
        const char* nA = has_next ? (const char*)g.A + (size_t)nxt.pm * tstep : cA; const char* nB = has_next ? (const char*)g.Bt + (size_t)nxt.pn * tstep : cB;
        for (int t = 0; t < nt; t += 2) {
            const bool last = (t == nt - 2);
            const char* a1 = cA + (size_t)(t + 1) * kstep;
            const char* a2 = last ? nA : cA + (size_t)(t + 2) * kstep; const char* b2 = last ? nB : cB + (size_t)(t + 2) * kstep;
            const char* a3 = a2 + kstep; const char* b3 = b2 + kstep;
            if (last && has_next) S.a_ready(nxt);
            if constexpr (Epi::HAS_MID) { if (t == Epi::MID_T) E.mid(acc, cur, wr, wc, fr, fq); }
            if constexpr (SP2) {
            PG8_LDB(B0, 0, 0); PG8_LDB(B1, 0, 1); PG8_SCHED; PG8_LDA(At, 0, 0); PG8_STAGE(PG8_SA(1, 1), a1 + hstep, voffA);
            PG8_WAIT_V(8); PG8_WAIT_L(0); PG8_BAR; PG8_MMA(0, 0, At, B0); PG8_MMA(0, 1, At, B1); PG8_BAR; PG8_SCHED;
            PG8_LDA(At, 0, 1); PG8_STAGE(PG8_SB(0, 0), b2, voffB); PG8_STAGE(PG8_SB(0, 1), b2 + hstep, voffB); PG8_STAGE(PG8_SA(0, 0), a2, voffA);
            PG8_WAIT_V(8); PG8_WAIT_L(0); PG8_BAR; PG8_MMA(1, 0, At, B0); PG8_MMA(1, 1, At, B1); PG8_BAR; PG8_SCHED;
            PG8_LDB(B0, 1, 0); PG8_LDB(B1, 1, 1); PG8_SCHED; PG8_LDA(At, 1, 0); PG8_STAGE(PG8_SA(0, 1), a2 + hstep, voffA);
            PG8_WAIT_V(8); PG8_WAIT_L(0); PG8_BAR; PG8_MMA(0, 0, At, B0); PG8_MMA(0, 1, At, B1); PG8_BAR; PG8_SCHED;
            PG8_LDA(At, 1, 1); PG8_STAGE(PG8_SB(1, 0), b3, voffB); PG8_STAGE(PG8_SB(1, 1), b3 + hstep, voffB); PG8_STAGE(PG8_SA(1, 0), a3, voffA);
            PG8_WAIT_V(8); PG8_WAIT_L(0); PG8_BAR; PG8_MMA(1, 0, At, B0); PG8_MMA(1, 1, At, B1); PG8_BAR; PG8_SCHED;
            } else {
            PG8_LDB(B0, 0, 0); PG8_SCHED; PG8_LDA(At, 0, 0); PG8_STAGE(PG8_SA(1, 1), a1 + hstep, voffA);
            PG8_WAIT_L(8); PG8_BAR; PG8_WAIT_L(0); PG8_MMA(0, 0, At, B0); PG8_BAR; PG8_SCHED;
            PG8_LDB(B1, 0, 1); PG8_STAGE(PG8_SB(0, 0), b2, voffB);
            PG8_BAR; PG8_WAIT_L(0); PG8_MMA(0, 1, At, B1); PG8_BAR;
            PG8_LDA(At, 0, 1); PG8_STAGE(PG8_SA(0, 0), a2, voffA);
            PG8_BAR; PG8_WAIT_L(0); PG8_MMA(1, 0, At, B0); PG8_BAR; PG8_SCHED;
            PG8_STAGE(PG8_SB(0, 1), b2 + hstep, voffB);
            PG8_WAIT_V(6); PG8_BAR; PG8_MMA(1, 1, At, B1); PG8_BAR;
            PG8_LDB(B0, 1, 0); PG8_SCHED; PG8_LDA(At, 1, 0); PG8_STAGE(PG8_SA(0, 1), a2 + hstep, voffA);
            PG8_WAIT_L(8); PG8_BAR; PG8_WAIT_L(0); PG8_MMA(0, 0, At, B0); PG8_BAR; PG8_SCHED;
            PG8_LDB(B1, 1, 1); PG8_STAGE(PG8_SB(1, 0), b3, voffB);
            PG8_BAR; PG8_WAIT_L(0); PG8_MMA(0, 1, At, B1); PG8_BAR;
            PG8_LDA(At, 1, 1); PG8_STAGE(PG8_SA(1, 0), a3, voffA);
            PG8_BAR; PG8_WAIT_L(0); PG8_MMA(1, 0, At, B0); PG8_BAR; PG8_SCHED;
            PG8_STAGE(PG8_SB(1, 1), b3 + hstep, voffB);
            PG8_WAIT_V(6); PG8_BAR; PG8_MMA(1, 1, At, B1); PG8_BAR;
            }
        }
        if constexpr (ALIGN_EPI) { if (wr == 0) PG8_BAR; }
        if constexpr (!Epi::AFTER_DRAIN) { E(acc, cur, wr, wc, fr, fq); S.done(cur); }
        if (!has_next) break;
#pragma unroll
        for (int a = 0; a < 2; ++a)
#pragma unroll
            for (int b = 0; b < 2; ++b)
#pragma unroll
                for (int m = 0; m < 4; ++m)
#pragma unroll
                    for (int n = 0; n < 2; ++n) acc[a][b][m][n] = (f32x4){0.f, 0.f, 0.f, 0.f};
        cur = nxt; cA = nA; cB = nB; ++ui;
        if constexpr (ALIGN_EPI) { if (wr == 1) PG8_BAR; }
    }
    PG8_WAIT_V(0);
    if constexpr (!ALIGN_EPI) { if (wr == 0) PG8_BAR; }
    PG8_BAR;
#undef PG8_SA
#undef PG8_SB
#undef PG8_STAGE
#undef PG8_LDA
#undef PG8_LDB
#undef PG8_MMA
#undef PG8_WAIT_V
#undef PG8_WAIT_L
#undef PG8_BAR
#undef PG8_SCHED
}
}

#ifndef PG8_SP2
#define PG8_SP2 true
#endif
#ifndef PG8_ALIGN
#define PG8_ALIGN true
#endif

constexpr int NWAVES = 8;
constexpr int N_LAUNCHES = MK_N_LAUNCHES;
constexpr int PER_PHASE = 10;
constexpr int D = 4096, FF = 11008, NIN = 20480, QKVW = 12288, GATEW = 8192, YABW = 3072;
constexpr int M_P = 8192, M_S = 16384, M = M_P + M_S;
constexpr float QSCALE = 0.08838834764831845f * 1.4426950408889634f;

constexpr size_t MiB = 1u << 20;
constexpr size_t WS_CTL = 0, CTL_ZERO_BYTES = 1 * MiB;
constexpr size_t WS_SS0 = 1 * MiB;
constexpr size_t WS_ROPE = 2 * MiB;
constexpr size_t WS_WIN = 4 * MiB;
constexpr size_t WS_WAB = WS_WIN + (size_t)NIN * D * 2;
constexpr size_t WS_WOUT = WS_WAB + (size_t)D * YABW * 2;
constexpr size_t WS_WGU = WS_WOUT + (size_t)D * D * 2;
constexpr size_t WS_WD = WS_WGU + (size_t)2 * FF * D * 2;
constexpr size_t WS_AB1 = WS_WD + (size_t)D * FF * 2;
constexpr size_t WS_ACT = WS_AB1 + (size_t)M * D * 2;
constexpr size_t WS_QKV = WS_ACT + (size_t)M * FF * 2;
constexpr size_t WS_END = WS_QKV + (size_t)M * QKVW * 2;
constexpr int CW_BAR = 4096;
constexpr int CW_SS1 = 16384, CW_SS2 = CW_SS1 + M, CW_SS3 = CW_SS2 + M;
static_assert((size_t)(CW_SS3 + M) * 4 <= CTL_ZERO_BYTES, "CTL words inside the memset region");
static_assert(WS_SS0 + (size_t)M * 4 <= WS_ROPE && WS_ROPE + (size_t)16384 * 32 * 4 <= WS_WIN, "ws map");

constexpr int RING_OFF = 0, RING_BYTES = 131072;
constexpr int LDSCTL_OFF = RING_BYTES, MISC_OFF = LDSCTL_OFF + 320;
constexpr int LDS_BYTES = 147456;

#define GAS __attribute__((address_space(1)))
#define LAS __attribute__((address_space(3)))
typedef unsigned short bf16;
typedef unsigned v4u __attribute__((ext_vector_type(4)));
typedef unsigned v2u __attribute__((ext_vector_type(2)));
typedef float f32x4 __attribute__((ext_vector_type(4)));
typedef short bf16x8 __attribute__((ext_vector_type(8)));
typedef short s16x4 __attribute__((ext_vector_type(4)));
typedef GAS unsigned gu32;
#define RLX_AGENT __ATOMIC_RELAXED, __HIP_MEMORY_SCOPE_AGENT
#define LDS_WAIT() asm volatile("s_waitcnt lgkmcnt(0)" ::: "memory")
#define VM_WAIT() asm volatile("s_waitcnt vmcnt(0)" ::: "memory")
__device__ __forceinline__ unsigned pk2(float lo, float hi) { return pg8::cvt_pk_bf16(lo, hi); }

#define XB_TMO      128
#define XB_XCNT(j)  (256  + 64 * (j))
#define XB_XSUB(j)  (1280 + 64 * (j))
#define XB_XGEN(j)  (2304 + 64 * (j))
#define XB_TOP      3328
#define XB_TOPGEN   3392
#define XCD_BAR_WORDS 3456
#define XB_SPIN_CAP (1u << 18)

__device__ __forceinline__ unsigned xb_ld(unsigned* p)              { return __hip_atomic_load(p, __ATOMIC_RELAXED, __HIP_MEMORY_SCOPE_AGENT); }
__device__ __forceinline__ unsigned xb_add(unsigned* p, unsigned v) { return __hip_atomic_fetch_add(p, v, __ATOMIC_RELAXED, __HIP_MEMORY_SCOPE_AGENT); }
__device__ __forceinline__ unsigned xb_xcc_id() { return (unsigned)__builtin_amdgcn_s_getreg((3 << 11) | 20) & 0xFu; }
#define XB_SPIN(cond, bar) do { unsigned _sp = 0; while (cond) { __builtin_amdgcn_s_sleep(1); \
    if ((++_sp & 255u) == 0u) { if (xb_ld(&(bar)[XB_TMO])) break; if (_sp > XB_SPIN_CAP) { atomicAdd(&(bar)[XB_TMO], 1u); break; } } } } while (0)

struct XcdBarrier {
    unsigned* bar; unsigned x;
    volatile LAS unsigned* st;
};
__device__ __forceinline__ XcdBarrier xcd_barrier_post(unsigned* bar, volatile LAS unsigned* st) {
    XcdBarrier b; b.bar = bar; b.x = xb_xcc_id(); b.st = st;
    if (threadIdx.x == 0) (void)xb_add(&bar[XB_XCNT(b.x)], 1u);
    return b;
}
__device__ __forceinline__ void xcd_barrier_complete(unsigned* bar, unsigned x, unsigned& nloc, unsigned& nx) {
    const unsigned G = gridDim.x * gridDim.y * gridDim.z;
    unsigned sum, cnt, mine, sp = 0u;
    for (;;) {
        sum = 0u; cnt = 0u; mine = 0u;
#pragma unroll
        for (unsigned j = 0; j < 16; ++j) { const unsigned c = xb_ld(&bar[XB_XCNT(j)]); sum += c; cnt += (c > 0u) ? 1u : 0u; mine = (j == x) ? c : mine; }
        if (sum == G) break;
        __builtin_amdgcn_s_sleep(1);
        if ((++sp & 255u) == 0u) { if (xb_ld(&bar[XB_TMO])) break; if (sp > XB_SPIN_CAP) { atomicAdd(&bar[XB_TMO], 1u); break; } }
    }
    nloc = mine > 0u ? mine : 1u; nx = cnt > 0u ? cnt : 1u;
}
__device__ __forceinline__ void xcd_barrier(const XcdBarrier& b) {
    asm volatile("s_waitcnt vmcnt(0)" ::: "memory");
    __syncthreads();
    if (threadIdx.x == 0) {
        unsigned* bar = b.bar;
        __builtin_amdgcn_s_waitcnt(0);
        unsigned nloc = b.st[0], nx = b.st[1];
        if (nloc == 0u) { xcd_barrier_complete(bar, b.x, nloc, nx); b.st[0] = nloc; b.st[1] = nx; }
        const unsigned old = xb_add(&bar[XB_XSUB(b.x)], 1u);
        const unsigned gen = old / nloc;
        if (old + 1u == (gen + 1u) * nloc) {
            __builtin_amdgcn_fence(__ATOMIC_RELEASE, "agent");
            asm volatile("s_waitcnt vmcnt(0)" ::: "memory");
            const unsigned og = xb_add(&bar[XB_TOP], 1u);
            const unsigned tg = og / nx;
            if (og + 1u == (tg + 1u) * nx) xb_add(&bar[XB_TOPGEN], 1u);
            else XB_SPIN(xb_ld(&bar[XB_TOPGEN]) == tg, bar);
            __builtin_amdgcn_fence(__ATOMIC_ACQUIRE, "agent");
            xb_add(&bar[XB_XGEN(b.x)], 1u);
            asm volatile("s_waitcnt vmcnt(0)" ::: "memory");
        } else {
            XB_SPIN(xb_ld(&bar[XB_XGEN(b.x)]) == gen, bar);
            __builtin_amdgcn_fence(__ATOMIC_ACQUIRE, "agent");
            asm volatile("s_waitcnt vmcnt(0)" ::: "memory");
        }
    }
    __syncthreads();
}

struct Frame {
    LAS unsigned char* lds;
    volatile LAS unsigned* MISC;
    gu32* ctl;
    int tid, lane, wave;
    int vcu, G;
};

__device__ __forceinline__ float wave_sum(float v) {
#pragma unroll
    for (int o = 1; o < 64; o <<= 1) v += __shfl_xor(v, o);
    return v;
}

__device__ __forceinline__ void p0_transpose_item(const float* W, int K, int N, const float* gain, bf16* WT, int ldT, int koff, int mode, LAS float* scr, int item, int lane) {
    const int nblk = N / 32, kb = item / nblk, nb = item % nblk, k0 = 64 * kb, n0 = 32 * nb;
    float cs = 1.0f; if (mode == 3 && (n0 < 3072 || (n0 >= 9216 && n0 < 11264))) cs = QSCALE;
    int drow = n0; if (mode == 1 || mode == 2) drow = 256 * (n0 >> 7) + (n0 & 127) + (mode == 2 ? 128 : 0);
#pragma unroll 8
    for (int i = 0; i < 32; ++i) { const int kk = 2 * i + (lane >> 5); const float gk = gain ? gain[k0 + kk] * cs : cs; scr[kk * 33 + (lane & 31)] = W[(size_t)(k0 + kk) * N + n0 + (lane & 31)] * gk; }
    LDS_WAIT(); asm volatile("" ::: "memory");
    const int c = lane & 7;
#pragma unroll
    for (int j = 0; j < 4; ++j) { const int n = (lane >> 3) + 8 * j; const LAS float* s = scr + (8 * c) * 33 + n;
        v4u o; o.x = pk2(s[0 * 33], s[1 * 33]); o.y = pk2(s[2 * 33], s[3 * 33]); o.z = pk2(s[4 * 33], s[5 * 33]); o.w = pk2(s[6 * 33], s[7 * 33]);
        *(GAS v4u*)(WT + (size_t)(drow + n) * ldT + koff + k0 + 8 * c) = o; }
    LDS_WAIT(); asm volatile("" ::: "memory");
}

__device__ __forceinline__ void sincos_acc(float a, float& s, float& c) {
    const double x = (double)a;
    const double kq = __builtin_rint(x * 0.63661977236758134308);
    double r = __builtin_fma(-kq, 1.57079632679489655800e+00, x);
    r = __builtin_fma(-kq, 6.12323399573676603587e-17, r);
    const int q = (int)((long long)kq) & 3;
    const double r2 = r * r;
    const double sp = r * (1.0 + r2 * (-1.0 / 6.0 + r2 * (1.0 / 120.0 + r2 * (-1.0 / 5040.0 + r2 * (1.0 / 362880.0 + r2 * (-1.0 / 39916800.0 + r2 * (1.0 / 6227020800.0)))))));
    const double cp = 1.0 + r2 * (-0.5 + r2 * (1.0 / 24.0 + r2 * (-1.0 / 720.0 + r2 * (1.0 / 40320.0 + r2 * (-1.0 / 3628800.0 + r2 * (1.0 / 479001600.0))))));
    const double ss = (q & 1) ? cp : sp, cc = (q & 1) ? sp : cp;
    s = (float)((q & 2) ? -ss : ss);
    c = (float)(((q + 1) & 2) ? -cc : cc);
}

struct Ptrs {
    const float* xp; const float* xs; const float* g1; const float* w1g; const float* w1u; const float* w1d; const float* gmix; const float* win; const float* sink;
    const float* wa; const float* wb; const float* wout; const float* g2; const float* w2g; const float* w2u; const float* w2d; const float* gfin;
    float* out; unsigned char* ws;
};

__device__ __forceinline__ void p0_prologue(Frame& F, const Ptrs& P) {
    LAS float* scr = (LAS float*)(F.lds + RING_OFF + F.wave * 16384);
    const int gw = F.vcu * NWAVES + F.wave, NGW = F.G * NWAVES;
    bf16* WGU = (bf16*)(P.ws + WS_WGU); bf16* WD = (bf16*)(P.ws + WS_WD); bf16* WIN = (bf16*)(P.ws + WS_WIN); bf16* WAB = (bf16*)(P.ws + WS_WAB); bf16* WOUT = (bf16*)(P.ws + WS_WOUT);
    { float* tab = (float*)(P.ws + WS_ROPE);
      const float inv[16] = {1.000000000e+00f, 4.403665960e-01f, 1.939227432e-01f, 8.539710194e-02f, 3.760603070e-02f, 1.656044088e-02f, 7.292664610e-03f, 3.211446106e-03f,
                             1.414213562e-03f, 6.227724371e-04f, 2.742481884e-04f, 1.207697351e-04f, 5.318295734e-05f, 2.341999971e-05f, 1.031338525e-05f, 4.541670478e-06f};
      for (int pos = gw * 64 + F.lane; pos < 16384; pos += NGW * 64) {
#pragma unroll
          for (int i = 0; i < 16; ++i) { const float ang = (float)pos * inv[i]; float s, c; sincos_acc(ang, s, c); tab[(size_t)pos * 32 + i] = c; tab[(size_t)pos * 32 + 16 + i] = s; } } }
    { bf16* XB = (bf16*)(P.ws + WS_AB1); float* ss0 = (float*)(P.ws + WS_SS0);
      for (int m = gw; m < M; m += NGW) { const float* xrow = (m < M_P) ? P.xp + (size_t)m * D : P.xs + (size_t)(m - M_P) * D;
          const GAS f32x4* xr = (const GAS f32x4*)xrow + F.lane; GAS v2u* o8 = (GAS v2u*)(XB + (size_t)m * D) + F.lane; float s = 0.f;
#pragma unroll
          for (int j = 0; j < 16; ++j) { const f32x4 v = xr[64 * j]; s += (v.x * v.x + v.y * v.y) + (v.z * v.z + v.w * v.w); v2u w; w.x = pk2(v.x, v.y); w.y = pk2(v.z, v.w); o8[64 * j] = w; }
          s = wave_sum(s); if (F.lane == 0) ss0[m] = s; } }
    constexpr int I_GU = (D / 64) * (FF / 32), I_D = (FF / 64) * (D / 32), I_IN = (D / 64) * (NIN / 32), I_A = (1024 / 64) * (D / 32), I_B = (2048 / 64) * (D / 32), I_O = (D / 64) * (D / 32);
    constexpr int NITEMS = 2 * I_GU + I_D + I_IN + I_A + I_B + I_O;
    for (int it = gw; it < NITEMS; it += NGW) {
        int r = it;
        if (r < I_GU) { p0_transpose_item(P.w1g, D, FF, P.g1, WGU, D, 0, 1, scr, r, F.lane); continue; } r -= I_GU;
        if (r < I_GU) { p0_transpose_item(P.w1u, D, FF, P.g1, WGU, D, 0, 2, scr, r, F.lane); continue; } r -= I_GU;
        if (r < I_D)  { p0_transpose_item(P.w1d, FF, D, nullptr, WD, FF, 0, 0, scr, r, F.lane); continue; } r -= I_D;
        if (r < I_IN) { p0_transpose_item(P.win, D, NIN, P.gmix, WIN, D, 0, 3, scr, r, F.lane); continue; } r -= I_IN;
        if (r < I_A)  { p0_transpose_item(P.wa, 1024, D, nullptr, WAB, YABW, 0, 0, scr, r, F.lane); continue; } r -= I_A;
        if (r < I_B)  { p0_transpose_item(P.wb, 2048, D, nullptr, WAB, YABW, 1024, 0, scr, r, F.lane); continue; } r -= I_B;
        p0_transpose_item(P.wout, D, D, nullptr, WOUT, D, 0, 0, scr, r, F.lane);
    }
}
__device__ __forceinline__ void p4_convert_w2(Frame& F, const Ptrs& P) {
    LAS float* scr = (LAS float*)(F.lds + RING_OFF + F.wave * 16384);
    const int gw = F.vcu * NWAVES + F.wave, NGW = F.G * NWAVES;
    bf16* WGU = (bf16*)(P.ws + WS_WGU); bf16* WD = (bf16*)(P.ws + WS_WD);
    constexpr int I_GU = (D / 64) * (FF / 32), I_D = (FF / 64) * (D / 32);
    constexpr int NITEMS = 2 * I_GU + I_D;
    for (int it = gw; it < NITEMS; it += NGW) {
        int r = it;
        if (r < I_GU) { p0_transpose_item(P.w2g, D, FF, P.g2, WGU, D, 0, 1, scr, r, F.lane); continue; } r -= I_GU;
        if (r < I_GU) { p0_transpose_item(P.w2u, D, FF, P.g2, WGU, D, 0, 2, scr, r, F.lane); continue; } r -= I_GU;
        p0_transpose_item(P.w2d, FF, D, nullptr, WD, FF, 0, 0, scr, r, F.lane);
    }
}

__device__ __forceinline__ unsigned off_b(unsigned row, unsigned ch) { return 256u * row + 16u * (ch ^ (((row & 3) << 2) | ((row >> 2) & 3))); }
struct AttState { float m, l; f32x4 O[8]; };

__device__ __forceinline__ void attn_keys(AttState& st, const bf16x8 (&qf)[4], const bf16* Kb, const bf16* Vb, int S, int tq, int kstart, int dil, int ntiles, int W, LAS unsigned char* vl, int lane) {
    const int i = lane & 15, g = lane >> 4;
    const int kk_a = 8 * (i >> 2) + (i & 3);
    for (int tile = 0; tile < ntiles; ++tile) {
        const int tb = kstart + tile * 32 * dil;
        v4u vreg[8];
#pragma unroll
        for (int c = 0; c < 8; ++c) { int tk = tb + dil * (4 * c + g); tk = tk < 0 ? 0 : (tk > S - 1 ? S - 1 : tk); vreg[c] = *(const v4u*)(Vb + (size_t)tk * QKVW + 8 * i); }
        bf16x8 kf[2][4];
#pragma unroll
        for (int t = 0; t < 2; ++t) { int tk = tb + dil * (kk_a + 4 * t); tk = tk < 0 ? 0 : (tk > S - 1 ? S - 1 : tk); const bf16* kp = Kb + (size_t)tk * QKVW + 32 * g;
#pragma unroll
            for (int s = 0; s < 4; ++s) kf[t][s] = *(const bf16x8*)(kp + 8 * s); }
#pragma unroll
        for (int c = 0; c < 8; ++c) *(LAS v4u*)(vl + off_b(4 * c + g, i)) = vreg[c];
        f32x4 sc[2];
#pragma unroll
        for (int t = 0; t < 2; ++t) { sc[t] = (f32x4){0.f, 0.f, 0.f, 0.f};
#pragma unroll
            for (int s = 0; s < 4; ++s) sc[t] = __builtin_amdgcn_mfma_f32_16x16x32_bf16(kf[t][s], qf[s], sc[t], 0, 0, 0); }
        float mx = -1e30f;
#pragma unroll
        for (int t = 0; t < 2; ++t)
#pragma unroll
            for (int r = 0; r < 4; ++r) { const int tk = tb + dil * (8 * g + 4 * t + r); const int d = tk - tq; const bool ok = (d <= W) && (d >= -W) && (tk >= 0) && (tk < S);
                sc[t][r] = ok ? sc[t][r] : -__builtin_inff(); mx = fmaxf(mx, sc[t][r]); }
        mx = fmaxf(mx, __shfl_xor(mx, 16)); mx = fmaxf(mx, __shfl_xor(mx, 32));
        const float mn = fmaxf(st.m, mx), alpha = __builtin_amdgcn_exp2f(st.m - mn);
        float ps = 0.f; float p[8];
#pragma unroll
        for (int t = 0; t < 2; ++t)
#pragma unroll
            for (int r = 0; r < 4; ++r) { p[4 * t + r] = __builtin_amdgcn_exp2f(sc[t][r] - mn); ps += p[4 * t + r]; }
        st.l = st.l * alpha + ps; st.m = mn;
#pragma unroll
        for (int dt = 0; dt < 8; ++dt) st.O[dt] *= alpha;
        v4u pw; pw.x = pk2(p[0], p[1]); pw.y = pk2(p[2], p[3]); pw.z = pk2(p[4], p[5]); pw.w = pk2(p[6], p[7]);
        const bf16x8 pf = __builtin_bit_cast(bf16x8, pw);
#pragma unroll
        for (int dt = 0; dt < 8; ++dt) {
            const unsigned q = (lane & 15) >> 2, pp = lane & 3;
            const unsigned a0 = off_b(8 * g + q, 2 * dt + (pp >> 1)) + 8 * (pp & 1), a1 = off_b(8 * g + 4 + q, 2 * dt + (pp >> 1)) + 8 * (pp & 1);
            const s16x4 lo = __builtin_bit_cast(s16x4, __builtin_amdgcn_ds_read_tr16_b64_v4i16((LAS s16x4*)(vl + a0)));
            const s16x4 hi = __builtin_bit_cast(s16x4, __builtin_amdgcn_ds_read_tr16_b64_v4i16((LAS s16x4*)(vl + a1)));
            const bf16x8 vf = __builtin_shufflevector(lo, hi, 0, 1, 2, 3, 4, 5, 6, 7);
            st.O[dt] = __builtin_amdgcn_mfma_f32_16x16x32_bf16(vf, pf, st.O[dt], 0, 0, 0);
        }
    }
}

__device__ __forceinline__ void attn_phase(Frame& F, const Ptrs& P) {
    const bf16* QKV = (const bf16*)(P.ws + WS_QKV); bf16* YAB = (bf16*)(P.ws + WS_AB1);
    LAS unsigned char* vl = F.lds + RING_OFF + F.wave * 16384;
    const int gw = F.vcu * NWAVES + F.wave, NGW = F.G * NWAVES, lane = F.lane, i = lane & 15, g = lane >> 4;
    { constexpr int NT = (M / 256) * 8 * 16; const int chunk = (NT + NGW - 1) / NGW;
      for (int id = gw * chunk; id < NT && id < (gw + 1) * chunk; ++id) {
          const int r16 = id & 15, h = (id >> 4) & 7, rb = id >> 7;
          const int row_blk = rb * 256; const int seq0 = row_blk < 4096 ? 0 : (row_blk < 8192 ? 4096 : 8192); const int S = row_blk < 8192 ? 4096 : 16384;
          const int t0 = row_blk - seq0 + r16; const int tq = t0 + 16 * i;
          AttState st; st.m = -1e30f; st.l = 0.f;
#pragma unroll
          for (int dt = 0; dt < 8; ++dt) st.O[dt] = (f32x4){0.f, 0.f, 0.f, 0.f};
          const bf16* seqbase = QKV + (size_t)seq0 * QKVW;
#pragma unroll 1
          for (int grp = 0; grp < 3; ++grp) {
              const int dil = grp == 0 ? 1 : (grp == 1 ? 4 : 16); const int ntiles = grp == 0 ? 12 : (grp == 1 ? 6 : 5);
              const int hc = grp * 1024 + h * 128;
              bf16x8 qf[4]; { const bf16* qp = seqbase + (size_t)tq * QKVW + hc + 32 * g;
#pragma unroll
                  for (int s = 0; s < 4; ++s) qf[s] = *(const bf16x8*)(qp + 8 * s); }
              attn_keys(st, qf, seqbase + 3072 + hc, seqbase + 6144 + hc, S, tq, t0 - 64 * dil, dil, ntiles, 64 * dil, vl, lane);
          }
          float l = st.l; l += __shfl_xor(l, 16); l += __shfl_xor(l, 32); const float rl = 1.0f / l;
          bf16* op = YAB + (size_t)(seq0 + tq) * YABW + h * 128 + 4 * g;
#pragma unroll
          for (int dt = 0; dt < 8; ++dt) { const f32x4 o = st.O[dt] * rl; v2u w; w.x = pk2(o[0], o[1]); w.y = pk2(o[2], o[3]); *(v2u*)(op + 16 * dt) = w; }
      } }
    { constexpr int NT = (M / 16) * 16; const int chunk = (NT + NGW - 1) / NGW;
      for (int id = gw * chunk; id < NT && id < (gw + 1) * chunk; ++id) {
          const int qh = id & 15, blk = id >> 4; const int row0 = blk * 16;
          const int seq0 = row0 < 4096 ? 0 : (row0 < 8192 ? 4096 : 8192); const int S = row0 < 8192 ? 4096 : 16384;
          const int t0 = row0 - seq0; const int tq = t0 + i;
          AttState st; st.m = -1e30f; st.l = 0.f;
#pragma unroll
          for (int dt = 0; dt < 8; ++dt) st.O[dt] = (f32x4){0.f, 0.f, 0.f, 0.f};
          const bf16* seqbase = QKV + (size_t)seq0 * QKVW; const int kvh = qh >> 2;
          bf16x8 qf[4]; { const bf16* qp = seqbase + (size_t)tq * QKVW + 9216 + qh * 128 + 32 * g;
#pragma unroll
              for (int s = 0; s < 4; ++s) qf[s] = *(const bf16x8*)(qp + 8 * s); }
          attn_keys(st, qf, seqbase + 11264 + kvh * 128, seqbase + 11776 + kvh * 128, S, tq, t0 - 128, 1, 9, 128, vl, lane);
          float l = st.l; l += __shfl_xor(l, 16); l += __shfl_xor(l, 32);
          const float sk = P.sink[qh] * 1.4426950408889634f; const float m2 = fmaxf(st.m, sk); const float e1 = __builtin_amdgcn_exp2f(st.m - m2);
          const float den = l * e1 + __builtin_amdgcn_exp2f(sk - m2); const float rl = e1 / den;
          bf16* op = YAB + (size_t)(seq0 + tq) * YABW + 1024 + qh * 128 + 4 * g;
#pragma unroll
          for (int dt = 0; dt < 8; ++dt) { const f32x4 o = st.O[dt] * rl; v2u w; w.x = pk2(o[0], o[1]); w.y = pk2(o[2], o[3]); *(v2u*)(op + 16 * dt) = w; }
      } }
}

__device__ __forceinline__ void final_norm(Frame& F, const Ptrs& P) {
    const int gw = F.vcu * NWAVES + F.wave, NGW = F.G * NWAVES; const float* ss3 = (const float*)(F.ctl + CW_SS3);
    f32x4 gv[16];
#pragma unroll
    for (int j = 0; j < 16; ++j) gv[j] = ((const f32x4*)P.gfin)[F.lane + 64 * j];
    for (int m = gw; m < M; m += NGW) { const float rs = __builtin_amdgcn_rsqf(ss3[m] * (1.0f / 4096.0f) + 1e-6f); GAS f32x4* o = (GAS f32x4*)(P.out + (size_t)m * D) + F.lane;
#pragma unroll
        for (int j = 0; j < 16; ++j) { const f32x4 v = o[64 * j]; o[64 * j] = v * rs * gv[j]; } }
}

struct Args { const float* in[17]; float* out; unsigned char* ws; int ph_lo, ph_hi, li, pad; };
__global__ void __launch_bounds__(NWAVES * 64, 2) mk_fwd(Args args) {
    extern __shared__ __attribute__((aligned(16))) unsigned char lds[];
    Frame F;
    F.lds = (LAS unsigned char*)lds;
    F.MISC = (volatile LAS unsigned*)(F.lds + MISC_OFF);
    F.tid = threadIdx.x; F.lane = F.tid & 63; F.wave = __builtin_amdgcn_readfirstlane(F.tid >> 6);
    F.G = gridDim.x; { const int bx = blockIdx.x; F.vcu = (F.G % 8 == 0) ? (bx % 8) * (F.G / 8) + bx / 8 : bx; }
    unsigned char* ws = args.ws;
    F.ctl = (gu32*)(ws + WS_CTL);
    Ptrs P;
    P.xp = args.in[0]; P.xs = args.in[1]; P.g1 = args.in[2]; P.w1g = args.in[3]; P.w1u = args.in[4]; P.w1d = args.in[5]; P.gmix = args.in[6]; P.win = args.in[7]; P.sink = args.in[8];
    P.wa = args.in[9]; P.wb = args.in[10]; P.wout = args.in[11]; P.g2 = args.in[12]; P.w2g = args.in[13]; P.w2u = args.in[14]; P.w2d = args.in[15]; P.gfin = args.in[16];
    P.out = args.out; P.ws = ws;
    for (int u = F.tid; u < (LDS_BYTES - LDSCTL_OFF) / 4; u += NWAVES * 64) ((LAS unsigned*)(F.lds + LDSCTL_OFF))[u] = 0u;
    __syncthreads();
    XcdBarrier bar; bar.bar = (unsigned*)(F.ctl + CW_BAR); bar.x = 0; bar.st = nullptr;
    if (N_LAUNCHES != PER_PHASE) bar = xcd_barrier_post((unsigned*)(F.ctl + CW_BAR), F.MISC + 8);
#define GRID_BAR(seam) do { if (N_LAUNCHES != PER_PHASE) xcd_barrier(bar); } while (0)
    const int lo = args.ph_lo, hi = args.ph_hi;
#define IN(k) (lo <= (k) && (k) < hi)
#define BOTH(k) (IN(k) && IN((k) + 1))
    bf16* AB1 = (bf16*)(ws + WS_AB1); bf16* ACT = (bf16*)(ws + WS_ACT); bf16* QKVB = (bf16*)(ws + WS_QKV);
    bf16* WGU = (bf16*)(ws + WS_WGU); bf16* WDN = (bf16*)(ws + WS_WD); bf16* WIN = (bf16*)(ws + WS_WIN); bf16* WAB = (bf16*)(ws + WS_WAB); bf16* WOUT = (bf16*)(ws + WS_WOUT);
    float* ss0 = (float*)(ws + WS_SS0); float* ss1 = (float*)(F.ctl + CW_SS1); float* ss2 = (float*)(F.ctl + CW_SS2); float* ss3 = (float*)(F.ctl + CW_SS3);
    const float* rope = (const float*)(ws + WS_ROPE);

    if (IN(0)) { p0_prologue(F, P); if (BOTH(0)) GRID_BAR(0); }
    if (IN(1)) { pg8::Gemm g{AB1, WGU, M, 2 * FF, D}; pg8::StaticOrder S; S.init(M, 2 * FF, F.G, (int)blockIdx.x);
        pg8::EpiSwiglu E{ACT, FF, ss0};
        pg8::gemm_phase<pg8::EpiSwiglu, pg8::StaticOrder, PG8_ALIGN, PG8_SP2>(F.lds + RING_OFF, g, S, E);
        if (BOTH(1)) GRID_BAR(1); }
    if (IN(2)) { pg8::Gemm g{ACT, WDN, M, D, FF}; pg8::StaticOrder S; S.init(M, D, F.G, (int)blockIdx.x);
        pg8::EpiResid<true> E{P.xp, P.xs, M_P, P.out, AB1, ss1, 0.5f};
        pg8::gemm_phase<pg8::EpiResid<true>, pg8::StaticOrder, PG8_ALIGN, PG8_SP2>(F.lds + RING_OFF, g, S, E);
        if (BOTH(2)) GRID_BAR(2); }
    if (IN(3)) { pg8::Gemm g{AB1, WIN, M, NIN, D}; pg8::StaticOrder S; S.init(M, NIN, F.G, (int)blockIdx.x);
        pg8::EpiProj E{QKVB, ACT, ss1, rope};
        pg8::gemm_phase<pg8::EpiProj, pg8::StaticOrder, PG8_ALIGN, PG8_SP2>(F.lds + RING_OFF, g, S, E);
        if (BOTH(3)) GRID_BAR(3); }
    if (IN(4)) { attn_phase(F, P); p4_convert_w2(F, P); if (BOTH(4)) GRID_BAR(4); }
    if (IN(5)) { pg8::Gemm g{AB1, WAB, M, D, YABW}; pg8::StaticOrder S; S.init(M, D, F.G, (int)blockIdx.x);
        pg8::EpiMerge E{ACT, QKVB};
        pg8::gemm_phase<pg8::EpiMerge, pg8::StaticOrder, PG8_ALIGN, PG8_SP2>(F.lds + RING_OFF, g, S, E);
        if (BOTH(5)) GRID_BAR(5); }
    if (IN(6)) { pg8::Gemm g{QKVB, WOUT, M, D, D}; pg8::StaticOrder S; S.init(M, D, F.G, (int)blockIdx.x);
        pg8::EpiResid<true> E{P.out, P.out, M, P.out, AB1, ss2, 1.0f};
        pg8::gemm_phase<pg8::EpiResid<true>, pg8::StaticOrder, PG8_ALIGN, PG8_SP2>(F.lds + RING_OFF, g, S, E);
        if (BOTH(6)) GRID_BAR(6); }
    if (IN(7)) { pg8::Gemm g{AB1, WGU, M, 2 * FF, D}; pg8::StaticOrder S; S.init(M, 2 * FF, F.G, (int)blockIdx.x);
        pg8::EpiSwiglu E{ACT, FF, ss2};
        pg8::gemm_phase<pg8::EpiSwiglu, pg8::StaticOrder, PG8_ALIGN, PG8_SP2>(F.lds + RING_OFF, g, S, E);
        if (BOTH(7)) GRID_BAR(7); }
    if (IN(8)) { pg8::Gemm g{ACT, WDN, M, D, FF}; pg8::StaticOrder S; S.init(M, D, F.G, (int)blockIdx.x);
        pg8::EpiResid<false> E{P.out, P.out, M, P.out, nullptr, ss3, 0.5f};
        pg8::gemm_phase<pg8::EpiResid<false>, pg8::StaticOrder, PG8_ALIGN, PG8_SP2>(F.lds + RING_OFF, g, S, E);
        if (BOTH(8)) GRID_BAR(8); }
    if (IN(9)) { final_norm(F, P); }
#undef IN
#undef BOTH
#undef GRID_BAR
}

extern "C" void kernel_launch(void* const* d_in, const int* in_sizes, int n_in, void* d_out, int out_size, void* d_ws, size_t ws_size, hipStream_t stream) {
    static int grid = 0;
    if (grid == 0) {
        if (n_in != 17 || out_size != M * D || ws_size < WS_END) { fprintf(stderr, "kernel_launch: unexpected shapes (n_in %d, out %d, ws %zu, need %zu)\n", n_in, out_size, ws_size, (size_t)WS_END); grid = -1; return; }
        int dev = 0, cus = 0, per_cu = 0;
        if (hipGetDevice(&dev) != hipSuccess || hipDeviceGetAttribute(&cus, hipDeviceAttributeMultiprocessorCount, dev) != hipSuccess) { grid = -1; return; }
        if (hipFuncSetAttribute((const void*)mk_fwd, hipFuncAttributeMaxDynamicSharedMemorySize, LDS_BYTES) != hipSuccess) { fprintf(stderr, "kernel_launch: hipFuncSetAttribute failed\n"); grid = -1; return; }
        if (hipOccupancyMaxActiveBlocksPerMultiprocessor(&per_cu, (const void*)mk_fwd, NWAVES * 64, LDS_BYTES) != hipSuccess || per_cu < 1) { fprintf(stderr, "kernel_launch: occupancy query says %d\n", per_cu); }
        (void)hipGetLastError();
        grid = cus;
    }
    if (grid < 0) return;
    (void)hipMemsetAsync((char*)d_ws + WS_CTL, 0, CTL_ZERO_BYTES, stream);
    Args a{};
    for (int i = 0; i < 17; ++i) a.in[i] = (const float*)d_in[i];
    a.out = (float*)d_out; a.ws = (unsigned char*)d_ws; a.pad = 0;
    for (int li = 0; li < N_LAUNCHES; ++li) {
        a.ph_lo = (N_LAUNCHES == PER_PHASE) ? li : 0; a.ph_hi = (N_LAUNCHES == PER_PHASE) ? li + 1 : PER_PHASE; a.li = li;
        hipLaunchKernelGGL(mk_fwd, dim3(grid), dim3(NWAVES * 64), LDS_BYTES, stream, a);
    }
}
```

```cpp
#include <hip/hip_runtime.h>
#include <cstdio>
#include <cstdint>

#ifndef MK_N_LAUNCHES
#define MK_N_LAUNCHES 1
#endif
#ifndef PROBE_REPEAT
#define PROBE_REPEAT -1
#endif
#define NREP(k) ((PROBE_REPEAT == (k)) ? 2 : 1)

namespace pg8 {
#define PG8_LAS __attribute__((address_space(3)))
typedef unsigned short bf16_t;
typedef short bf16x8 __attribute__((ext_vector_type(8)));
typedef float f32x4 __attribute__((ext_vector_type(4)));
typedef unsigned u32x4 __attribute__((ext_vector_type(4)));
constexpr int BM = 256, BK = 64, HALF = 128, HTB = HALF * BK * 2, STAGE_BYTES = 8 * HTB, NXCD = 8, WGM = 8;

__host__ __device__ __forceinline__ int lds_byte(int r, int c) { const int st = (r >> 4) * 2 + (c >> 5), rr = r & 15, cc = c & 31, ob = rr * 64 + cc * 2; return st * 1024 + (ob ^ (((ob >> 9) & 1) << 5)); }
__host__ __device__ __forceinline__ void stage_rc(int b, int& R, int& C) { const int st = b / 1024, sb = b % 1024, swz = sb ^ (((sb >> 9) & 1) << 5); R = (st >> 1) * 16 + swz / 64; C = (st & 1) * 32 + (swz % 64) / 2; }
__host__ __device__ __forceinline__ int perm32(int rho) { const int n = rho >> 4, i = rho & 15; return 8 * (i >> 2) + 4 * n + (i & 3); }

struct Unit { int pm, pn; };
struct Gemm { const bf16_t* A; const bf16_t* Bt; int M, N, K; };

struct StaticOrder {
    int nM, nN, nwg, G, c;
    __host__ __device__ void init(int M, int N, int G_, int c_) { nM = M / BM; nN = N / BM; nwg = nM * nN; G = G_; c = c_; }
    __host__ __device__ bool next(int i, Unit& u) const {
        const long L = (long)i * G + c; if (L >= nwg) return false;
        int wgid = (int)L; { const int q = nwg / NXCD, r = nwg % NXCD, xcd = wgid % NXCD, off = wgid / NXCD; wgid = (xcd < r ? xcd * (q + 1) : r * (q + 1) + (xcd - r) * q) + off; }
        const int nig = WGM * nN, gid = wgid / nig, fm = gid * WGM, gsz = (nM - fm) < WGM ? (nM - fm) : WGM;
        u.pm = fm + ((wgid % nig) % gsz); u.pn = (wgid % nig) / gsz; return true;
    }
    __device__ __forceinline__ void a_ready(const Unit&) const {}
    __device__ __forceinline__ void done(const Unit&) const {}
};

__device__ __forceinline__ unsigned cvt_pk_bf16(float lo, float hi) { unsigned r; asm volatile("v_cvt_pk_bf16_f32 %0, %1, %2" : "=v"(r) : "v"(lo), "v"(hi)); return r; }
__device__ __forceinline__ float bf_lo(unsigned w) { return __uint_as_float(w << 16); }
__device__ __forceinline__ float bf_hi(unsigned w) { return __uint_as_float(w & 0xffff0000u); }
__device__ __forceinline__ float sigmoid_f(float x) { return __builtin_amdgcn_rcpf(1.0f + __builtin_amdgcn_exp2f(-1.44269504089f * x)); }


struct EpiSwiglu {
    static constexpr bool PERM = true, AFTER_DRAIN = false, HAS_MID = false; static constexpr int MID_T = 0;
    bf16_t* O; int ldc; const float* ss;
    __device__ __forceinline__ void mid(f32x4 (&)[2][2][4][2], const Unit&, int, int, int, int) const {}
    __device__ __forceinline__ void operator()(f32x4 (&acc)[2][2][4][2], const Unit& u, int wr, int wc, int fr, int fq) const {
        const int row0 = u.pm * BM + wr * 64 + fr, col0 = u.pn * HALF + wc * 32 + 8 * fq;
        float rs[2][4];
#pragma unroll
        for (int ai = 0; ai < 2; ++ai)
#pragma unroll
            for (int m = 0; m < 4; ++m) rs[ai][m] = ss[row0 + ai * HALF + m * 16];
#pragma unroll
        for (int ai = 0; ai < 2; ++ai)
#pragma unroll
            for (int m = 0; m < 4; ++m) { const int r = row0 + ai * HALF + m * 16; const float rr = __builtin_amdgcn_rsqf(rs[ai][m] * (1.0f / 4096.0f) + 1e-6f);
                float o[8];
#pragma unroll
                for (int n = 0; n < 2; ++n)
#pragma unroll
                    for (int j = 0; j < 4; ++j) { const float g = acc[ai][0][m][n][j] * rr, up = acc[ai][1][m][n][j] * rr; o[4 * n + j] = g * sigmoid_f(g) * up; }
                u32x4 w; w.x = cvt_pk_bf16(o[0], o[1]); w.y = cvt_pk_bf16(o[2], o[3]); w.z = cvt_pk_bf16(o[4], o[5]); w.w = cvt_pk_bf16(o[6], o[7]);
                *(u32x4*)(O + (size_t)r * ldc + col0) = w; }
    }
};

template <bool HAS_OB> struct EpiResid {
    static constexpr bool PERM = true, AFTER_DRAIN = false, HAS_MID = false; static constexpr int MID_T = 0;
    const float* base_lo; const float* base_hi; int split_row; float* out; bf16_t* ob; float* ss; float scale;
    __device__ __forceinline__ void mid(f32x4 (&)[2][2][4][2], const Unit&, int, int, int, int) const {}
    __device__ __forceinline__ void operator()(f32x4 (&acc)[2][2][4][2], const Unit& u, int wr, int wc, int fr, int fq) const {
        const int row0 = u.pm * BM + wr * 64 + fr, col0 = u.pn * BM + wc * 32 + 8 * fq;
        const float* bb = (u.pm * BM < split_row) ? base_lo : base_hi - (size_t)split_row * 4096;
        f32x4 tb[2][4];
#define RES_LOAD(k) do { const size_t off_ = (size_t)(row0 + ((k) >> 2) * HALF + ((k) & 3) * 16) * 4096 + col0; \
            tb[(k) & 1][0] = *(const f32x4*)(bb + off_); tb[(k) & 1][1] = *(const f32x4*)(bb + off_ + 4); tb[(k) & 1][2] = *(const f32x4*)(bb + off_ + HALF); tb[(k) & 1][3] = *(const f32x4*)(bb + off_ + HALF + 4); } while (0)
        RES_LOAD(0);
#pragma unroll
        for (int k = 0; k < 8; ++k) { const int ai = k >> 2, m = k & 3;
            if (k + 1 < 8) RES_LOAD(k + 1);
            acc[ai][0][m][0] = tb[k & 1][0] + acc[ai][0][m][0] * scale; acc[ai][0][m][1] = tb[k & 1][1] + acc[ai][0][m][1] * scale;
            acc[ai][1][m][0] = tb[k & 1][2] + acc[ai][1][m][0] * scale; acc[ai][1][m][1] = tb[k & 1][3] + acc[ai][1][m][1] * scale;
            asm volatile("" : "+v"(acc[ai][0][m][0]), "+v"(acc[ai][0][m][1]), "+v"(acc[ai][1][m][0]), "+v"(acc[ai][1][m][1]));
            __builtin_amdgcn_sched_barrier(0); }
#undef RES_LOAD
#pragma unroll
        for (int ai = 0; ai < 2; ++ai)
#pragma unroll
            for (int m = 0; m < 4; ++m) { const int r = row0 + ai * HALF + m * 16; const size_t off = (size_t)r * 4096 + col0; float sq = 0.f;
#pragma unroll
                for (int bj = 0; bj < 2; ++bj) { const f32x4 v0 = acc[ai][bj][m][0], v1 = acc[ai][bj][m][1];
                    *(f32x4*)(out + off + bj * HALF) = v0; *(f32x4*)(out + off + bj * HALF + 4) = v1;
                    sq += (v0[0] * v0[0] + v0[1] * v0[1]) + (v0[2] * v0[2] + v0[3] * v0[3]) + (v1[0] * v1[0] + v1[1] * v1[1]) + (v1[2] * v1[2] + v1[3] * v1[3]);
                    if (HAS_OB) { u32x4 w; w.x = cvt_pk_bf16(v0[0], v0[1]); w.y = cvt_pk_bf16(v0[2], v0[3]); w.z = cvt_pk_bf16(v1[0], v1[1]); w.w = cvt_pk_bf16(v1[2], v1[3]); *(u32x4*)(ob + off + bj * HALF) = w; } }
                sq += __shfl_xor(sq, 16); sq += __shfl_xor(sq, 32);
                if (fq == 0) __hip_atomic_fetch_add(ss + r, sq, __ATOMIC_RELAXED, __HIP_MEMORY_SCOPE_AGENT); }
    }
};

struct EpiProj {
    static constexpr bool PERM = true, AFTER_DRAIN = false, HAS_MID = false; static constexpr int MID_T = 0;
    bf16_t* qkv; bf16_t* gates; const float* ss; const float* rope;
    __device__ __forceinline__ void mid(f32x4 (&)[2][2][4][2], const Unit&, int, int, int, int) const {}
    __device__ __forceinline__ void operator()(f32x4 (&acc)[2][2][4][2], const Unit& u, int wr, int wc, int fr, int fq) const {
        const int pn = u.pn; const bool is_gate = pn >= 48, is_rope = (pn < 24) || (pn >= 36 && pn < 46);
        const int row0 = u.pm * BM + wr * 64 + fr, cw = wc * 32 + 8 * fq;
        bf16_t* dst = is_gate ? gates + (pn - 48) * BM + cw : qkv + pn * BM + cw; const int ld = is_gate ? 8192 : 12288;
        const bool do_rope = is_rope && (wc == 0); const float sgn = fq < 2 ? -1.0f : 1.0f;
        float rs[2][4];
#pragma unroll
        for (int ai = 0; ai < 2; ++ai)
#pragma unroll
            for (int m = 0; m < 4; ++m) rs[ai][m] = ss[row0 + ai * HALF + m * 16];
#pragma unroll
        for (int ai = 0; ai < 2; ++ai)
#pragma unroll
            for (int m = 0; m < 4; ++m) { const int r = row0 + ai * HALF + m * 16; const float rr = __builtin_amdgcn_rsqf(rs[ai][m] * (1.0f / 4096.0f) + 1e-6f);
#pragma unroll
                for (int bj = 0; bj < 2; ++bj) { acc[ai][bj][m][0] *= rr; acc[ai][bj][m][1] *= rr; }
                if (do_rope) { const int pos = r < 8192 ? (r & 4095) : r - 8192; const float* tp = rope + (size_t)pos * 32 + 8 * (fq & 1);
                    const f32x4 c0 = *(const f32x4*)tp, c1 = *(const f32x4*)(tp + 4), s0 = *(const f32x4*)(tp + 16), s1 = *(const f32x4*)(tp + 20);
#pragma unroll
                    for (int bj = 0; bj < 2; ++bj) { f32x4 v0 = acc[ai][bj][m][0], v1 = acc[ai][bj][m][1];
#pragma unroll
                        for (int j = 0; j < 4; ++j) { const float p0 = __shfl_xor(v0[j], 32), p1 = __shfl_xor(v1[j], 32); v0[j] = v0[j] * c0[j] + sgn * p0 * s0[j]; v1[j] = v1[j] * c1[j] + sgn * p1 * s1[j]; }
                        acc[ai][bj][m][0] = v0; acc[ai][bj][m][1] = v1; } } }
#pragma unroll
        for (int ai = 0; ai < 2; ++ai)
#pragma unroll
            for (int m = 0; m < 4; ++m) { const int r = row0 + ai * HALF + m * 16;
#pragma unroll
                for (int bj = 0; bj < 2; ++bj) { f32x4 v0 = acc[ai][bj][m][0], v1 = acc[ai][bj][m][1];
                    if (is_gate) {
#pragma unroll
                        for (int j = 0; j < 4; ++j) { v0[j] = sigmoid_f(v0[j]); v1[j] = sigmoid_f(v1[j]); } }
                    u32x4 w; w.x = cvt_pk_bf16(v0[0], v0[1]); w.y = cvt_pk_bf16(v0[2], v0[3]); w.z = cvt_pk_bf16(v1[0], v1[1]); w.w = cvt_pk_bf16(v1[2], v1[3]);
                    *(u32x4*)(dst + (size_t)r * ld + bj * HALF) = w; } }
    }
};

struct EpiMerge {
    static constexpr bool PERM = true, AFTER_DRAIN = false, HAS_MID = true; static constexpr int MID_T = 16;
    const bf16_t* gates; bf16_t* O;
    __device__ __forceinline__ void mid(f32x4 (&acc)[2][2][4][2], const Unit& u, int wr, int wc, int fr, int fq) const {
        const int row0 = u.pm * BM + wr * 64 + fr, col0 = u.pn * BM + wc * 32 + 8 * fq;
#pragma unroll
        for (int ai = 0; ai < 2; ++ai)
#pragma unroll
            for (int m = 0; m < 4; ++m) { int r = row0 + ai * HALF + m * 16; asm volatile("" : "+v"(r));
                const bf16_t* gp = gates + (size_t)r * 8192 + col0;
#pragma unroll
                for (int bj = 0; bj < 2; ++bj) { const u32x4 a = *(const u32x4*)(gp + bj * HALF), b = *(const u32x4*)(gp + 4096 + bj * HALF);
                    f32x4 r0, r1;
                    r0[0] = bf_lo(a.x) * __builtin_amdgcn_rcpf(fmaxf(bf_lo(b.x), 1e-20f)); r0[1] = bf_hi(a.x) * __builtin_amdgcn_rcpf(fmaxf(bf_hi(b.x), 1e-20f));
                    r0[2] = bf_lo(a.y) * __builtin_amdgcn_rcpf(fmaxf(bf_lo(b.y), 1e-20f)); r0[3] = bf_hi(a.y) * __builtin_amdgcn_rcpf(fmaxf(bf_hi(b.y), 1e-20f));
                    r1[0] = bf_lo(a.z) * __builtin_amdgcn_rcpf(fmaxf(bf_lo(b.z), 1e-20f)); r1[1] = bf_hi(a.z) * __builtin_amdgcn_rcpf(fmaxf(bf_hi(b.z), 1e-20f));
                    r1[2] = bf_lo(a.w) * __builtin_amdgcn_rcpf(fmaxf(bf_lo(b.w), 1e-20f)); r1[3] = bf_hi(a.w) * __builtin_amdgcn_rcpf(fmaxf(bf_hi(b.w), 1e-20f));
                    acc[ai][bj][m][0] *= r0; acc[ai][bj][m][1] *= r1; }
                asm volatile("" ::: "memory"); }
    }
    __device__ __forceinline__ void operator()(f32x4 (&acc)[2][2][4][2], const Unit& u, int wr, int wc, int fr, int fq) const {
        const int row0 = u.pm * BM + wr * 64 + fr, col0 = u.pn * BM + wc * 32 + 8 * fq;
#pragma unroll
        for (int ai = 0; ai < 2; ++ai)
#pragma unroll
            for (int m = 0; m < 4; ++m) { const int r = row0 + ai * HALF + m * 16; const bf16_t* gp = gates + (size_t)r * 8192 + 4096 + col0;
#pragma unroll
                for (int bj = 0; bj < 2; ++bj) { const u32x4 b = *(const u32x4*)(gp + bj * HALF); f32x4 g0, g1;
                    g0[0] = fmaxf(bf_lo(b.x), 1e-20f); g0[1] = fmaxf(bf_hi(b.x), 1e-20f); g0[2] = fmaxf(bf_lo(b.y), 1e-20f); g0[3] = fmaxf(bf_hi(b.y), 1e-20f);
                    g1[0] = fmaxf(bf_lo(b.z), 1e-20f); g1[1] = fmaxf(bf_hi(b.z), 1e-20f); g1[2] = fmaxf(bf_lo(b.w), 1e-20f); g1[3] = fmaxf(bf_hi(b.w), 1e-20f);
                    acc[ai][bj][m][0] *= g0; acc[ai][bj][m][1] *= g1; } }
#pragma unroll
        for (int ai = 0; ai < 2; ++ai)
#pragma unroll
            for (int m = 0; m < 4; ++m) { const int r = row0 + ai * HALF + m * 16;
#pragma unroll
                for (int bj = 0; bj < 2; ++bj) { const f32x4 a0 = acc[ai][bj][m][0], a1 = acc[ai][bj][m][1];
                    u32x4 w; w.x = cvt_pk_bf16(a0[0], a0[1]); w.y = cvt_pk_bf16(a0[2], a0[3]); w.z = cvt_pk_bf16(a1[0], a1[1]); w.w = cvt_pk_bf16(a1[2], a1[3]);
                    *(u32x4*)(O + (size_t)r * 4096 + col0 + bj * HALF) = w; } }
    }
};

template <class Epi, class Sched, bool ALIGN_EPI = false, bool SP2 = false>
__device__ __forceinline__ void gemm_phase(PG8_LAS unsigned char* lds, const Gemm g, const Sched& S, const Epi& E) {
    const int tid = threadIdx.x, wid = __builtin_amdgcn_readfirstlane(tid >> 6), lane = tid & 63, wr = wid >> 2, wc = wid & 3, fr = lane & 15, fq = lane >> 4;
    const int K = g.K, nt = K / BK;
    unsigned voffA[2], voffB[2];
#pragma unroll
    for (int i = 0; i < 2; ++i) { int R, C; stage_rc(tid * 16 + i * 8192, R, C); const int Rb = Epi::PERM ? ((R & ~31) + perm32(R & 31)) : R;
        voffA[i] = (unsigned)(R * K + C) * 2u; voffB[i] = (unsigned)(Rb * K + C) * 2u; }
    const size_t kstep = (size_t)(BK * 2);
    const size_t hstep = (size_t)HALF * K * 2;
    const size_t tstep = 2 * hstep;
    const unsigned ldsw = (unsigned)wid * 1024u;
    const int aoff = lds_byte(wr * 64 + fr, fq * 8), boff = lds_byte(wc * 32 + fr, fq * 8);
#define PG8_SA(b, h) (((b) * 2 + (h)) * HTB)
#define PG8_SB(b, h) ((4 + (b) * 2 + (h)) * HTB)
#define PG8_STAGE(bufoff, gbase, voff) do { _Pragma("unroll") for (int _i = 0; _i < 2; ++_i) \
        __builtin_amdgcn_global_load_lds((const unsigned*)((const char*)(gbase) + (voff)[_i]), (PG8_LAS unsigned*)(lds + (bufoff) + ldsw + _i * 8192), 16, 0, 0); } while (0)
#define PG8_LDA(dst, b, h) do { _Pragma("unroll") for (int m = 0; m < 4; ++m) _Pragma("unroll") for (int k = 0; k < 2; ++k) dst[m][k] = *(const PG8_LAS bf16x8*)(lds + PG8_SA(b, h) + aoff + m * 2048 + k * 1024); } while (0)
#define PG8_LDB(dst, b, h) do { _Pragma("unroll") for (int n = 0; n < 2; ++n) _Pragma("unroll") for (int k = 0; k < 2; ++k) dst[n][k] = *(const PG8_LAS bf16x8*)(lds + PG8_SB(b, h) + boff + n * 2048 + k * 1024); } while (0)
#define PG8_MMA(ai, bj, At, Bt) do { __builtin_amdgcn_s_setprio(1); _Pragma("unroll") for (int m = 0; m < 4; ++m) _Pragma("unroll") for (int n = 0; n < 2; ++n) _Pragma("unroll") for (int k = 0; k < 2; ++k) \
        acc[ai][bj][m][n] = __builtin_amdgcn_mfma_f32_16x16x32_bf16(Bt[n][k], At[m][k], acc[ai][bj][m][n], 0, 0, 0); __builtin_amdgcn_s_setprio(0); } while (0)
#define PG8_WAIT_V(n) asm volatile("s_waitcnt vmcnt(" #n ")" ::: "memory")
#define PG8_WAIT_L(n) asm volatile("s_waitcnt lgkmcnt(" #n ")" ::: "memory")
#define PG8_BAR __builtin_amdgcn_s_barrier()
#define PG8_SCHED __builtin_amdgcn_sched_barrier(0)
    Unit cur, nxt; int ui = 0;
    if (!S.next(0, cur)) return;
    f32x4 acc[2][2][4][2];
#pragma unroll
    for (int a = 0; a < 2; ++a)
#pragma unroll
        for (int b = 0; b < 2; ++b)
#pragma unroll
            for (int m = 0; m < 4; ++m)
#pragma unroll
                for (int n = 0; n < 2; ++n) acc[a][b][m][n] = (f32x4){0.f, 0.f, 0.f, 0.f};
    bf16x8 At[4][2], B0[2][2], B1[2][2];
    const char* cA = (const char*)g.A + (size_t)cur.pm * tstep; const char* cB = (const char*)g.Bt + (size_t)cur.pn * tstep;
    S.a_ready(cur);
    if constexpr (SP2) {
        PG8_STAGE(PG8_SB(0, 0), cB, voffB); PG8_STAGE(PG8_SB(0, 1), cB + hstep, voffB); PG8_STAGE(PG8_SA(0, 0), cA, voffA); PG8_STAGE(PG8_SA(0, 1), cA + hstep, voffA);
        if (wr == 1) PG8_BAR;
        PG8_WAIT_V(2); PG8_BAR;
        PG8_STAGE(PG8_SB(1, 0), cB + kstep, voffB); PG8_STAGE(PG8_SA(1, 0), cA + kstep, voffA); PG8_STAGE(PG8_SB(1, 1), cB + hstep + kstep, voffB);
        PG8_WAIT_V(6); PG8_BAR;
    } else {
        PG8_STAGE(PG8_SB(0, 0), cB, voffB); PG8_STAGE(PG8_SA(0, 0), cA, voffA); PG8_STAGE(PG8_SB(0, 1), cB + hstep, voffB); PG8_STAGE(PG8_SA(0, 1), cA + hstep, voffA);
        if (wr == 1) PG8_BAR;
        PG8_WAIT_V(4); PG8_BAR;
        PG8_STAGE(PG8_SB(1, 0), cB + kstep, voffB); PG8_STAGE(PG8_SA(1, 0), cA + kstep, voffA); PG8_STAGE(PG8_SB(1, 1), cB + hstep + kstep, voffB);
        PG8_WAIT_V(6); PG8_BAR;
    }
    for (;;) {
        const bool has_next = S.next(ui + 1, nxt);
        const char* nA = has_next ? (const char*)g.A + (size_t)nxt.pm * tstep : cA; const char* nB = has_next ? (const char*)g.Bt + (size_t)nxt.pn * tstep : cB;
        for (int t = 0; t < nt; t += 2) {
            const bool last = (t == nt - 2);
            const char* a1 = cA + (size_t)(t + 1) * kstep;
            const char* a2 = last ? nA : cA + (size_t)(t + 2) * kstep; const char* b2 = last ? nB : cB + (size_t)(t + 2) * kstep;
            const char* a3 = a2 + kstep; const char* b3 = b2 + kstep;
            if (last && has_next) S.a_ready(nxt);
            if constexpr (Epi::HAS_MID) { if (t == Epi::MID_T) E.mid(acc, cur, wr, wc, fr, fq); }
            if constexpr (SP2) {
            PG8_LDB(B0, 0, 0); PG8_LDB(B1, 0, 1); PG8_SCHED; PG8_LDA(At, 0, 0); PG8_STAGE(PG8_SA(1, 1), a1 + hstep, voffA);
            PG8_WAIT_V(8); PG8_WAIT_L(0); PG8_BAR; PG8_MMA(0, 0, At, B0); PG8_MMA(0, 1, At, B1); PG8_BAR; PG8_SCHED;
            PG8_LDA(At, 0, 1); PG8_STAGE(PG8_SB(0, 0), b2, voffB); PG8_STAGE(PG8_SB(0, 1), b2 + hstep, voffB); PG8_STAGE(PG8_SA(0, 0), a2, voffA);
            PG8_WAIT_V(8); PG8_WAIT_L(0); PG8_BAR; PG8_MMA(1, 0, At, B0); PG8_MMA(1, 1, At, B1); PG8_BAR; PG8_SCHED;
            PG8_LDB(B0, 1, 0); PG8_LDB(B1, 1, 1); PG8_SCHED; PG8_LDA(At, 1, 0); PG8_STAGE(PG8_SA(0, 1), a2 + hstep, voffA);
            PG8_WAIT_V(8); PG8_WAIT_L(0); PG8_BAR; PG8_MMA(0, 0, At, B0); PG8_MMA(0, 1, At, B1); PG8_BAR; PG8_SCHED;
            PG8_LDA(At, 1, 1); PG8_STAGE(PG8_SB(1, 0), b3, voffB); PG8_STAGE(PG8_SB(1, 1), b3 + hstep, voffB); PG8_STAGE(PG8_SA(1, 0), a3, voffA);
            PG8_WAIT_V(8); PG8_WAIT_L(0); PG8_BAR; PG8_MMA(1, 0, At, B0); PG8_MMA(1, 1, At, B1); PG8_BAR; PG8_SCHED;
            } else {
            PG8_LDB(B0, 0, 0); PG8_SCHED; PG8_LDA(At, 0, 0); PG8_STAGE(PG8_SA(1, 1), a1 + hstep, voffA);
            PG8_WAIT_L(8); PG8_BAR; PG8_WAIT_L(0); PG8_MMA(0, 0, At, B0); PG8_BAR; PG8_SCHED;
            PG8_LDB(B1, 0, 1); PG8_STAGE(PG8_SB(0, 0), b2, voffB);
            PG8_BAR; PG8_WAIT_L(0); PG8_MMA(0, 1, At, B1); PG8_BAR;
            PG8_LDA(At, 0, 1); PG8_STAGE(PG8_SA(0, 0), a2, voffA);
            PG8_BAR; PG8_WAIT_L(0); PG8_MMA(1, 0, At, B0); PG8_BAR; PG8_SCHED;
            PG8_STAGE(PG8_SB(0, 1), b2 + hstep, voffB);
            PG8_WAIT_V(6); PG8_BAR; PG8_MMA(1, 1, At, B1); PG8_BAR;
            PG8_LDB(B0, 1, 0); PG8_SCHED; PG8_LDA(At, 1, 0); PG8_STAGE(PG8_SA(0, 1), a2 + hstep, voffA);
            PG8_WAIT_L(8); PG8_BAR; PG8_WAIT_L(0); PG8_MMA(0, 0, At, B0); PG8_BAR; PG8_SCHED;
            PG8_LDB(B1, 1, 1); PG8_STAGE(PG8_SB(1, 0), b3, voffB);
            PG8_BAR; PG8_WAIT_L(0); PG8_MMA(0, 1, At, B1); PG8_BAR;
            PG8_LDA(At, 1, 1); PG8_STAGE(PG8_SA(1, 0), a3, voffA);
            PG8_BAR; PG8_WAIT_L(0); PG8_MMA(1, 0, At, B0); PG8_BAR; PG8_SCHED;
            PG8_STAGE(PG8_SB(1, 1), b3 + hstep, voffB);
            PG8_WAIT_V(6); PG8_BAR; PG8_MMA(1, 1, At, B1); PG8_BAR;
            }
        }
        if constexpr (ALIGN_EPI) { if (wr == 0) PG8_BAR; }
        if constexpr (!Epi::AFTER_DRAIN) { E(acc, cur, wr, wc, fr, fq); S.done(cur); }
        if (!has_next) break;
#pragma unroll
        for (int a = 0; a < 2; ++a)
#pragma unroll
            for (int b = 0; b < 2; ++b)
#pragma unroll
                for (int m = 0; m < 4; ++m)
#pragma unroll
                    for (int n = 0; n < 2; ++n) acc[a][b][m][n] = (f32x4){0.f, 0.f, 0.f, 0.f};
        cur = nxt; cA = nA; cB = nB; ++ui;
        if constexpr (ALIGN_EPI) { if (wr == 1) PG8_BAR; }
    }
    PG8_WAIT_V(0);
    if constexpr (!ALIGN_EPI) { if (wr == 0) PG8_BAR; }
    PG8_BAR;
#undef PG8_SA
#undef PG8_SB
#undef PG8_STAGE
#undef PG8_LDA
#undef PG8_LDB
#undef PG8_MMA
#undef PG8_WAIT_V
#undef PG8_WAIT_L
#undef PG8_BAR
#undef PG8_SCHED
}
}

#ifndef PG8_SP2
#define PG8_SP2 true
#endif
#ifndef PG8_ALIGN
#define PG8_ALIGN true
#endif

constexpr int NWAVES = 8;
constexpr int N_LAUNCHES = MK_N_LAUNCHES;
constexpr int PER_PHASE = 10;
constexpr int D = 4096, FF = 11008, NIN = 20480, QKVW = 12288, GATEW = 8192, YABW = 3072;
constexpr int M_P = 8192, M_S = 16384, M = M_P + M_S;
constexpr float QSCALE = 0.08838834764831845f * 1.4426950408889634f;

constexpr size_t MiB = 1u << 20;
constexpr size_t WS_CTL = 0, CTL_ZERO_BYTES = 1 * MiB;
constexpr size_t WS_SS0 = 1 * MiB;
constexpr size_t WS_ROPE = 2 * MiB;
constexpr size_t WS_WIN = 4 * MiB;
constexpr size_t WS_WAB = WS_WIN + (size_t)NIN * D * 2;
constexpr size_t WS_WOUT = WS_WAB + (size_t)D * YABW * 2;
constexpr size_t WS_WGU = WS_WOUT + (size_t)D * D * 2;
constexpr size_t WS_WD = WS_WGU + (size_t)2 * FF * D * 2;
constexpr size_t WS_AB1 = WS_WD + (size_t)D * FF * 2;
constexpr size_t WS_ACT = WS_AB1 + (size_t)M * D * 2;
constexpr size_t WS_QKV = WS_ACT + (size_t)M * FF * 2;
constexpr size_t WS_END = WS_QKV + (size_t)M * QKVW * 2;
constexpr int CW_BAR = 4096;
constexpr int CW_SS1 = 16384, CW_SS2 = CW_SS1 + M, CW_SS3 = CW_SS2 + M;
static_assert((size_t)(CW_SS3 + M) * 4 <= CTL_ZERO_BYTES, "CTL words inside the memset region");
static_assert(WS_SS0 + (size_t)M * 4 <= WS_ROPE && WS_ROPE + (size_t)16384 * 32 * 4 <= WS_WIN, "ws map");

constexpr int RING_OFF = 0, RING_BYTES = 131072;
constexpr int LDSCTL_OFF = RING_BYTES, MISC_OFF = LDSCTL_OFF + 320;
constexpr int LDS_BYTES = 147456;

#define GAS __attribute__((address_space(1)))
#define LAS __attribute__((address_space(3)))
typedef unsigned short bf16;
typedef unsigned v4u __attribute__((ext_vector_type(4)));
typedef unsigned v2u __attribute__((ext_vector_type(2)));
typedef float f32x4 __attribute__((ext_vector_type(4)));
typedef short bf16x8 __attribute__((ext_vector_type(8)));
typedef short s16x4 __attribute__((ext_vector_type(4)));
typedef GAS unsigned gu32;
#define RLX_AGENT __ATOMIC_RELAXED, __HIP_MEMORY_SCOPE_AGENT
#define LDS_WAIT() asm volatile("s_waitcnt lgkmcnt(0)" ::: "memory")
#define VM_WAIT() asm volatile("s_waitcnt vmcnt(0)" ::: "memory")
__device__ __forceinline__ unsigned pk2(float lo, float hi) { return pg8::cvt_pk_bf16(lo, hi); }

#define XB_TMO      128
#define XB_XCNT(j)  (256  + 64 * (j))
#define XB_XSUB(j)  (1280 + 64 * (j))
#define XB_XGEN(j)  (2304 + 64 * (j))
#define XB_TOP      3328
#define XB_TOPGEN   3392
#define XCD_BAR_WORDS 3456
#define XB_SPIN_CAP (1u << 18)

__device__ __forceinline__ unsigned xb_ld(unsigned* p)              { return __hip_atomic_load(p, __ATOMIC_RELAXED, __HIP_MEMORY_SCOPE_AGENT); }
__device__ __forceinline__ unsigned xb_add(unsigned* p, unsigned v) { return __hip_atomic_fetch_add(p, v, __ATOMIC_RELAXED, __HIP_MEMORY_SCOPE_AGENT); }
__device__ __forceinline__ unsigned xb_xcc_id() { return (unsigned)__builtin_amdgcn_s_getreg((3 << 11) | 20) & 0xFu; }
#define XB_SPIN(cond, bar) do { unsigned _sp = 0; while (cond) { __builtin_amdgcn_s_sleep(1); \
    if ((++_sp & 255u) == 0u) { if (xb_ld(&(bar)[XB_TMO])) break; if (_sp > XB_SPIN_CAP) { atomicAdd(&(bar)[XB_TMO], 1u); break; } } } } while (0)

struct XcdBarrier {
    unsigned* bar; unsigned x;
    volatile LAS unsigned* st;
};
__device__ __forceinline__ XcdBarrier xcd_barrier_post(unsigned* bar, volatile LAS unsigned* st) {
    XcdBarrier b; b.bar = bar; b.x = xb_xcc_id(); b.st = st;
    if (threadIdx.x == 0) (void)xb_add(&bar[XB_XCNT(b.x)], 1u);
    return b;
}
__device__ __forceinline__ void xcd_barrier_complete(unsigned* bar, unsigned x, unsigned& nloc, unsigned& nx) {
    const unsigned G = gridDim.x * gridDim.y * gridDim.z;
    unsigned sum, cnt, mine, sp = 0u;
    for (;;) {
        sum = 0u; cnt = 0u; mine = 0u;
#pragma unroll
        for (unsigned j = 0; j < 16; ++j) { const unsigned c = xb_ld(&bar[XB_XCNT(j)]); sum += c; cnt += (c > 0u) ? 1u : 0u; mine = (j == x) ? c : mine; }
        if (sum == G) break;
        __builtin_amdgcn_s_sleep(1);
        if ((++sp & 255u) == 0u) { if (xb_ld(&bar[XB_TMO])) break; if (sp > XB_SPIN_CAP) { atomicAdd(&bar[XB_TMO], 1u); break; } }
    }
    nloc = mine > 0u ? mine : 1u; nx = cnt > 0u ? cnt : 1u;
}
__device__ __forceinline__ void xcd_barrier(const XcdBarrier& b) {
    asm volatile("s_waitcnt vmcnt(0)" ::: "memory");
    __syncthreads();
    if (threadIdx.x == 0) {
        unsigned* bar = b.bar;
        __builtin_amdgcn_s_waitcnt(0);
        unsigned nloc = b.st[0], nx = b.st[1];
        if (nloc == 0u) { xcd_barrier_complete(bar, b.x, nloc, nx); b.st[0] = nloc; b.st[1] = nx; }
        const unsigned old = xb_add(&bar[XB_XSUB(b.x)], 1u);
        const unsigned gen = old / nloc;
        if (old + 1u == (gen + 1u) * nloc) {
            __builtin_amdgcn_fence(__ATOMIC_RELEASE, "agent");
            asm volatile("s_waitcnt vmcnt(0)" ::: "memory");
            const unsigned og = xb_add(&bar[XB_TOP], 1u);
            const unsigned tg = og / nx;
            if (og + 1u == (tg + 1u) * nx) xb_add(&bar[XB_TOPGEN], 1u);
            else XB_SPIN(xb_ld(&bar[XB_TOPGEN]) == tg, bar);
            __builtin_amdgcn_fence(__ATOMIC_ACQUIRE, "agent");
            xb_add(&bar[XB_XGEN(b.x)], 1u);
            asm volatile("s_waitcnt vmcnt(0)" ::: "memory");
        } else {
            XB_SPIN(xb_ld(&bar[XB_XGEN(b.x)]) == gen, bar);
            __builtin_amdgcn_fence(__ATOMIC_ACQUIRE, "agent");
            asm volatile("s_waitcnt vmcnt(0)" ::: "memory");
        }
    }
    __syncthreads();
}

struct Frame {
    LAS unsigned char* lds;
    volatile LAS unsigned* MISC;
    gu32* ctl;
    int tid, lane, wave;
    int vcu, G;
};

__device__ __forceinline__ float wave_sum(float v) {
#pragma unroll
    for (int o = 1; o < 64; o <<= 1) v += __shfl_xor(v, o);
    return v;
}

struct CvtJob { const float* W; const float* gain; bf16* WT; int N, ldT, drow, kcol0, k0, n0; float cs; };
__device__ __forceinline__ void cvt_job(CvtJob& J, const float* W, int N, const float* gain, bf16* WT, int ldT, int koff, int mode, int item) {
    const int nblk = N / 64, kb = item / nblk, nb = item % nblk, k0 = 64 * kb, n0 = 64 * nb;
    J.W = W; J.gain = gain; J.WT = WT; J.N = N; J.ldT = ldT; J.k0 = k0; J.n0 = n0; J.kcol0 = koff + k0;
    J.cs = (mode == 3 && (n0 < 3072 || (n0 >= 9216 && n0 < 11264))) ? QSCALE : 1.0f;
    J.drow = (mode == 1 || mode == 2) ? 256 * (n0 >> 7) + (n0 & 127) + (mode == 2 ? 128 : 0) : n0;
}
__device__ __forceinline__ void cvt_load(const CvtJob& J, int lane, f32x4 (&v)[16]) {
    const float* p = J.W + (size_t)(J.k0 + 16 * (lane >> 4)) * J.N + J.n0 + 4 * (lane & 15);
#pragma unroll
    for (int i = 0; i < 16; ++i) v[i] = __builtin_nontemporal_load((const f32x4*)(p + (size_t)i * J.N));
}
__device__ __forceinline__ void cvt_store(const CvtJob& J, const f32x4 (&v)[16], LAS unsigned char* img, int lane) {
    const int g = lane >> 4, i15 = lane & 15;
    f32x4 gq[4];
#pragma unroll
    for (int j = 0; j < 4; ++j) gq[j] = J.gain ? *(const f32x4*)(J.gain + J.k0 + 16 * g + 4 * j) * J.cs : (f32x4){J.cs, J.cs, J.cs, J.cs};
#pragma unroll
    for (int i = 0; i < 16; ++i) { const f32x4 f = v[i] * gq[i >> 2][i & 3]; v2u w; w.x = pk2(f[0], f[1]); w.y = pk2(f[2], f[3]); *(LAS v2u*)(img + (16 * g + i) * 192 + 8 * i15) = w; }
    const int q = i15 >> 2, p = lane & 3;
    bf16* op = J.WT + (size_t)(J.drow + 16 * g + i15) * J.ldT + J.kcol0;
#pragma unroll
    for (int s = 0; s < 8; ++s) {
        const s16x4 lo = __builtin_bit_cast(s16x4, __builtin_amdgcn_ds_read_tr16_b64_v4i16((LAS s16x4*)(img + (8 * s + q) * 192 + 32 * g + 8 * p)));
        const s16x4 hi = __builtin_bit_cast(s16x4, __builtin_amdgcn_ds_read_tr16_b64_v4i16((LAS s16x4*)(img + (8 * s + 4 + q) * 192 + 32 * g + 8 * p)));
        const bf16x8 o = __builtin_shufflevector(lo, hi, 0, 1, 2, 3, 4, 5, 6, 7);
        *(bf16x8*)(op + 8 * s) = o;
    }
}
struct Ptrs;
template <int SET> __device__ __forceinline__ void cvt_decode(const Ptrs& P, int it, CvtJob& J);

__device__ __forceinline__ void sincos_acc(float a, float& s, float& c) {
    const double x = (double)a;
    const double kq = __builtin_rint(x * 0.63661977236758134308);
    double r = __builtin_fma(-kq, 1.57079632679489655800e+00, x);
    r = __builtin_fma(-kq, 6.12323399573676603587e-17, r);
    const int q = (int)((long long)kq) & 3;
    const double r2 = r * r;
    const double sp = r * (1.0 + r2 * (-1.0 / 6.0 + r2 * (1.0 / 120.0 + r2 * (-1.0 / 5040.0 + r2 * (1.0 / 362880.0 + r2 * (-1.0 / 39916800.0 + r2 * (1.0 / 6227020800.0)))))));
    const double cp = 1.0 + r2 * (-0.5 + r2 * (1.0 / 24.0 + r2 * (-1.0 / 720.0 + r2 * (1.0 / 40320.0 + r2 * (-1.0 / 3628800.0 + r2 * (1.0 / 479001600.0))))));
    const double ss = (q & 1) ? cp : sp, cc = (q & 1) ? sp : cp;
    s = (float)((q & 2) ? -ss : ss);
    c = (float)(((q + 1) & 2) ? -cc : cc);
}

struct Ptrs {
    const float* xp; const float* xs; const float* g1; const float* w1g; const float* w1u; const float* w1d; const float* gmix; const float* win; const float* sink;
    const float* wa; const float* wb; const float* wout; const float* g2; const float* w2g; const float* w2u; const float* w2d; const float* gfin;
    float* out; unsigned char* ws;
};

constexpr int CI_GU = (D / 64) * (FF / 64), CI_D = (FF / 64) * (D / 64), CI_IN = (D / 64) * (NIN / 64), CI_A = (1024 / 64) * (D / 64), CI_B = (2048 / 64) * (D / 64), CI_O = (D / 64) * (D / 64);
template <> __device__ __forceinline__ void cvt_decode<0>(const Ptrs& P, int it, CvtJob& J) {
    bf16* WGU = (bf16*)(P.ws + WS_WGU); bf16* WD = (bf16*)(P.ws + WS_WD); bf16* WIN = (bf16*)(P.ws + WS_WIN); bf16* WAB = (bf16*)(P.ws + WS_WAB); bf16* WOUT = (bf16*)(P.ws + WS_WOUT);
    int r = it;
    if (r < CI_GU) { cvt_job(J, P.w1g, FF, P.g1, WGU, D, 0, 1, r); return; } r -= CI_GU;
    if (r < CI_GU) { cvt_job(J, P.w1u, FF, P.g1, WGU, D, 0, 2, r); return; } r -= CI_GU;
    if (r < CI_D)  { cvt_job(J, P.w1d, D, nullptr, WD, FF, 0, 0, r); return; } r -= CI_D;
    if (r < CI_IN) { cvt_job(J, P.win, NIN, P.gmix, WIN, D, 0, 3, r); return; } r -= CI_IN;
    if (r < CI_A)  { cvt_job(J, P.wa, D, nullptr, WAB, YABW, 0, 0, r); return; } r -= CI_A;
    if (r < CI_B)  { cvt_job(J, P.wb, D, nullptr, WAB, YABW, 1024, 0, r); return; } r -= CI_B;
    cvt_job(J, P.wout, D, nullptr, WOUT, D, 0, 0, r);
}
template <> __device__ __forceinline__ void cvt_decode<1>(const Ptrs& P, int it, CvtJob& J) {
    bf16* WGU = (bf16*)(P.ws + WS_WGU); bf16* WD = (bf16*)(P.ws + WS_WD);
    int r = it;
    if (r < CI_GU) { cvt_job(J, P.w2g, FF, P.g2, WGU, D, 0, 1, r); return; } r -= CI_GU;
    if (r < CI_GU) { cvt_job(J, P.w2u, FF, P.g2, WGU, D, 0, 2, r); return; } r -= CI_GU;
    cvt_job(J, P.w2d, D, nullptr, WD, FF, 0, 0, r);
}
template <int SET> __device__ __forceinline__ void cvt_run(Frame& F, const Ptrs& P) {
    constexpr int NITEMS = SET == 0 ? 2 * CI_GU + CI_D + CI_IN + CI_A + CI_B + CI_O : 2 * CI_GU + CI_D;
    LAS unsigned char* img = F.lds + RING_OFF + F.wave * 16384;
    const int gw = F.vcu * NWAVES + F.wave, NGW = F.G * NWAVES, lane = F.lane;
    f32x4 va[16], vb[16]; CvtJob Ja, Jb;
    int it = gw;
    if (it >= NITEMS) return;
    cvt_decode<SET>(P, it, Ja); cvt_load(Ja, lane, va);
    for (;;) {
        int nx = it + NGW;
        cvt_decode<SET>(P, nx < NITEMS ? nx : NITEMS - 1, Jb); cvt_load(Jb, lane, vb);
        cvt_store(Ja, va, img, lane);
        it = nx; if (it >= NITEMS) break;
        nx = it + NGW;
        cvt_decode<SET>(P, nx < NITEMS ? nx : NITEMS - 1, Ja); cvt_load(Ja, lane, va);
        cvt_store(Jb, vb, img, lane);
        it = nx; if (it >= NITEMS) break;
    }
}
__device__ __forceinline__ void p0_prologue(Frame& F, const Ptrs& P) {
    const int gw = F.vcu * NWAVES + F.wave, NGW = F.G * NWAVES;
    { float* tab = (float*)(P.ws + WS_ROPE);
      const float inv[16] = {1.000000000e+00f, 4.403665960e-01f, 1.939227432e-01f, 8.539710194e-02f, 3.760603070e-02f, 1.656044088e-02f, 7.292664610e-03f, 3.211446106e-03f,
                             1.414213562e-03f, 6.227724371e-04f, 2.742481884e-04f, 1.207697351e-04f, 5.318295734e-05f, 2.341999971e-05f, 1.031338525e-05f, 4.541670478e-06f};
      for (int pos = gw * 64 + F.lane; pos < 16384; pos += NGW * 64) {
#pragma unroll
          for (int i = 0; i < 16; ++i) { const float ang = (float)pos * inv[i]; float s, c; sincos_acc(ang, s, c); tab[(size_t)pos * 32 + i] = c; tab[(size_t)pos * 32 + 16 + i] = s; } } }
    { bf16* XB = (bf16*)(P.ws + WS_AB1); float* ss0 = (float*)(P.ws + WS_SS0);
      for (int m = gw; m < M; m += NGW) { const float* xrow = (m < M_P) ? P.xp + (size_t)m * D : P.xs + (size_t)(m - M_P) * D;
          const GAS f32x4* xr = (const GAS f32x4*)xrow + F.lane; GAS v2u* o8 = (GAS v2u*)(XB + (size_t)m * D) + F.lane; float s = 0.f;
#pragma unroll
          for (int j = 0; j < 16; ++j) { const f32x4 v = xr[64 * j]; s += (v.x * v.x + v.y * v.y) + (v.z * v.z + v.w * v.w); v2u w; w.x = pk2(v.x, v.y); w.y = pk2(v.z, v.w); o8[64 * j] = w; }
          s = wave_sum(s); if (F.lane == 0) ss0[m] = s; } }
    cvt_run<0>(F, P);
}
__device__ __forceinline__ void p4_convert_w2(Frame& F, const Ptrs& P) { cvt_run<1>(F, P); }

__device__ __forceinline__ unsigned off_b(unsigned row, unsigned ch) { return 256u * row + 16u * (ch ^ (((row & 3) << 2) | ((row >> 2) & 3))); }
struct AttState { float m, l; f32x4 O[8]; };

__device__ __forceinline__ void k_load(bf16x8 (&kf)[2][4], const bf16* Kb, int S, int tb, int dil, int lane) {
    const int i = lane & 15, g = lane >> 4;
    const int kk_a = 8 * (i >> 2) + (i & 3);
#pragma unroll
    for (int t = 0; t < 2; ++t) { int tk = tb + dil * (kk_a + 4 * t); tk = max(0, min(tk, S - 1)); const bf16* kp = Kb + (size_t)tk * QKVW + 32 * g;
#pragma unroll
        for (int s = 0; s < 4; ++s) kf[t][s] = *(const bf16x8*)(kp + 8 * s); }
}
__device__ __forceinline__ void v_dma(LAS unsigned char* vbuf, const bf16* Vb, int S, int tb, int dil, int lane) {
    const int i = lane & 15, g = lane >> 4;
#pragma unroll
    for (int c = 0; c < 8; ++c) { int tk = tb + dil * (4 * c + g); tk = max(0, min(tk, S - 1)); const int ch = i ^ ((g << 2) | (c & 3));
        __builtin_amdgcn_global_load_lds((const unsigned*)(Vb + (size_t)tk * QKVW + 8 * ch), (LAS unsigned*)(vbuf + 1024 * c), 16, 0, 0); }
    asm volatile("" ::: "memory");
}
__device__ __forceinline__ void kv_compute(AttState& st, const bf16x8 (&kf)[2][4], const bf16x8 (&qf)[4], int S, int tq, int tb, int dil, int W, LAS unsigned char* vbuf, int lane_,
                                           bool pf, bf16x8 (&kn)[2][4], LAS unsigned char* vnext, const bf16* Kb, const bf16* Vb, int tbn) {
    int lane = lane_; asm volatile("" : "+v"(lane));
    const int g = lane >> 4;
    f32x4 sc[2];
#pragma unroll
    for (int t = 0; t < 2; ++t) { sc[t] = (f32x4){0.f, 0.f, 0.f, 0.f};
#pragma unroll
        for (int s = 0; s < 4; ++s) sc[t] = __builtin_amdgcn_mfma_f32_16x16x32_bf16(kf[t][s], qf[s], sc[t], 0, 0, 0); }
    if (pf) { v_dma(vnext, Vb, S, tbn, dil, lane_); k_load(kn, Kb, S, tbn, dil, lane_); }
    float mx = -1e30f;
#pragma unroll
    for (int t = 0; t < 2; ++t)
#pragma unroll
        for (int r = 0; r < 4; ++r) { const int tk = tb + dil * (8 * g + 4 * t + r); const int d = tk - tq; const bool ok = (d <= W) && (d >= -W) && (tk >= 0) && (tk < S);
            sc[t][r] = ok ? sc[t][r] : -__builtin_inff(); mx = fmaxf(mx, sc[t][r]); }
    mx = fmaxf(mx, __shfl_xor(mx, 16)); mx = fmaxf(mx, __shfl_xor(mx, 32));
    const float mn = fmaxf(st.m, mx), alpha = __builtin_amdgcn_exp2f(st.m - mn);
    float ps = 0.f; float p[8];
#pragma unroll
    for (int t = 0; t < 2; ++t)
#pragma unroll
        for (int r = 0; r < 4; ++r) { p[4 * t + r] = __builtin_amdgcn_exp2f(sc[t][r] - mn); ps += p[4 * t + r]; }
    st.l = st.l * alpha + ps; st.m = mn;
#pragma unroll
    for (int dt = 0; dt < 8; ++dt) st.O[dt] *= alpha;
    v4u pw; pw.x = pk2(p[0], p[1]); pw.y = pk2(p[2], p[3]); pw.z = pk2(p[4], p[5]); pw.w = pk2(p[6], p[7]);
    const bf16x8 pf16 = __builtin_bit_cast(bf16x8, pw);
    if (pf) asm volatile("s_waitcnt vmcnt(16)" ::: "memory"); else asm volatile("s_waitcnt vmcnt(0)" ::: "memory");
    const unsigned q = (lane & 15) >> 2, pp = lane & 3, vb = (unsigned)(uintptr_t)vbuf;
    unsigned a[16]; s16x4 f[16];
#pragma unroll
    for (int dt = 0; dt < 8; ++dt) { a[2 * dt] = vb + off_b(8 * g + q, 2 * dt + (pp >> 1)) + 8 * (pp & 1); a[2 * dt + 1] = vb + off_b(8 * g + 4 + q, 2 * dt + (pp >> 1)) + 8 * (pp & 1); }
#define TR4(k) asm volatile("ds_read_b64_tr_b16 %0, %4\n\tds_read_b64_tr_b16 %1, %5\n\tds_read_b64_tr_b16 %2, %6\n\tds_read_b64_tr_b16 %3, %7" \
        : "=&v"(f[k]), "=&v"(f[k + 1]), "=&v"(f[k + 2]), "=&v"(f[k + 3]) : "v"(a[k]), "v"(a[k + 1]), "v"(a[k + 2]), "v"(a[k + 3]) : "memory")
    TR4(0); TR4(4); TR4(8); TR4(12);
#undef TR4
    asm volatile("s_waitcnt lgkmcnt(0)" : "+v"(f[0]), "+v"(f[1]), "+v"(f[2]), "+v"(f[3]), "+v"(f[4]), "+v"(f[5]), "+v"(f[6]), "+v"(f[7]) :: "memory");
    asm volatile("" : "+v"(f[8]), "+v"(f[9]), "+v"(f[10]), "+v"(f[11]), "+v"(f[12]), "+v"(f[13]), "+v"(f[14]), "+v"(f[15]));
#pragma unroll
    for (int dt = 0; dt < 8; ++dt) {
        const bf16x8 vf = __builtin_shufflevector(f[2 * dt], f[2 * dt + 1], 0, 1, 2, 3, 4, 5, 6, 7);
        st.O[dt] = __builtin_amdgcn_mfma_f32_16x16x32_bf16(vf, pf16, st.O[dt], 0, 0, 0);
    }
}
__device__ __forceinline__ void attn_keys(AttState& st, const bf16x8 (&qf)[4], const bf16* Kb, const bf16* Vb, int S, int tq, int kstart, int dil, int ntiles, int W, LAS unsigned char* vl, int lane) {
    bf16x8 ka[2][4], kb[2][4]; const int tstep = 32 * dil;
    LAS unsigned char* v0 = vl; LAS unsigned char* v1 = vl + 8192;
    v_dma(v0, Vb, S, kstart, dil, lane); k_load(ka, Kb, S, kstart, dil, lane);
    for (int tile = 0; tile < ntiles; tile += 2) {
        const int tb = kstart + tile * tstep;
        const bool m1 = tile + 1 < ntiles;
        kv_compute(st, ka, qf, S, tq, tb, dil, W, v0, lane, m1, kb, v1, Kb, Vb, tb + tstep);
        if (!m1) break;
        const bool m2 = tile + 2 < ntiles;
        kv_compute(st, kb, qf, S, tq, tb + tstep, dil, W, v1, lane, m2, ka, v0, Kb, Vb, tb + 2 * tstep);
    }
}

__device__ __forceinline__ void attn_phase(Frame& F, const Ptrs& P) {
    const bf16* QKV = (const bf16*)(P.ws + WS_QKV); bf16* YAB = (bf16*)(P.ws + WS_AB1);
    LAS unsigned char* vl = F.lds + RING_OFF + F.wave * 16384;
    const int gw = F.vcu * NWAVES + F.wave, NGW = F.G * NWAVES, lane = F.lane, i = lane & 15, g = lane >> 4;
    { constexpr int NT = (M / 256) * 8 * 16; const int chunk = (NT + NGW - 1) / NGW;
      for (int id = gw * chunk; id < NT && id < (gw + 1) * chunk; ++id) {
          const int r16 = id & 15, h = (id >> 4) & 7, rb = id >> 7;
          const int row_blk = rb * 256; const int seq0 = row_blk < 4096 ? 0 : (row_blk < 8192 ? 4096 : 8192); const int S = row_blk < 8192 ? 4096 : 16384;
          const int t0 = row_blk - seq0 + r16; const int tq = t0 + 16 * i;
          AttState st; st.m = -1e30f; st.l = 0.f;
#pragma unroll
          for (int dt = 0; dt < 8; ++dt) st.O[dt] = (f32x4){0.f, 0.f, 0.f, 0.f};
          const bf16* seqbase = QKV + (size_t)seq0 * QKVW;
#pragma unroll 1
          for (int grp = 0; grp < 3; ++grp) {
              const int dil = grp == 0 ? 1 : (grp == 1 ? 4 : 16); const int ntiles = grp == 0 ? 12 : (grp == 1 ? 6 : 5);
              const int hc = grp * 1024 + h * 128;
              bf16x8 qf[4]; { const bf16* qp = seqbase + (size_t)tq * QKVW + hc + 32 * g;
#pragma unroll
                  for (int s = 0; s < 4; ++s) qf[s] = *(const bf16x8*)(qp + 8 * s); }
              attn_keys(st, qf, seqbase + 3072 + hc, seqbase + 6144 + hc, S, tq, t0 - 64 * dil, dil, ntiles, 64 * dil, vl, lane);
          }
          float l = st.l; l += __shfl_xor(l, 16); l += __shfl_xor(l, 32); const float rl = 1.0f / l;
          bf16* op = YAB + (size_t)(seq0 + tq) * YABW + h * 128 + 4 * g;
#pragma unroll
          for (int dt = 0; dt < 8; ++dt) { const f32x4 o = st.O[dt] * rl; v2u w; w.x = pk2(o[0], o[1]); w.y = pk2(o[2], o[3]); *(v2u*)(op + 16 * dt) = w; }
      } }
    { constexpr int NT = (M / 16) * 16; const int chunk = (NT + NGW - 1) / NGW;
      for (int id = gw * chunk; id < NT && id < (gw + 1) * chunk; ++id) {
          const int qh = id & 15, blk = id >> 4; const int row0 = blk * 16;
          const int seq0 = row0 < 4096 ? 0 : (row0 < 8192 ? 4096 : 8192); const int S = row0 < 8192 ? 4096 : 16384;
          const int t0 = row0 - seq0; const int tq = t0 + i;
          AttState st; st.m = -1e30f; st.l = 0.f;
#pragma unroll
          for (int dt = 0; dt < 8; ++dt) st.O[dt] = (f32x4){0.f, 0.f, 0.f, 0.f};
          const bf16* seqbase = QKV + (size_t)seq0 * QKVW; const int kvh = qh >> 2;
          bf16x8 qf[4]; { const bf16* qp = seqbase + (size_t)tq * QKVW + 9216 + qh * 128 + 32 * g;
#pragma unroll
              for (int s = 0; s < 4; ++s) qf[s] = *(const bf16x8*)(qp + 8 * s); }
          attn_keys(st, qf, seqbase + 11264 + kvh * 128, seqbase + 11776 + kvh * 128, S, tq, t0 - 128, 1, 9, 128, vl, lane);
          float l = st.l; l += __shfl_xor(l, 16); l += __shfl_xor(l, 32);
          const float sk = P.sink[qh] * 1.4426950408889634f; const float m2 = fmaxf(st.m, sk); const float e1 = __builtin_amdgcn_exp2f(st.m - m2);
          const float den = l * e1 + __builtin_amdgcn_exp2f(sk - m2); const float rl = e1 / den;
          bf16* op = YAB + (size_t)(seq0 + tq) * YABW + 1024 + qh * 128 + 4 * g;
#pragma unroll
          for (int dt = 0; dt < 8; ++dt) { const f32x4 o = st.O[dt] * rl; v2u w; w.x = pk2(o[0], o[1]); w.y = pk2(o[2], o[3]); *(v2u*)(op + 16 * dt) = w; }
      } }
}

__device__ __forceinline__ void final_norm(Frame& F, const Ptrs& P) {
    const int gw = F.vcu * NWAVES + F.wave, NGW = F.G * NWAVES; const float* ss3 = (const float*)(F.ctl + CW_SS3);
    f32x4 gv[16];
#pragma unroll
    for (int j = 0; j < 16; ++j) gv[j] = ((const f32x4*)P.gfin)[F.lane + 64 * j];
    for (int m = gw; m < M; m += NGW) { const float rs = __builtin_amdgcn_rsqf(ss3[m] * (1.0f / 4096.0f) + 1e-6f); GAS f32x4* o = (GAS f32x4*)(P.out + (size_t)m * D) + F.lane;
#pragma unroll
        for (int j = 0; j < 16; ++j) { const f32x4 v = o[64 * j]; o[64 * j] = v * rs * gv[j]; } }
}

struct Args { const float* in[17]; float* out; unsigned char* ws; int ph_lo, ph_hi, li, pad; };
__global__ void __launch_bounds__(NWAVES * 64, 2) mk_fwd(Args args) {
    extern __shared__ __attribute__((aligned(16))) unsigned char lds[];
    Frame F;
    F.lds = (LAS unsigned char*)lds;
    F.MISC = (volatile LAS unsigned*)(F.lds + MISC_OFF);
    F.tid = threadIdx.x; F.lane = F.tid & 63; F.wave = __builtin_amdgcn_readfirstlane(F.tid >> 6);
    F.G = gridDim.x; { const int bx = blockIdx.x; F.vcu = (F.G % 8 == 0) ? (bx % 8) * (F.G / 8) + bx / 8 : bx; }
    unsigned char* ws = args.ws;
    F.ctl = (gu32*)(ws + WS_CTL);
    Ptrs P;
    P.xp = args.in[0]; P.xs = args.in[1]; P.g1 = args.in[2]; P.w1g = args.in[3]; P.w1u = args.in[4]; P.w1d = args.in[5]; P.gmix = args.in[6]; P.win = args.in[7]; P.sink = args.in[8];
    P.wa = args.in[9]; P.wb = args.in[10]; P.wout = args.in[11]; P.g2 = args.in[12]; P.w2g = args.in[13]; P.w2u = args.in[14]; P.w2d = args.in[15]; P.gfin = args.in[16];
    P.out = args.out; P.ws = ws;
    for (int u = F.tid; u < (LDS_BYTES - LDSCTL_OFF) / 4; u += NWAVES * 64) ((LAS unsigned*)(F.lds + LDSCTL_OFF))[u] = 0u;
    __syncthreads();
    XcdBarrier bar; bar.bar = (unsigned*)(F.ctl + CW_BAR); bar.x = 0; bar.st = nullptr;
    if (N_LAUNCHES != PER_PHASE) bar = xcd_barrier_post((unsigned*)(F.ctl + CW_BAR), F.MISC + 8);
#define GRID_BAR(seam) do { if (N_LAUNCHES != PER_PHASE) xcd_barrier(bar); } while (0)
    const int lo = args.ph_lo, hi = args.ph_hi;
#define IN(k) (lo <= (k) && (k) < hi)
#define BOTH(k) (IN(k) && IN((k) + 1))
    bf16* AB1 = (bf16*)(ws + WS_AB1); bf16* ACT = (bf16*)(ws + WS_ACT); bf16* QKVB = (bf16*)(ws + WS_QKV);
    bf16* WGU = (bf16*)(ws + WS_WGU); bf16* WDN = (bf16*)(ws + WS_WD); bf16* WIN = (bf16*)(ws + WS_WIN); bf16* WAB = (bf16*)(ws + WS_WAB); bf16* WOUT = (bf16*)(ws + WS_WOUT);
    float* ss0 = (float*)(ws + WS_SS0); float* ss1 = (float*)(F.ctl + CW_SS1); float* ss2 = (float*)(F.ctl + CW_SS2); float* ss3 = (float*)(F.ctl + CW_SS3);
    const float* rope = (const float*)(ws + WS_ROPE);

    if (IN(0)) { for (int rep = 0; rep < NREP(0); ++rep) p0_prologue(F, P); if (BOTH(0)) GRID_BAR(0); }
    if (IN(1)) { pg8::Gemm g{AB1, WGU, M, 2 * FF, D}; pg8::StaticOrder S; S.init(M, 2 * FF, F.G, (int)blockIdx.x);
        pg8::EpiSwiglu E{ACT, FF, ss0};
        for (int rep = 0; rep < NREP(1); ++rep)
        pg8::gemm_phase<pg8::EpiSwiglu, pg8::StaticOrder, PG8_ALIGN, PG8_SP2>(F.lds + RING_OFF, g, S, E);
        if (BOTH(1)) GRID_BAR(1); }
    if (IN(2)) { pg8::Gemm g{ACT, WDN, M, D, FF}; pg8::StaticOrder S; S.init(M, D, F.G, (int)blockIdx.x);
        pg8::EpiResid<true> E{P.xp, P.xs, M_P, P.out, AB1, ss1, 0.5f};
        for (int rep = 0; rep < NREP(2); ++rep) { if (rep) E.ss = (float*)(ws + WS_END);
        pg8::gemm_phase<pg8::EpiResid<true>, pg8::StaticOrder, PG8_ALIGN, PG8_SP2>(F.lds + RING_OFF, g, S, E); }
        if (BOTH(2)) GRID_BAR(2); }
    if (IN(3)) { pg8::Gemm g{AB1, WIN, M, NIN, D}; pg8::StaticOrder S; S.init(M, NIN, F.G, (int)blockIdx.x);
        pg8::EpiProj E{QKVB, ACT, ss1, rope};
        pg8::gemm_phase<pg8::EpiProj, pg8::StaticOrder, PG8_ALIGN, PG8_SP2>(F.lds + RING_OFF, g, S, E);
        if (NREP(3) == 2) pg8::gemm_phase<pg8::EpiProj, pg8::StaticOrder, PG8_ALIGN, PG8_SP2>(F.lds + RING_OFF, g, S, E);
        if (BOTH(3)) GRID_BAR(3); }
    if (IN(4)) { for (int rep = 0; rep < NREP(4); ++rep) attn_phase(F, P); for (int rep = 0; rep < NREP(14); ++rep) p4_convert_w2(F, P); if (BOTH(4)) GRID_BAR(4); }
    if (IN(5)) { pg8::Gemm g{AB1, WAB, M, D, YABW}; pg8::StaticOrder S; S.init(M, D, F.G, (int)blockIdx.x);
        pg8::EpiMerge E{ACT, QKVB};
        for (int rep = 0; rep < NREP(5); ++rep)
        pg8::gemm_phase<pg8::EpiMerge, pg8::StaticOrder, PG8_ALIGN, PG8_SP2>(F.lds + RING_OFF, g, S, E);
        if (BOTH(5)) GRID_BAR(5); }
    if (IN(6)) { pg8::Gemm g{QKVB, WOUT, M, D, D}; pg8::StaticOrder S; S.init(M, D, F.G, (int)blockIdx.x);
        pg8::EpiResid<true> E{P.out, P.out, M, P.out, AB1, ss2, 1.0f};
        for (int rep = 0; rep < NREP(6); ++rep) { if (rep) { E.ss = (float*)(ws + WS_END); E.scale = 0.f; }
        pg8::gemm_phase<pg8::EpiResid<true>, pg8::StaticOrder, PG8_ALIGN, PG8_SP2>(F.lds + RING_OFF, g, S, E); }
        if (BOTH(6)) GRID_BAR(6); }
    if (IN(7)) { pg8::Gemm g{AB1, WGU, M, 2 * FF, D}; pg8::StaticOrder S; S.init(M, 2 * FF, F.G, (int)blockIdx.x);
        pg8::EpiSwiglu E{ACT, FF, ss2};
        pg8::gemm_phase<pg8::EpiSwiglu, pg8::StaticOrder, PG8_ALIGN, PG8_SP2>(F.lds + RING_OFF, g, S, E);
        if (BOTH(7)) GRID_BAR(7); }
    if (IN(8)) { pg8::Gemm g{ACT, WDN, M, D, FF}; pg8::StaticOrder S; S.init(M, D, F.G, (int)blockIdx.x);
        pg8::EpiResid<false> E{P.out, P.out, M, P.out, nullptr, ss3, 0.5f};
        pg8::gemm_phase<pg8::EpiResid<false>, pg8::StaticOrder, PG8_ALIGN, PG8_SP2>(F.lds + RING_OFF, g, S, E);
        if (BOTH(8)) GRID_BAR(8); }
    if (IN(9)) { final_norm(F, P); }
#undef IN
#undef BOTH
#undef GRID_BAR
}

extern "C" void kernel_launch(void* const* d_in, const int* in_sizes, int n_in, void* d_out, int out_size, void* d_ws, size_t ws_size, hipStream_t stream) {
    static int grid = 0;
    if (grid == 0) {
        if (n_in != 17 || out_size != M * D || ws_size < WS_END) { fprintf(stderr, "kernel_launch: unexpected shapes (n_in %d, out %d, ws %zu, need %zu)\n", n_in, out_size, ws_size, (size_t)WS_END); grid = -1; return; }
        int dev = 0, cus = 0, per_cu = 0;
        if (hipGetDevice(&dev) != hipSuccess || hipDeviceGetAttribute(&cus, hipDeviceAttributeMultiprocessorCount, dev) != hipSuccess) { grid = -1; return; }
        if (hipFuncSetAttribute((const void*)mk_fwd, hipFuncAttributeMaxDynamicSharedMemorySize, LDS_BYTES) != hipSuccess) { fprintf(stderr, "kernel_launch: hipFuncSetAttribute failed\n"); grid = -1; return; }
        if (hipOccupancyMaxActiveBlocksPerMultiprocessor(&per_cu, (const void*)mk_fwd, NWAVES * 64, LDS_BYTES) != hipSuccess || per_cu < 1) { fprintf(stderr, "kernel_launch: occupancy query says %d\n", per_cu); }
        (void)hipGetLastError();
        grid = cus;
    }
    if (grid < 0) return;
    (void)hipMemsetAsync((char*)d_ws + WS_CTL, 0, CTL_ZERO_BYTES, stream);
    Args a{};
    for (int i = 0; i < 17; ++i) a.in[i] = (const float*)d_in[i];
    a.out = (float*)d_out; a.ws = (unsigned char*)d_ws; a.pad = 0;
    for (int li = 0; li < N_LAUNCHES; ++li) {
        a.ph_lo = (N_LAUNCHES == PER_PHASE) ? li : 0; a.ph_hi = (N_LAUNCHES == PER_PHASE) ? li + 1 : PER_PHASE; a.li = li;
        hipLaunchKernelGGL(mk_fwd, dim3(grid), dim3(NWAVES * 64), LDS_BYTES, stream, a);
    }
}
```

```cpp
#include <hip/hip_runtime.h>
#include <cstdio>
#include <cstdint>

#ifndef MK_N_LAUNCHES
#define MK_N_LAUNCHES 1
#endif
#ifndef PROBE_REPEAT
#define PROBE_REPEAT -1
#endif
#define NREP(k) ((PROBE_REPEAT == (k)) ? 2 : 1)
#ifndef WGM_DOWN
#define WGM_DOWN 4
#endif
#ifndef WGM_UP
#define WGM_UP 8
#endif
#ifndef WGM_IN
#define WGM_IN 8
#endif
#ifndef RES_DEPTH
#define RES_DEPTH 8
#endif
#ifndef RES_DEPTH_F
#define RES_DEPTH_F 4
#endif
#ifndef STAGGER_TICKS
#define STAGGER_TICKS 0
#endif

namespace pg8 {
#define PG8_LAS __attribute__((address_space(3)))
typedef unsigned short bf16_t;
typedef short bf16x8 __attribute__((ext_vector_type(8)));
typedef float f32x4 __attribute__((ext_vector_type(4)));
typedef unsigned u32x4 __attribute__((ext_vector_type(4)));
constexpr int BM = 256, BK = 64, HALF = 128, HTB = HALF * BK * 2, STAGE_BYTES = 8 * HTB, NXCD = 8, WGM = 8;

__host__ __device__ __forceinline__ int lds_byte(int r, int c) { const int st = (r >> 4) * 2 + (c >> 5), rr = r & 15, cc = c & 31, ob = rr * 64 + cc * 2; return st * 1024 + (ob ^ (((ob >> 9) & 1) << 5)); }
__host__ __device__ __forceinline__ void stage_rc(int b, int& R, int& C) { const int st = b / 1024, sb = b % 1024, swz = sb ^ (((sb >> 9) & 1) << 5); R = (st >> 1) * 16 + swz / 64; C = (st & 1) * 32 + (swz % 64) / 2; }
__host__ __device__ __forceinline__ int perm32(int rho) { const int n = rho >> 4, i = rho & 15; return 8 * (i >> 2) + 4 * n + (i & 3); }

struct Unit { int pm, pn; };
__device__ __forceinline__ void ss_prefetch(const float* ss, PG8_LAS unsigned char* ssl, int pm, int wid, int lane) {
    const float* src = ss + pm * 256 + (wid >> 2) * 64 + lane;
    __builtin_amdgcn_global_load_lds((const unsigned*)src, (PG8_LAS unsigned*)(ssl + wid * 512), 4, 0, 0);
    __builtin_amdgcn_global_load_lds((const unsigned*)(src + 128), (PG8_LAS unsigned*)(ssl + wid * 512 + 256), 4, 0, 0);
}
__device__ __forceinline__ float ss_lds(PG8_LAS unsigned char* ssl, int wr, int wc, int fr, int ai, int m) { return *(const PG8_LAS float*)(ssl + (wr * 4 + wc) * 512 + ai * 256 + (m * 16 + fr) * 4); }
struct Gemm { const bf16_t* A; const bf16_t* Bt; int M, N, K; };

struct StaticOrder {
    int nM, nN, nwg, G, c, wgm;
    __host__ __device__ void init(int M, int N, int G_, int c_, int wgm_ = WGM) { nM = M / BM; nN = N / BM; nwg = nM * nN; G = G_; c = c_; wgm = wgm_; }
    __host__ __device__ bool next(int i, Unit& u) const {
        const long L = (long)i * G + c; if (L >= nwg) return false;
        int wgid = (int)L; { const int q = nwg / NXCD, r = nwg % NXCD, xcd = wgid % NXCD, off = wgid / NXCD; wgid = (xcd < r ? xcd * (q + 1) : r * (q + 1) + (xcd - r) * q) + off; }
        const int nig = wgm * nN, gid = wgid / nig, fm = gid * wgm, gsz = (nM - fm) < wgm ? (nM - fm) : wgm;
        u.pm = fm + ((wgid % nig) % gsz); u.pn = (wgid % nig) / gsz; return true;
    }
    __device__ __forceinline__ void a_ready(const Unit&) const {}
    __device__ __forceinline__ void done(const Unit&) const {}
};

struct FixedOrder : StaticOrder {
    __host__ __device__ bool next(int i, Unit& u) const { Unit t; if (!StaticOrder::next(i, t)) return false; u.pm = 0; u.pn = 0; return true; }
};
__device__ __forceinline__ unsigned cvt_pk_bf16(float lo, float hi) { unsigned r; asm volatile("v_cvt_pk_bf16_f32 %0, %1, %2" : "=v"(r) : "v"(lo), "v"(hi)); return r; }
__device__ __forceinline__ float bf_lo(unsigned w) { return __uint_as_float(w << 16); }
__device__ __forceinline__ float bf_hi(unsigned w) { return __uint_as_float(w & 0xffff0000u); }
__device__ __forceinline__ float sigmoid_f(float x) { return __builtin_amdgcn_rcpf(1.0f + __builtin_amdgcn_exp2f(-1.44269504089f * x)); }


template <int MODE> struct EpiSwigluT {
    static constexpr bool PERM = true, AFTER_DRAIN = false, HAS_MID = false, SS_LDS = true; static constexpr int MID_T = 0, VM_TAIL = (MODE & 1) ? 0 : 8;
    bf16_t* O; int ldc; const float* ss; PG8_LAS unsigned char* ssl;
    __device__ __forceinline__ void mid(f32x4 (&)[2][2][4][2], const Unit&, int, int, int, int) const {}
    __device__ __forceinline__ void operator()(f32x4 (&acc)[2][2][4][2], const Unit& u, int wr, int wc, int fr, int fq) const {
        const int row0 = u.pm * BM + wr * 64 + fr, col0 = u.pn * HALF + wc * 32 + 8 * fq;
        float rs[2][4];
#pragma unroll
        for (int ai = 0; ai < 2; ++ai)
#pragma unroll
            for (int m = 0; m < 4; ++m) rs[ai][m] = (MODE & 2) ? 4096.0f * (float)(fr + 1) : ss_lds(ssl, wr, wc, fr, ai, m);
#pragma unroll
        for (int ai = 0; ai < 2; ++ai)
#pragma unroll
            for (int m = 0; m < 4; ++m) { const int r = row0 + ai * HALF + m * 16; const float rr = __builtin_amdgcn_rsqf(rs[ai][m] * (1.0f / 4096.0f) + 1e-6f);
                const float c1 = -1.44269504089f * rr, rr2 = rr * rr; f32x4 o[2];
#pragma unroll
                for (int n = 0; n < 2; ++n) { const f32x4 g = acc[ai][0][m][n], up = acc[ai][1][m][n]; const f32x4 t = g * c1;
                    f32x4 d = {__builtin_amdgcn_exp2f(t[0]), __builtin_amdgcn_exp2f(t[1]), __builtin_amdgcn_exp2f(t[2]), __builtin_amdgcn_exp2f(t[3])}; d = d + 1.0f;
                    const f32x4 q = {__builtin_amdgcn_rcpf(d[0]), __builtin_amdgcn_rcpf(d[1]), __builtin_amdgcn_rcpf(d[2]), __builtin_amdgcn_rcpf(d[3])};
                    o[n] = ((g * up) * rr2) * q; }
                u32x4 w; w.x = cvt_pk_bf16(o[0][0], o[0][1]); w.y = cvt_pk_bf16(o[0][2], o[0][3]); w.z = cvt_pk_bf16(o[1][0], o[1][1]); w.w = cvt_pk_bf16(o[1][2], o[1][3]);
                if (MODE & 1) asm volatile("" :: "v"(w.x), "v"(w.y), "v"(w.z), "v"(w.w)); else *(u32x4*)(O + (size_t)r * ldc + col0) = w; }
    }
};
using EpiSwiglu = EpiSwigluT<0>;

template <bool BASE_BF16, bool OUT_F32, bool HAS_OB> struct EpiResid {
    static constexpr bool PERM = true, AFTER_DRAIN = false, HAS_MID = false, SS_LDS = false; static constexpr int MID_T = 0, VM_TAIL = (HAS_OB || OUT_F32) ? 16 : 0;
    const void* base_lo; const void* base_hi; int split_row; float* out; bf16_t* ob; float* ss; float scale;
    __device__ __forceinline__ void mid(f32x4 (&)[2][2][4][2], const Unit&, int, int, int, int) const {}
    __device__ __forceinline__ void operator()(f32x4 (&acc)[2][2][4][2], const Unit& u, int wr, int wc, int fr, int fq) const {
        const int row0 = u.pm * BM + wr * 64 + fr, col0 = u.pn * BM + wc * 32 + 8 * fq;
        if constexpr (BASE_BF16) {
            const bf16_t* bb = (const bf16_t*)((u.pm * BM < split_row) ? base_lo : base_hi) - ((u.pm * BM < split_row) ? (size_t)0 : (size_t)split_row * 4096);
            u32x4 tb[RES_DEPTH][2];
#define RES_LOAD(k) do { const size_t off_ = (size_t)(row0 + ((k) >> 2) * HALF + ((k) & 3) * 16) * 4096 + col0; \
                tb[(k) % RES_DEPTH][0] = *(const u32x4*)(bb + off_); tb[(k) % RES_DEPTH][1] = *(const u32x4*)(bb + off_ + HALF); } while (0)
#pragma unroll
            for (int k = 0; k < RES_DEPTH - 1; ++k) RES_LOAD(k);
#pragma unroll
            for (int k = 0; k < 8; ++k) { const int ai = k >> 2, m = k & 3;
                if (k + RES_DEPTH - 1 < 8) RES_LOAD(k + RES_DEPTH - 1);
#pragma unroll
                for (int bj = 0; bj < 2; ++bj) { const u32x4 w = tb[k % RES_DEPTH][bj];
                    acc[ai][bj][m][0] = (f32x4){bf_lo(w.x), bf_hi(w.x), bf_lo(w.y), bf_hi(w.y)} + acc[ai][bj][m][0] * scale;
                    acc[ai][bj][m][1] = (f32x4){bf_lo(w.z), bf_hi(w.z), bf_lo(w.w), bf_hi(w.w)} + acc[ai][bj][m][1] * scale; }
                asm volatile("" : "+v"(acc[ai][0][m][0]), "+v"(acc[ai][0][m][1]), "+v"(acc[ai][1][m][0]), "+v"(acc[ai][1][m][1]));
                __builtin_amdgcn_sched_barrier(0); }
#undef RES_LOAD
        } else {
            const float* bb = (const float*)((u.pm * BM < split_row) ? base_lo : base_hi) - ((u.pm * BM < split_row) ? (size_t)0 : (size_t)split_row * 4096);
            f32x4 tb[RES_DEPTH_F][4];
#define RES_LOAD(k) do { const size_t off_ = (size_t)(row0 + ((k) >> 2) * HALF + ((k) & 3) * 16) * 4096 + col0; \
                tb[(k) % RES_DEPTH_F][0] = __builtin_nontemporal_load((const f32x4*)(bb + off_)); tb[(k) % RES_DEPTH_F][1] = __builtin_nontemporal_load((const f32x4*)(bb + off_ + 4)); tb[(k) % RES_DEPTH_F][2] = __builtin_nontemporal_load((const f32x4*)(bb + off_ + HALF)); tb[(k) % RES_DEPTH_F][3] = __builtin_nontemporal_load((const f32x4*)(bb + off_ + HALF + 4)); } while (0)
#pragma unroll
            for (int k = 0; k < RES_DEPTH_F - 1; ++k) RES_LOAD(k);
#pragma unroll
            for (int k = 0; k < 8; ++k) { const int ai = k >> 2, m = k & 3;
                if (k + RES_DEPTH_F - 1 < 8) RES_LOAD(k + RES_DEPTH_F - 1);
                acc[ai][0][m][0] = tb[k % RES_DEPTH_F][0] + acc[ai][0][m][0] * scale; acc[ai][0][m][1] = tb[k % RES_DEPTH_F][1] + acc[ai][0][m][1] * scale;
                acc[ai][1][m][0] = tb[k % RES_DEPTH_F][2] + acc[ai][1][m][0] * scale; acc[ai][1][m][1] = tb[k % RES_DEPTH_F][3] + acc[ai][1][m][1] * scale;
                asm volatile("" : "+v"(acc[ai][0][m][0]), "+v"(acc[ai][0][m][1]), "+v"(acc[ai][1][m][0]), "+v"(acc[ai][1][m][1]));
                __builtin_amdgcn_sched_barrier(0); }
#undef RES_LOAD
        }
#pragma unroll
        for (int ai = 0; ai < 2; ++ai)
#pragma unroll
            for (int m = 0; m < 4; ++m) { const int r = row0 + ai * HALF + m * 16; const size_t off = (size_t)r * 4096 + col0; float sq = 0.f;
#pragma unroll
                for (int bj = 0; bj < 2; ++bj) { const f32x4 v0 = acc[ai][bj][m][0], v1 = acc[ai][bj][m][1];
                    if (OUT_F32) { *(f32x4*)(out + off + bj * HALF) = v0; *(f32x4*)(out + off + bj * HALF + 4) = v1; }
                    sq += (v0[0] * v0[0] + v0[1] * v0[1]) + (v0[2] * v0[2] + v0[3] * v0[3]) + (v1[0] * v1[0] + v1[1] * v1[1]) + (v1[2] * v1[2] + v1[3] * v1[3]);
                    if (HAS_OB) { u32x4 w; w.x = cvt_pk_bf16(v0[0], v0[1]); w.y = cvt_pk_bf16(v0[2], v0[3]); w.z = cvt_pk_bf16(v1[0], v1[1]); w.w = cvt_pk_bf16(v1[2], v1[3]); *(u32x4*)(ob + off + bj * HALF) = w; } }
                sq += __shfl_xor(sq, 16); sq += __shfl_xor(sq, 32);
                if (fq == 0) __hip_atomic_fetch_add(ss + r, sq, __ATOMIC_RELAXED, __HIP_MEMORY_SCOPE_AGENT); }
    }
};

struct EpiProj {
    static constexpr bool PERM = true, AFTER_DRAIN = false, HAS_MID = false, SS_LDS = true; static constexpr int MID_T = 0, VM_TAIL = 16;
    bf16_t* qkv; bf16_t* gates; const float* ss; const float* rope; PG8_LAS unsigned char* ssl;
    __device__ __forceinline__ void mid(f32x4 (&)[2][2][4][2], const Unit&, int, int, int, int) const {}
    __device__ __forceinline__ void operator()(f32x4 (&acc)[2][2][4][2], const Unit& u, int wr, int wc, int fr, int fq) const {
        const int pn = u.pn; const bool is_gate = pn >= 48, is_rope = (pn < 24) || (pn >= 36 && pn < 46);
        const int row0 = u.pm * BM + wr * 64 + fr, cw = wc * 32 + 8 * fq;
        bf16_t* dst = is_gate ? gates + (pn - 48) * BM + cw : qkv + pn * BM + cw; const int ld = is_gate ? 8192 : 12288;
        const bool do_rope = is_rope && (wc == 0); const float sgn = fq < 2 ? -1.0f : 1.0f;
        float rs[2][4];
#pragma unroll
        for (int ai = 0; ai < 2; ++ai)
#pragma unroll
            for (int m = 0; m < 4; ++m) rs[ai][m] = ss_lds(ssl, wr, wc, fr, ai, m);
#pragma unroll
        for (int ai = 0; ai < 2; ++ai)
#pragma unroll
            for (int m = 0; m < 4; ++m) { const int r = row0 + ai * HALF + m * 16; const float rr = __builtin_amdgcn_rsqf(rs[ai][m] * (1.0f / 4096.0f) + 1e-6f);
#pragma unroll
                for (int bj = 0; bj < 2; ++bj) { acc[ai][bj][m][0] *= rr; acc[ai][bj][m][1] *= rr; }
                if (do_rope) { const int pos = r < 8192 ? (r & 4095) : r - 8192; const float* tp = rope + (size_t)pos * 32 + 8 * (fq & 1);
                    const f32x4 c0 = *(const f32x4*)tp, c1 = *(const f32x4*)(tp + 4), s0 = *(const f32x4*)(tp + 16), s1 = *(const f32x4*)(tp + 20);
#pragma unroll
                    for (int bj = 0; bj < 2; ++bj) { f32x4 v0 = acc[ai][bj][m][0], v1 = acc[ai][bj][m][1];
#pragma unroll
                        for (int j = 0; j < 4; ++j) { const float p0 = __shfl_xor(v0[j], 32), p1 = __shfl_xor(v1[j], 32); v0[j] = v0[j] * c0[j] + sgn * p0 * s0[j]; v1[j] = v1[j] * c1[j] + sgn * p1 * s1[j]; }
                        acc[ai][bj][m][0] = v0; acc[ai][bj][m][1] = v1; } } }
#pragma unroll
        for (int ai = 0; ai < 2; ++ai)
#pragma unroll
            for (int m = 0; m < 4; ++m) { const int r = row0 + ai * HALF + m * 16;
                if (is_gate) {
                    bf16_t* gd = gates + (size_t)r * 8192 + (pn - 48) * HALF + cw; f32x4 uu[2], sbv[2];
#pragma unroll
                    for (int n = 0; n < 2; ++n)
#pragma unroll
                        for (int j = 0; j < 4; ++j) { const float sa = sigmoid_f(acc[ai][0][m][n][j]), sb = sigmoid_f(acc[ai][1][m][n][j]); sbv[n][j] = sb; uu[n][j] = sa * __builtin_amdgcn_rcpf(fmaxf(sb, 1e-20f)); }
                    u32x4 w; w.x = cvt_pk_bf16(uu[0][0], uu[0][1]); w.y = cvt_pk_bf16(uu[0][2], uu[0][3]); w.z = cvt_pk_bf16(uu[1][0], uu[1][1]); w.w = cvt_pk_bf16(uu[1][2], uu[1][3]);
                    *(u32x4*)gd = w;
                    w.x = cvt_pk_bf16(sbv[0][0], sbv[0][1]); w.y = cvt_pk_bf16(sbv[0][2], sbv[0][3]); w.z = cvt_pk_bf16(sbv[1][0], sbv[1][1]); w.w = cvt_pk_bf16(sbv[1][2], sbv[1][3]);
                    *(u32x4*)(gd + 4096) = w;
                } else {
#pragma unroll
                    for (int bj = 0; bj < 2; ++bj) { const f32x4 v0 = acc[ai][bj][m][0], v1 = acc[ai][bj][m][1];
                        u32x4 w; w.x = cvt_pk_bf16(v0[0], v0[1]); w.y = cvt_pk_bf16(v0[2], v0[3]); w.z = cvt_pk_bf16(v1[0], v1[1]); w.w = cvt_pk_bf16(v1[2], v1[3]);
                        *(u32x4*)(dst + (size_t)r * ld + bj * HALF) = w; } } }
    }
};

struct EpiMerge {
    static constexpr bool PERM = true, AFTER_DRAIN = false, HAS_MID = true, SS_LDS = false; static constexpr int MID_T = 16, VM_TAIL = 16;
    const bf16_t* gates; bf16_t* O;
    static constexpr int MID_DEPTH = 8, END_DEPTH = 8;
    __device__ __forceinline__ void mid(f32x4 (&acc)[2][2][4][2], const Unit& u, int wr, int wc, int fr, int fq) const {
        const __amdgpu_buffer_rsrc_t rsG = __builtin_amdgcn_make_buffer_rsrc((void*)gates, (short)0, (int)0xffffffffu, 0x00020000);
        int vo = ((u.pm * BM + wr * 64 + fr) * 8192 + u.pn * BM + wc * 32 + 8 * fq) * 2; asm volatile("" : "+v"(vo));
        u32x4 ta[MID_DEPTH][2];
#define MG_LOAD(k) do { const int o_ = vo + (((k) >> 2) * HALF + ((k) & 3) * 16) * 16384; _Pragma("unroll") for (int bj = 0; bj < 2; ++bj) ta[(k) % MID_DEPTH][bj] = __builtin_amdgcn_raw_buffer_load_b128(rsG, o_ + bj * 256, 0, 0); } while (0)
#pragma unroll
        for (int k = 0; k < MID_DEPTH - 1; ++k) MG_LOAD(k);
#pragma unroll
        for (int k = 0; k < 8; ++k) { const int ai = k >> 2, m = k & 3;
            if (k + MID_DEPTH - 1 < 8) MG_LOAD(k + MID_DEPTH - 1);
#pragma unroll
            for (int bj = 0; bj < 2; ++bj) { const u32x4 a = ta[k % MID_DEPTH][bj];
                acc[ai][bj][m][0] *= (f32x4){bf_lo(a.x), bf_hi(a.x), bf_lo(a.y), bf_hi(a.y)}; acc[ai][bj][m][1] *= (f32x4){bf_lo(a.z), bf_hi(a.z), bf_lo(a.w), bf_hi(a.w)}; }
            asm volatile("" : "+v"(acc[ai][0][m][0]), "+v"(acc[ai][0][m][1]), "+v"(acc[ai][1][m][0]), "+v"(acc[ai][1][m][1]));
            __builtin_amdgcn_sched_barrier(0); }
#undef MG_LOAD
    }
    __device__ __forceinline__ void operator()(f32x4 (&acc)[2][2][4][2], const Unit& u, int wr, int wc, int fr, int fq) const {
        const int row0 = u.pm * BM + wr * 64 + fr, col0 = u.pn * BM + wc * 32 + 8 * fq;
        { const __amdgpu_buffer_rsrc_t rsG = __builtin_amdgcn_make_buffer_rsrc((void*)gates, (short)0, (int)0xffffffffu, 0x00020000);
          const int vo = (row0 * 8192 + col0) * 2;
          u32x4 tb[END_DEPTH][2];
#define MG_LOAD(k) do { const int o_ = vo + (((k) >> 2) * HALF + ((k) & 3) * 16) * 16384; _Pragma("unroll") for (int bj = 0; bj < 2; ++bj) tb[(k) % END_DEPTH][bj] = __builtin_amdgcn_raw_buffer_load_b128(rsG, o_ + bj * 256, 8192, 0); } while (0)
#pragma unroll
          for (int k = 0; k < END_DEPTH - 1; ++k) MG_LOAD(k);
#pragma unroll
          for (int k = 0; k < 8; ++k) { const int ai = k >> 2, m = k & 3;
              if (k + END_DEPTH - 1 < 8) MG_LOAD(k + END_DEPTH - 1);
#pragma unroll
              for (int bj = 0; bj < 2; ++bj) { const u32x4 b = tb[k % END_DEPTH][bj]; f32x4 g0, g1;
                  g0[0] = fmaxf(bf_lo(b.x), 1e-20f); g0[1] = fmaxf(bf_hi(b.x), 1e-20f); g0[2] = fmaxf(bf_lo(b.y), 1e-20f); g0[3] = fmaxf(bf_hi(b.y), 1e-20f);
                  g1[0] = fmaxf(bf_lo(b.z), 1e-20f); g1[1] = fmaxf(bf_hi(b.z), 1e-20f); g1[2] = fmaxf(bf_lo(b.w), 1e-20f); g1[3] = fmaxf(bf_hi(b.w), 1e-20f);
                  acc[ai][bj][m][0] *= g0; acc[ai][bj][m][1] *= g1; }
              asm volatile("" : "+v"(acc[ai][0][m][0]), "+v"(acc[ai][0][m][1]), "+v"(acc[ai][1][m][0]), "+v"(acc[ai][1][m][1]));
              __builtin_amdgcn_sched_barrier(0); }
#undef MG_LOAD
        }
#pragma unroll
        for (int ai = 0; ai < 2; ++ai)
#pragma unroll
            for (int m = 0; m < 4; ++m) { const int r = row0 + ai * HALF + m * 16;
#pragma unroll
                for (int bj = 0; bj < 2; ++bj) { const f32x4 a0 = acc[ai][bj][m][0], a1 = acc[ai][bj][m][1];
                    u32x4 w; w.x = cvt_pk_bf16(a0[0], a0[1]); w.y = cvt_pk_bf16(a0[2], a0[3]); w.z = cvt_pk_bf16(a1[0], a1[1]); w.w = cvt_pk_bf16(a1[2], a1[3]);
                    *(u32x4*)(O + (size_t)r * 4096 + col0 + bj * HALF) = w; } }
    }
};

template <class Epi, class Sched, bool ALIGN_EPI = false, bool SP2 = false>
__device__ __forceinline__ void gemm_phase(PG8_LAS unsigned char* lds, const Gemm g, const Sched& S, const Epi& E) {
    const int tid = threadIdx.x, wid = __builtin_amdgcn_readfirstlane(tid >> 6), lane = tid & 63, wr = wid >> 2, wc = wid & 3, fr = lane & 15, fq = lane >> 4;
    const int K = g.K, nt = K / BK;
    unsigned voffA[2], voffB[2];
#pragma unroll
    for (int i = 0; i < 2; ++i) { int R, C; stage_rc(tid * 16 + i * 8192, R, C); const int Rb = Epi::PERM ? ((R & ~31) + perm32(R & 31)) : R;
        voffA[i] = (unsigned)(R * K + C) * 2u; voffB[i] = (unsigned)(Rb * K + C) * 2u; }
    const unsigned kstep = (unsigned)(BK * 2);
    const unsigned hstep = (unsigned)HALF * (unsigned)K * 2u;
    const unsigned tstep = 2u * hstep;
    const __amdgpu_buffer_rsrc_t rsA = __builtin_amdgcn_make_buffer_rsrc((void*)g.A, (short)0, (int)0xffffffffu, 0x00020000);
    const __amdgpu_buffer_rsrc_t rsB = __builtin_amdgcn_make_buffer_rsrc((void*)g.Bt, (short)0, (int)0xffffffffu, 0x00020000);
    const unsigned ldsw = (unsigned)wid * 1024u;
    const int aoff = lds_byte(wr * 64 + fr, fq * 8), boff = lds_byte(wc * 32 + fr, fq * 8);
#define PG8_SA(b, h) (((b) * 2 + (h)) * HTB)
#define PG8_SB(b, h) ((4 + (b) * 2 + (h)) * HTB)
#define PG8_STAGE(bufoff, rs, soff, voff) do { _Pragma("unroll") for (int _i = 0; _i < 2; ++_i) \
        __builtin_amdgcn_raw_ptr_buffer_load_lds(rs, (PG8_LAS unsigned*)(lds + (bufoff) + ldsw + _i * 8192), 16, (int)(voff)[_i], (int)(soff), 0, 0); } while (0)
#define PG8_LDA(dst, b, h) do { _Pragma("unroll") for (int m = 0; m < 4; ++m) _Pragma("unroll") for (int k = 0; k < 2; ++k) dst[m][k] = *(const PG8_LAS bf16x8*)(lds + PG8_SA(b, h) + aoff + m * 2048 + k * 1024); } while (0)
#define PG8_LDB(dst, b, h) do { _Pragma("unroll") for (int n = 0; n < 2; ++n) _Pragma("unroll") for (int k = 0; k < 2; ++k) dst[n][k] = *(const PG8_LAS bf16x8*)(lds + PG8_SB(b, h) + boff + n * 2048 + k * 1024); } while (0)
#define PG8_MMA(ai, bj, At, Bt) do { __builtin_amdgcn_s_setprio(1); _Pragma("unroll") for (int m = 0; m < 4; ++m) _Pragma("unroll") for (int n = 0; n < 2; ++n) _Pragma("unroll") for (int k = 0; k < 2; ++k) \
        acc[ai][bj][m][n] = __builtin_amdgcn_mfma_f32_16x16x32_bf16(Bt[n][k], At[m][k], acc[ai][bj][m][n], 0, 0, 0); __builtin_amdgcn_s_setprio(0); } while (0)
#define PG8_WAIT_V(n) asm volatile("s_waitcnt vmcnt(" #n ")" ::: "memory")
#define PG8_WAIT_VN(N) asm volatile("s_waitcnt vmcnt(%0)" :: "n"(N) : "memory")
#define PG8_WAIT_L(n) asm volatile("s_waitcnt lgkmcnt(" #n ")" ::: "memory")
#define PG8_BAR __builtin_amdgcn_s_barrier()
#define PG8_SCHED __builtin_amdgcn_sched_barrier(0)
    Unit cur, nxt; int ui = 0;
    if (!S.next(0, cur)) return;
    f32x4 acc[2][2][4][2];
#pragma unroll
    for (int a = 0; a < 2; ++a)
#pragma unroll
        for (int b = 0; b < 2; ++b)
#pragma unroll
            for (int m = 0; m < 4; ++m)
#pragma unroll
                for (int n = 0; n < 2; ++n) acc[a][b][m][n] = (f32x4){0.f, 0.f, 0.f, 0.f};
    bf16x8 At[4][2], B0[2][2], B1[2][2];
    unsigned cA = __builtin_amdgcn_readfirstlane((unsigned)cur.pm * tstep), cB = __builtin_amdgcn_readfirstlane((unsigned)cur.pn * tstep);
    S.a_ready(cur);
    if constexpr (Epi::SS_LDS) ss_prefetch(E.ss, E.ssl, cur.pm, wid, lane);
    if constexpr (SP2) {
        PG8_STAGE(PG8_SB(0, 0), rsB, cB, voffB); PG8_STAGE(PG8_SB(0, 1), rsB, cB + hstep, voffB); PG8_STAGE(PG8_SA(0, 0), rsA, cA, voffA); PG8_STAGE(PG8_SA(0, 1), rsA, cA + hstep, voffA);
        if (wr == 1) PG8_BAR;
        PG8_WAIT_V(2); PG8_BAR;
        PG8_STAGE(PG8_SB(1, 0), rsB, cB + kstep, voffB); PG8_STAGE(PG8_SA(1, 0), rsA, cA + kstep, voffA); PG8_STAGE(PG8_SB(1, 1), rsB, cB + hstep + kstep, voffB);
        PG8_WAIT_V(0); PG8_BAR;
    } else {
        PG8_STAGE(PG8_SB(0, 0), rsB, cB, voffB); PG8_STAGE(PG8_SA(0, 0), rsA, cA, voffA); PG8_STAGE(PG8_SB(0, 1), rsB, cB + hstep, voffB); PG8_STAGE(PG8_SA(0, 1), rsA, cA + hstep, voffA);
        if (wr == 1) PG8_BAR;
        PG8_WAIT_V(4); PG8_BAR;
        PG8_STAGE(PG8_SB(1, 0), rsB, cB + kstep, voffB); PG8_STAGE(PG8_SA(1, 0), rsA, cA + kstep, voffA); PG8_STAGE(PG8_SB(1, 1), rsB, cB + hstep + kstep, voffB);
        PG8_WAIT_V(6); PG8_BAR;
    }
    for (;;) {
        const bool has_next = S.next(ui + 1, nxt);
        const unsigned nA = __builtin_amdgcn_readfirstlane(has_next ? (unsigned)nxt.pm * tstep : cA), nB = __builtin_amdgcn_readfirstlane(has_next ? (unsigned)nxt.pn * tstep : cB);
#define PG8_KADDR const bool last = (t == nt - 2); const unsigned a1 = cA + (unsigned)(t + 1) * kstep; \
            const unsigned a2 = last ? nA : cA + (unsigned)(t + 2) * kstep, b2 = last ? nB : cB + (unsigned)(t + 2) * kstep, a3 = a2 + kstep, b3 = b2 + kstep; \
            if (last && has_next) S.a_ready(nxt); \
            if constexpr (Epi::HAS_MID) { if (t == Epi::MID_T) E.mid(acc, cur, wr, wc, fr, fq); }
#define PG8_KPAIR_SP2(W12) do { \
            PG8_LDB(B0, 0, 0); PG8_LDB(B1, 0, 1); PG8_SCHED; PG8_LDA(At, 0, 0); PG8_STAGE(PG8_SA(1, 1), rsA, a1 + hstep, voffA); \
            PG8_WAIT_VN(W12); PG8_WAIT_L(0); PG8_BAR; PG8_MMA(0, 0, At, B0); PG8_MMA(0, 1, At, B1); PG8_BAR; PG8_SCHED; \
            PG8_LDA(At, 0, 1); PG8_STAGE(PG8_SB(0, 0), rsB, b2, voffB); PG8_STAGE(PG8_SB(0, 1), rsB, b2 + hstep, voffB); PG8_STAGE(PG8_SA(0, 0), rsA, a2, voffA); \
            PG8_WAIT_VN(W12); PG8_WAIT_L(0); PG8_BAR; PG8_MMA(1, 0, At, B0); PG8_MMA(1, 1, At, B1); PG8_BAR; PG8_SCHED; \
            PG8_LDB(B0, 1, 0); PG8_LDB(B1, 1, 1); PG8_SCHED; PG8_LDA(At, 1, 0); PG8_STAGE(PG8_SA(0, 1), rsA, a2 + hstep, voffA); \
            PG8_WAIT_V(8); PG8_WAIT_L(0); PG8_BAR; PG8_MMA(0, 0, At, B0); PG8_MMA(0, 1, At, B1); PG8_BAR; PG8_SCHED; \
            PG8_LDA(At, 1, 1); PG8_STAGE(PG8_SB(1, 0), rsB, b3, voffB); PG8_STAGE(PG8_SB(1, 1), rsB, b3 + hstep, voffB); PG8_STAGE(PG8_SA(1, 0), rsA, a3, voffA); \
            PG8_WAIT_V(8); PG8_WAIT_L(0); PG8_BAR; PG8_MMA(1, 0, At, B0); PG8_MMA(1, 1, At, B1); PG8_BAR; PG8_SCHED; } while (0)
        if constexpr (SP2) {
            { const int t = 0; PG8_KADDR; PG8_KPAIR_SP2(8 + Epi::VM_TAIL); }
            for (int t = 2; t < nt; t += 2) { PG8_KADDR; PG8_KPAIR_SP2(8); }
        } else {
        for (int t = 0; t < nt; t += 2) {
            PG8_KADDR;
            PG8_LDB(B0, 0, 0); PG8_SCHED; PG8_LDA(At, 0, 0); PG8_STAGE(PG8_SA(1, 1), rsA, a1 + hstep, voffA);
            PG8_WAIT_L(8); PG8_BAR; PG8_WAIT_L(0); PG8_MMA(0, 0, At, B0); PG8_BAR; PG8_SCHED;
            PG8_LDB(B1, 0, 1); PG8_STAGE(PG8_SB(0, 0), rsB, b2, voffB);
            PG8_BAR; PG8_WAIT_L(0); PG8_MMA(0, 1, At, B1); PG8_BAR;
            PG8_LDA(At, 0, 1); PG8_STAGE(PG8_SA(0, 0), rsA, a2, voffA);
            PG8_BAR; PG8_WAIT_L(0); PG8_MMA(1, 0, At, B0); PG8_BAR; PG8_SCHED;
            PG8_STAGE(PG8_SB(0, 1), rsB, b2 + hstep, voffB);
            PG8_WAIT_V(6); PG8_BAR; PG8_MMA(1, 1, At, B1); PG8_BAR;
            PG8_LDB(B0, 1, 0); PG8_SCHED; PG8_LDA(At, 1, 0); PG8_STAGE(PG8_SA(0, 1), rsA, a2 + hstep, voffA);
            PG8_WAIT_L(8); PG8_BAR; PG8_WAIT_L(0); PG8_MMA(0, 0, At, B0); PG8_BAR; PG8_SCHED;
            PG8_LDB(B1, 1, 1); PG8_STAGE(PG8_SB(1, 0), rsB, b3, voffB);
            PG8_BAR; PG8_WAIT_L(0); PG8_MMA(0, 1, At, B1); PG8_BAR;
            PG8_LDA(At, 1, 1); PG8_STAGE(PG8_SA(1, 0), rsA, a3, voffA);
            PG8_BAR; PG8_WAIT_L(0); PG8_MMA(1, 0, At, B0); PG8_BAR; PG8_SCHED;
            PG8_STAGE(PG8_SB(1, 1), rsB, b3 + hstep, voffB);
            PG8_WAIT_V(6); PG8_BAR; PG8_MMA(1, 1, At, B1); PG8_BAR;
        }
        }
        if constexpr (ALIGN_EPI) { if (wr == 0) PG8_BAR; }
        if constexpr (!Epi::AFTER_DRAIN) { E(acc, cur, wr, wc, fr, fq); S.done(cur); }
        if (!has_next) break;
#pragma unroll
        for (int a = 0; a < 2; ++a)
#pragma unroll
            for (int b = 0; b < 2; ++b)
#pragma unroll
                for (int m = 0; m < 4; ++m)
#pragma unroll
                    for (int n = 0; n < 2; ++n) acc[a][b][m][n] = (f32x4){0.f, 0.f, 0.f, 0.f};
        cur = nxt; cA = nA; cB = nB; ++ui;
        if constexpr (Epi::SS_LDS) ss_prefetch(E.ss, E.ssl, cur.pm, wid, lane);
        if constexpr (ALIGN_EPI) { if (wr == 1) PG8_BAR; }
    }
    PG8_WAIT_V(0);
    if constexpr (!ALIGN_EPI) { if (wr == 0) PG8_BAR; }
    PG8_BAR;
#undef PG8_SA
#undef PG8_SB
#undef PG8_STAGE
#undef PG8_LDA
#undef PG8_LDB
#undef PG8_MMA
#undef PG8_WAIT_V
#undef PG8_WAIT_L
#undef PG8_WAIT_VN
#undef PG8_KADDR
#undef PG8_KPAIR_SP2
#undef PG8_BAR
#undef PG8_SCHED
}
}

#ifndef PG8_SP2
#define PG8_SP2 true
#endif
#ifndef PG8_ALIGN
#define PG8_ALIGN true
#endif

constexpr int NWAVES = 8;
constexpr int N_LAUNCHES = MK_N_LAUNCHES;
constexpr int PER_PHASE = 10;
constexpr int D = 4096, FF = 11008, NIN = 20480, QKVW = 12288, GATEW = 8192, YABW = 3072;
constexpr int M_P = 8192, M_S = 16384, M = M_P + M_S;
constexpr float QSCALE = 0.08838834764831845f * 1.4426950408889634f;

constexpr size_t MiB = 1u << 20;
constexpr size_t WS_CTL = 0, CTL_ZERO_BYTES = 1 * MiB;
constexpr size_t WS_SS0 = 1 * MiB;
constexpr size_t WS_ROPE = 2 * MiB;
constexpr size_t WS_WIN = 4 * MiB;
constexpr size_t WS_WAB = WS_WIN + (size_t)NIN * D * 2;
constexpr size_t WS_WOUT = WS_WAB + (size_t)D * YABW * 2;
constexpr size_t WS_WGU = WS_WOUT + (size_t)D * D * 2;
constexpr size_t WS_WD = WS_WGU + (size_t)2 * FF * D * 2;
constexpr size_t WS_AB1 = WS_WD + (size_t)D * FF * 2;
constexpr size_t WS_ACT = WS_AB1 + (size_t)M * D * 2;
constexpr size_t WS_QKV = WS_ACT + (size_t)M * FF * 2;
constexpr size_t WS_END = WS_QKV + (size_t)M * QKVW * 2;
constexpr int CW_BAR = 4096;
constexpr int CW_SS1 = 16384, CW_SS2 = CW_SS1 + M, CW_SS3 = CW_SS2 + M;
static_assert((size_t)(CW_SS3 + M) * 4 <= CTL_ZERO_BYTES, "CTL words inside the memset region");
static_assert(WS_SS0 + (size_t)M * 4 <= WS_ROPE && WS_ROPE + (size_t)16384 * 32 * 4 <= WS_WIN, "ws map");

constexpr int RING_OFF = 0, RING_BYTES = 131072;
constexpr int LDSCTL_OFF = RING_BYTES, MISC_OFF = LDSCTL_OFF + 320;
constexpr int SSL_OFF = MISC_OFF + 1024;
constexpr int LDS_BYTES = 147456;

#define GAS __attribute__((address_space(1)))
#define LAS __attribute__((address_space(3)))
typedef unsigned short bf16;
typedef unsigned v4u __attribute__((ext_vector_type(4)));
typedef unsigned v2u __attribute__((ext_vector_type(2)));
typedef float f32x4 __attribute__((ext_vector_type(4)));
typedef short bf16x8 __attribute__((ext_vector_type(8)));
typedef short s16x4 __attribute__((ext_vector_type(4)));
typedef GAS unsigned gu32;
#define RLX_AGENT __ATOMIC_RELAXED, __HIP_MEMORY_SCOPE_AGENT
#define LDS_WAIT() asm volatile("s_waitcnt lgkmcnt(0)" ::: "memory")
#define VM_WAIT() asm volatile("s_waitcnt vmcnt(0)" ::: "memory")
__device__ __forceinline__ unsigned pk2(float lo, float hi) { return pg8::cvt_pk_bf16(lo, hi); }

#define XB_TMO      128
#define XB_XCNT(j)  (256  + 64 * (j))
#define XB_XSUB(j)  (1280 + 64 * (j))
#define XB_XGEN(j)  (2304 + 64 * (j))
#define XB_TOP      3328
#define XB_TOPGEN   3392
#define XCD_BAR_WORDS 3456
#define XB_SPIN_CAP (1u << 18)

__device__ __forceinline__ unsigned xb_ld(unsigned* p)              { return __hip_atomic_load(p, __ATOMIC_RELAXED, __HIP_MEMORY_SCOPE_AGENT); }
__device__ __forceinline__ unsigned xb_add(unsigned* p, unsigned v) { return __hip_atomic_fetch_add(p, v, __ATOMIC_RELAXED, __HIP_MEMORY_SCOPE_AGENT); }
__device__ __forceinline__ unsigned xb_xcc_id() { return (unsigned)__builtin_amdgcn_s_getreg((3 << 11) | 20) & 0xFu; }
#define XB_SPIN(cond, bar) do { unsigned _sp = 0; while (cond) { __builtin_amdgcn_s_sleep(1); \
    if ((++_sp & 255u) == 0u) { if (xb_ld(&(bar)[XB_TMO])) break; if (_sp > XB_SPIN_CAP) { atomicAdd(&(bar)[XB_TMO], 1u); break; } } } } while (0)

struct XcdBarrier {
    unsigned* bar; unsigned x;
    volatile LAS unsigned* st;
};
__device__ __forceinline__ XcdBarrier xcd_barrier_post(unsigned* bar, volatile LAS unsigned* st) {
    XcdBarrier b; b.bar = bar; b.x = xb_xcc_id(); b.st = st;
    if (threadIdx.x == 0) (void)xb_add(&bar[XB_XCNT(b.x)], 1u);
    return b;
}
__device__ __forceinline__ void xcd_barrier_complete(unsigned* bar, unsigned x, unsigned& nloc, unsigned& nx) {
    const unsigned G = gridDim.x * gridDim.y * gridDim.z;
    unsigned sum, cnt, mine, sp = 0u;
    for (;;) {
        sum = 0u; cnt = 0u; mine = 0u;
#pragma unroll
        for (unsigned j = 0; j < 16; ++j) { const unsigned c = xb_ld(&bar[XB_XCNT(j)]); sum += c; cnt += (c > 0u) ? 1u : 0u; mine = (j == x) ? c : mine; }
        if (sum == G) break;
        __builtin_amdgcn_s_sleep(1);
        if ((++sp & 255u) == 0u) { if (xb_ld(&bar[XB_TMO])) break; if (sp > XB_SPIN_CAP) { atomicAdd(&bar[XB_TMO], 1u); break; } }
    }
    nloc = mine > 0u ? mine : 1u; nx = cnt > 0u ? cnt : 1u;
}
__device__ __forceinline__ void xcd_barrier(const XcdBarrier& b) {
    asm volatile("s_waitcnt vmcnt(0)" ::: "memory");
    __syncthreads();
    if (threadIdx.x == 0) {
        unsigned* bar = b.bar;
        __builtin_amdgcn_s_waitcnt(0);
        unsigned nloc = b.st[0], nx = b.st[1];
        if (nloc == 0u) { xcd_barrier_complete(bar, b.x, nloc, nx); b.st[0] = nloc; b.st[1] = nx; }
        const unsigned old = xb_add(&bar[XB_XSUB(b.x)], 1u);
        const unsigned gen = old / nloc;
        if (old + 1u == (gen + 1u) * nloc) {
            __builtin_amdgcn_fence(__ATOMIC_RELEASE, "agent");
            asm volatile("s_waitcnt vmcnt(0)" ::: "memory");
            const unsigned og = xb_add(&bar[XB_TOP], 1u);
            const unsigned tg = og / nx;
            if (og + 1u == (tg + 1u) * nx) xb_add(&bar[XB_TOPGEN], 1u);
            else XB_SPIN(xb_ld(&bar[XB_TOPGEN]) == tg, bar);
            __builtin_amdgcn_fence(__ATOMIC_ACQUIRE, "agent");
            xb_add(&bar[XB_XGEN(b.x)], 1u);
            asm volatile("s_waitcnt vmcnt(0)" ::: "memory");
        } else {
            XB_SPIN(xb_ld(&bar[XB_XGEN(b.x)]) == gen, bar);
            __builtin_amdgcn_fence(__ATOMIC_ACQUIRE, "agent");
            asm volatile("s_waitcnt vmcnt(0)" ::: "memory");
        }
    }
    __syncthreads();
}

__device__ __forceinline__ void xcd_stagger(unsigned ticks) {
    const unsigned long long dt = (unsigned long long)(xb_xcc_id() & 7u) * ticks, t0 = __builtin_amdgcn_s_memrealtime();
    while (__builtin_amdgcn_s_memrealtime() - t0 < dt) __builtin_amdgcn_s_sleep(8);
}

struct Frame {
    LAS unsigned char* lds;
    volatile LAS unsigned* MISC;
    gu32* ctl;
    int tid, lane, wave;
    int vcu, G;
};

__device__ __forceinline__ float wave_sum(float v) {
#pragma unroll
    for (int o = 1; o < 64; o <<= 1) v += __shfl_xor(v, o);
    return v;
}

struct CvtJob { const float* W; const float* gain; bf16* WT; int N, ldT, drow, kcol0, k0, n0; float cs; };
__device__ __forceinline__ void cvt_job(CvtJob& J, const float* W, int N, const float* gain, bf16* WT, int ldT, int koff, int mode, int item) {
    const int nblk = N / 64, kb = item / nblk, nb = item % nblk, k0 = 64 * kb, n0 = 64 * nb;
    J.W = W; J.gain = gain; J.WT = WT; J.N = N; J.ldT = ldT; J.k0 = k0; J.n0 = n0; J.kcol0 = koff + k0;
    J.cs = (mode == 3 && (n0 < 3072 || (n0 >= 9216 && n0 < 11264))) ? QSCALE : 1.0f;
    J.drow = (mode == 1 || mode == 2) ? 256 * (n0 >> 7) + (n0 & 127) + (mode == 2 ? 128 : 0) : n0;
    if (mode == 3 && n0 >= 12288) { const int c = n0 - 12288, c2 = c & 4095;
        J.drow = 12288 + 256 * (c2 >> 7) + (c2 & 127) + (c >= 4096 ? 128 : 0); }
}
__device__ __forceinline__ void cvt_load(const CvtJob& J, int lane, f32x4 (&v)[16]) {
    const float* p = J.W + (size_t)(J.k0 + 16 * (lane >> 4)) * J.N + J.n0 + 4 * (lane & 15);
#pragma unroll
    for (int i = 0; i < 16; ++i) v[i] = __builtin_nontemporal_load((const f32x4*)(p + (size_t)i * J.N));
}
__device__ __forceinline__ void cvt_store(const CvtJob& J, const f32x4 (&v)[16], LAS unsigned char* img, int lane) {
    const int g = lane >> 4, i15 = lane & 15;
    f32x4 gq[4];
#pragma unroll
    for (int j = 0; j < 4; ++j) gq[j] = J.gain ? *(const f32x4*)(J.gain + J.k0 + 16 * g + 4 * j) * J.cs : (f32x4){J.cs, J.cs, J.cs, J.cs};
#pragma unroll
    for (int i = 0; i < 16; ++i) { const f32x4 f = v[i] * gq[i >> 2][i & 3]; v2u w; w.x = pk2(f[0], f[1]); w.y = pk2(f[2], f[3]); *(LAS v2u*)(img + (16 * g + i) * 192 + 8 * i15) = w; }
    const int q = i15 >> 2, p = lane & 3;
    bf16* op = J.WT + (size_t)(J.drow + 16 * g + i15) * J.ldT + J.kcol0;
#pragma unroll
    for (int s = 0; s < 8; ++s) {
        const s16x4 lo = __builtin_bit_cast(s16x4, __builtin_amdgcn_ds_read_tr16_b64_v4i16((LAS s16x4*)(img + (8 * s + q) * 192 + 32 * g + 8 * p)));
        const s16x4 hi = __builtin_bit_cast(s16x4, __builtin_amdgcn_ds_read_tr16_b64_v4i16((LAS s16x4*)(img + (8 * s + 4 + q) * 192 + 32 * g + 8 * p)));
        const bf16x8 o = __builtin_shufflevector(lo, hi, 0, 1, 2, 3, 4, 5, 6, 7);
        *(bf16x8*)(op + 8 * s) = o;
    }
}
struct Ptrs;
template <int SET> __device__ __forceinline__ void cvt_decode(const Ptrs& P, int it, CvtJob& J);

__device__ __forceinline__ void sincos_acc(float a, float& s, float& c) {
    const double x = (double)a;
    const double kq = __builtin_rint(x * 0.63661977236758134308);
    double r = __builtin_fma(-kq, 1.57079632679489655800e+00, x);
    r = __builtin_fma(-kq, 6.12323399573676603587e-17, r);
    const int q = (int)((long long)kq) & 3;
    const double r2 = r * r;
    const double sp = r * (1.0 + r2 * (-1.0 / 6.0 + r2 * (1.0 / 120.0 + r2 * (-1.0 / 5040.0 + r2 * (1.0 / 362880.0 + r2 * (-1.0 / 39916800.0 + r2 * (1.0 / 6227020800.0)))))));
    const double cp = 1.0 + r2 * (-0.5 + r2 * (1.0 / 24.0 + r2 * (-1.0 / 720.0 + r2 * (1.0 / 40320.0 + r2 * (-1.0 / 3628800.0 + r2 * (1.0 / 479001600.0))))));
    const double ss = (q & 1) ? cp : sp, cc = (q & 1) ? sp : cp;
    s = (float)((q & 2) ? -ss : ss);
    c = (float)(((q + 1) & 2) ? -cc : cc);
}

struct Ptrs {
    const float* xp; const float* xs; const float* g1; const float* w1g; const float* w1u; const float* w1d; const float* gmix; const float* win; const float* sink;
    const float* wa; const float* wb; const float* wout; const float* g2; const float* w2g; const float* w2u; const float* w2d; const float* gfin;
    float* out; unsigned char* ws;
};

constexpr int CI_GU = (D / 64) * (FF / 64), CI_D = (FF / 64) * (D / 64), CI_IN = (D / 64) * (NIN / 64), CI_A = (1024 / 64) * (D / 64), CI_B = (2048 / 64) * (D / 64), CI_O = (D / 64) * (D / 64);
constexpr int CI_IN0 = CI_IN / 2;
template <> __device__ __forceinline__ void cvt_decode<0>(const Ptrs& P, int it, CvtJob& J) {
    bf16* WGU = (bf16*)(P.ws + WS_WGU); bf16* WD = (bf16*)(P.ws + WS_WD); bf16* WIN = (bf16*)(P.ws + WS_WIN);
    int r = it;
    if (r < CI_GU) { cvt_job(J, P.w1g, FF, P.g1, WGU, D, 0, 1, r); return; } r -= CI_GU;
    if (r < CI_GU) { cvt_job(J, P.w1u, FF, P.g1, WGU, D, 0, 2, r); return; } r -= CI_GU;
    if (r < CI_D)  { cvt_job(J, P.w1d, D, nullptr, WD, FF, 0, 0, r); return; } r -= CI_D;
    cvt_job(J, P.win, NIN, P.gmix, WIN, D, 0, 3, r);
}
template <> __device__ __forceinline__ void cvt_decode<2>(const Ptrs& P, int it, CvtJob& J) {
    bf16* WIN = (bf16*)(P.ws + WS_WIN); bf16* WAB = (bf16*)(P.ws + WS_WAB); bf16* WOUT = (bf16*)(P.ws + WS_WOUT);
    int r = it;
    if (r < CI_IN - CI_IN0) { cvt_job(J, P.win, NIN, P.gmix, WIN, D, 0, 3, r + CI_IN0); return; } r -= CI_IN - CI_IN0;
    if (r < CI_A)  { cvt_job(J, P.wa, D, nullptr, WAB, YABW, 0, 0, r); return; } r -= CI_A;
    if (r < CI_B)  { cvt_job(J, P.wb, D, nullptr, WAB, YABW, 1024, 0, r); return; } r -= CI_B;
    cvt_job(J, P.wout, D, nullptr, WOUT, D, 0, 0, r);
}
template <> __device__ __forceinline__ void cvt_decode<1>(const Ptrs& P, int it, CvtJob& J) {
    bf16* WGU = (bf16*)(P.ws + WS_WGU); bf16* WD = (bf16*)(P.ws + WS_WD);
    int r = it;
    if (r < CI_GU) { cvt_job(J, P.w2g, FF, P.g2, WGU, D, 0, 1, r); return; } r -= CI_GU;
    cvt_job(J, P.w2u, FF, P.g2, WGU, D, 0, 2, r);
}
template <> __device__ __forceinline__ void cvt_decode<3>(const Ptrs& P, int it, CvtJob& J) { cvt_job(J, P.w2d, D, nullptr, (bf16*)(P.ws + WS_WD), FF, 0, 0, it); }
template <int SET> __device__ __forceinline__ void cvt_run(Frame& F, const Ptrs& P, int gw, int NGW) {
    constexpr int NITEMS = SET == 0 ? 2 * CI_GU + CI_D + CI_IN0 : (SET == 1 ? 2 * CI_GU : (SET == 3 ? CI_D : (CI_IN - CI_IN0) + CI_A + CI_B + CI_O));
    LAS unsigned char* img = F.lds + RING_OFF + F.wave * 16384;
    const int lane = F.lane;
    f32x4 va[16], vb[16]; CvtJob Ja, Jb;
    int it = gw;
    if (it >= NITEMS) return;
    cvt_decode<SET>(P, it, Ja); cvt_load(Ja, lane, va);
    for (;;) {
        int nx = it + NGW;
        cvt_decode<SET>(P, nx < NITEMS ? nx : NITEMS - 1, Jb); cvt_load(Jb, lane, vb);
        cvt_store(Ja, va, img, lane);
        it = nx; if (it >= NITEMS) break;
        nx = it + NGW;
        cvt_decode<SET>(P, nx < NITEMS ? nx : NITEMS - 1, Ja); cvt_load(Ja, lane, va);
        cvt_store(Jb, vb, img, lane);
        it = nx; if (it >= NITEMS) break;
    }
}
__device__ __forceinline__ void p0_prologue(Frame& F, const Ptrs& P) {
    const int gw = F.vcu * NWAVES + F.wave, NGW = F.G * NWAVES;
    { float* tab = (float*)(P.ws + WS_ROPE);
      const float inv[16] = {1.000000000e+00f, 4.403665960e-01f, 1.939227432e-01f, 8.539710194e-02f, 3.760603070e-02f, 1.656044088e-02f, 7.292664610e-03f, 3.211446106e-03f,
                             1.414213562e-03f, 6.227724371e-04f, 2.742481884e-04f, 1.207697351e-04f, 5.318295734e-05f, 2.341999971e-05f, 1.031338525e-05f, 4.541670478e-06f};
      for (int pos = gw * 64 + F.lane; pos < 16384; pos += NGW * 64) {
#pragma unroll
          for (int i = 0; i < 16; ++i) { const float ang = (float)pos * inv[i]; float s, c; sincos_acc(ang, s, c); tab[(size_t)pos * 32 + i] = c; tab[(size_t)pos * 32 + 16 + i] = s; } } }
    { bf16* XB = (bf16*)(P.ws + WS_AB1); float* ss0 = (float*)(P.ws + WS_SS0);
      for (int m = gw; m < M; m += NGW) { const float* xrow = (m < M_P) ? P.xp + (size_t)m * D : P.xs + (size_t)(m - M_P) * D;
          const GAS f32x4* xr = (const GAS f32x4*)xrow + F.lane; GAS v2u* o8 = (GAS v2u*)(XB + (size_t)m * D) + F.lane; float s = 0.f;
#pragma unroll
          for (int j = 0; j < 16; ++j) { const f32x4 v = __builtin_nontemporal_load(xr + 64 * j); s += (v.x * v.x + v.y * v.y) + (v.z * v.z + v.w * v.w); v2u w; w.x = pk2(v.x, v.y); w.y = pk2(v.z, v.w); o8[64 * j] = w; }
          s = wave_sum(s); if (F.lane == 0) ss0[m] = s; } }
    cvt_run<0>(F, P, gw, NGW);
}
__device__ __forceinline__ void p4_convert_w2(Frame& F, const Ptrs& P) { cvt_run<1>(F, P, F.vcu * NWAVES + F.wave, F.G * NWAVES); }

__device__ __forceinline__ unsigned off_b(unsigned row, unsigned ch) { return 256u * row + 16u * (ch ^ (((row & 3) << 2) | ((row >> 2) & 3))); }
struct AttState2 { float m[2], l[2]; f32x4 O[2][8]; };

struct AttLane { unsigned choff[4]; };
__device__ __forceinline__ void att_lane_init(AttLane& L, int lane) {
    const unsigned i = lane & 15, g = lane >> 4;
#pragma unroll
    for (int j = 0; j < 4; ++j) L.choff[j] = 16u * (i ^ ((g << 2) | (unsigned)j));
}
__device__ __forceinline__ void k_load(bf16x8 (&kf)[2][4], const bf16* Kb, int S, int tb, int dil, int lane) {
    const int i = lane & 15, g = lane >> 4;
    const int kk_a = 8 * (i >> 2) + (i & 3);
#pragma unroll
    for (int t = 0; t < 2; ++t) { int tk = tb + dil * (kk_a + 4 * t); tk = max(0, min(tk, S - 1)); const bf16* kp = Kb + (size_t)tk * QKVW + 8 * g;
#pragma unroll
        for (int s = 0; s < 4; ++s) kf[t][s] = *(const bf16x8*)(kp + 32 * s); }
}
__device__ __forceinline__ void v_dma(LAS unsigned char* vbuf, const bf16* Vb, int S, int tb, int dil, int lane, const AttLane& L) {
    const int g = lane >> 4;
    if (tb >= 0 && tb + 31 * dil < S) {
        const char* p0 = (const char*)(Vb + (size_t)(tb + dil * g) * QKVW); const size_t rstep = (size_t)(4 * dil) * QKVW * 2;
#pragma unroll
        for (int c = 0; c < 8; ++c) __builtin_amdgcn_global_load_lds((const unsigned*)(p0 + c * rstep + L.choff[c & 3]), (LAS unsigned*)(vbuf + 1024 * c), 16, 0, 0);
    } else {
#pragma unroll
        for (int c = 0; c < 8; ++c) { int tk = tb + dil * (4 * c + g); tk = max(0, min(tk, S - 1));
            __builtin_amdgcn_global_load_lds((const unsigned*)((const char*)(Vb + (size_t)tk * QKVW) + L.choff[c & 3]), (LAS unsigned*)(vbuf + 1024 * c), 16, 0, 0); }
    }
    asm volatile("" ::: "memory");
}
template <int BUF>
__device__ __forceinline__ void kv_compute2(AttState2& st, bf16x8 (&kf)[2][4], const bf16x8 (&qf)[2][4], int S, int tb, int dil, const int (&mlo)[2], const unsigned (&mspan)[2],
                                            LAS unsigned char* vl, int lane, const AttLane& L, bool pf, const bf16* Kb, const bf16* Vb, int tbn) {
    const int g = lane >> 4;
    f32x4 sc[2][2];
#pragma unroll
    for (int q = 0; q < 2; ++q)
#pragma unroll
        for (int t = 0; t < 2; ++t) { sc[q][t] = (f32x4){0.f, 0.f, 0.f, 0.f};
#pragma unroll
            for (int s = 0; s < 4; ++s) sc[q][t] = __builtin_amdgcn_mfma_f32_16x16x32_bf16(kf[t][s], qf[q][s], sc[q][t], 0, 0, 0); }
    if (pf) v_dma(vl + (BUF ? 0 : 8192), Vb, S, tbn, dil, lane, L);
    bf16x8 pf16[2];
#pragma unroll
    for (int q = 0; q < 2; ++q) {
        const int x0 = tb + dil * 8 * g - mlo[q];
        float mx = -__builtin_inff();
#pragma unroll
        for (int t = 0; t < 2; ++t)
#pragma unroll
            for (int r = 0; r < 4; ++r) { const bool ok = (unsigned)(x0 + dil * (4 * t + r)) <= mspan[q]; sc[q][t][r] = ok ? sc[q][t][r] : -__builtin_inff(); mx = fmaxf(mx, sc[q][t][r]); }
        mx = fmaxf(mx, __shfl_xor(mx, 16)); mx = fmaxf(mx, __shfl_xor(mx, 32));
        if (__builtin_amdgcn_ballot_w64(mx > st.m[q] + 8.0f) != 0ull) {
            const float mn = fmaxf(st.m[q], mx), alpha = __builtin_amdgcn_exp2f(st.m[q] - mn);
            st.l[q] *= alpha; st.m[q] = mn;
#pragma unroll
            for (int dt = 0; dt < 8; ++dt) st.O[q][dt] *= alpha;
        }
        float ps = 0.f; float p[8];
#pragma unroll
        for (int t = 0; t < 2; ++t)
#pragma unroll
            for (int r = 0; r < 4; ++r) { p[4 * t + r] = __builtin_amdgcn_exp2f(sc[q][t][r] - st.m[q]); ps += p[4 * t + r]; }
        st.l[q] += ps;
        v4u pw; pw.x = pk2(p[0], p[1]); pw.y = pk2(p[2], p[3]); pw.z = pk2(p[4], p[5]); pw.w = pk2(p[6], p[7]);
        pf16[q] = __builtin_bit_cast(bf16x8, pw);
    }
    if (pf) asm volatile("s_waitcnt vmcnt(8)" ::: "memory"); else asm volatile("s_waitcnt vmcnt(0)" ::: "memory");
    const unsigned vb = (unsigned)(uintptr_t)vl;
#define TR4(k) asm volatile("ds_read_b64_tr_b16 %0, %4 offset:%8\n\tds_read_b64_tr_b16 %1, %5 offset:%8\n\tds_read_b64_tr_b16 %2, %6 offset:%8\n\tds_read_b64_tr_b16 %3, %7 offset:%8" \
        : "=&v"(f[k]), "=&v"(f[k + 1]), "=&v"(f[k + 2]), "=&v"(f[k + 3]) : "v"(a[k]), "v"(a[k + 1]), "v"(a[k + 2]), "v"(a[k + 3]), "i"(BUF ? 8192 : 0) : "memory")
#pragma unroll
    for (int hf = 0; hf < 2; ++hf) {
        unsigned a[8]; s16x4 f[8];
        int ln = lane; asm volatile("" : "+v"(ln));
        const unsigned g2 = ln >> 4, q2 = (ln & 15) >> 2, pp = ln & 3;
#pragma unroll
        for (int k = 0; k < 4; ++k) { const int dt = 4 * hf + k; a[2 * k] = vb + off_b(8 * g2 + q2, 2 * dt + (pp >> 1)) + 8 * (pp & 1); a[2 * k + 1] = vb + off_b(8 * g2 + 4 + q2, 2 * dt + (pp >> 1)) + 8 * (pp & 1); }
        TR4(0); TR4(4);
        asm volatile("s_waitcnt lgkmcnt(0)" : "+v"(f[0]), "+v"(f[1]), "+v"(f[2]), "+v"(f[3]), "+v"(f[4]), "+v"(f[5]), "+v"(f[6]), "+v"(f[7]) :: "memory");
#pragma unroll
        for (int k = 0; k < 4; ++k) { const int dt = 4 * hf + k;
            const bf16x8 vf = __builtin_shufflevector(f[2 * k], f[2 * k + 1], 0, 1, 2, 3, 4, 5, 6, 7);
            st.O[0][dt] = __builtin_amdgcn_mfma_f32_16x16x32_bf16(vf, pf16[0], st.O[0][dt], 0, 0, 0);
            st.O[1][dt] = __builtin_amdgcn_mfma_f32_16x16x32_bf16(vf, pf16[1], st.O[1][dt], 0, 0, 0); }
    }
#undef TR4
    if (pf) { asm volatile("" ::: "memory"); k_load(kf, Kb, S, tbn, dil, lane); }
}
__device__ __forceinline__ void attn_keys2(AttState2& st, const bf16x8 (&qf)[2][4], const bf16* Kb, const bf16* Vb, int S, const int (&tq)[2], int kstart, int dil, int ntiles, int W,
                                           LAS unsigned char* vl, int lane, const AttLane& L) {
    bf16x8 kf[2][4]; const int tstep = 32 * dil;
    int mlo[2]; unsigned mspan[2];
#pragma unroll
    for (int q = 0; q < 2; ++q) { mlo[q] = max(tq[q] - W, 0); mspan[q] = (unsigned)(min(tq[q] + W, S - 1) - mlo[q]); }
    v_dma(vl, Vb, S, kstart, dil, lane, L); k_load(kf, Kb, S, kstart, dil, lane);
    for (int tile = 0; tile < ntiles; tile += 2) {
        const int tb = kstart + tile * tstep;
        const bool m1 = tile + 1 < ntiles;
        kv_compute2<0>(st, kf, qf, S, tb, dil, mlo, mspan, vl, lane, L, m1, Kb, Vb, tb + tstep);
        if (!m1) break;
        const bool m2 = tile + 2 < ntiles;
        kv_compute2<1>(st, kf, qf, S, tb + tstep, dil, mlo, mspan, vl, lane, L, m2, Kb, Vb, tb + 2 * tstep);
    }
}

template <int HALFW> __device__ __forceinline__ void attn_phase(Frame& F, const Ptrs& P) {
    if (HALFW && F.wave >= 4) return;
    const bf16* QKV = (const bf16*)(P.ws + WS_QKV); bf16* YAB = (bf16*)P.out;
    LAS unsigned char* vl = F.lds + RING_OFF + F.wave * 16384;
    const int gw = HALFW ? F.vcu * 4 + F.wave : F.vcu * NWAVES + F.wave, NGW = HALFW ? F.G * 4 : F.G * NWAVES, lane = F.lane, i = lane & 15, g = lane >> 4;
    AttLane AL; att_lane_init(AL, lane);
    { constexpr int NT = (M / 512) * 8 * 16;
      for (int id = gw; id < NT; id += NGW) {
          const int r16 = id & 15, h = (id >> 4) & 7, rb = id >> 7;
          const int row_blk = rb * 512; const int seq0 = row_blk < 4096 ? 0 : (row_blk < 8192 ? 4096 : 8192); const int S = row_blk < 8192 ? 4096 : 16384;
          const int t0 = row_blk - seq0 + r16; const int tq[2] = {t0 + 16 * i, t0 + 256 + 16 * i};
          AttState2 st;
#pragma unroll
          for (int q = 0; q < 2; ++q) { st.m[q] = -1e30f; st.l[q] = 0.f;
#pragma unroll
              for (int dt = 0; dt < 8; ++dt) st.O[q][dt] = (f32x4){0.f, 0.f, 0.f, 0.f}; }
          const bf16* seqbase = QKV + (size_t)seq0 * QKVW;
#pragma unroll 1
          for (int grp = 0; grp < 3; ++grp) {
              const int dil = grp == 0 ? 1 : (grp == 1 ? 4 : 16); const int ntiles = grp == 0 ? 20 : (grp == 1 ? 8 : 5);
              const int hc = grp * 1024 + h * 128;
              bf16x8 qf[2][4];
#pragma unroll
              for (int q = 0; q < 2; ++q) { const bf16* qp = seqbase + (size_t)tq[q] * QKVW + hc + 8 * g;
#pragma unroll
                  for (int s = 0; s < 4; ++s) qf[q][s] = *(const bf16x8*)(qp + 32 * s); }
              attn_keys2(st, qf, seqbase + 3072 + hc, seqbase + 6144 + hc, S, tq, t0 - 64 * dil, dil, ntiles, 64 * dil, vl, lane, AL);
          }
#pragma unroll
          for (int q = 0; q < 2; ++q) { float l = st.l[q]; l += __shfl_xor(l, 16); l += __shfl_xor(l, 32); const float rl = 1.0f / l;
              bf16* op = YAB + (size_t)(seq0 + tq[q]) * YABW + h * 128 + 4 * g;
#pragma unroll
              for (int dt = 0; dt < 8; ++dt) { const f32x4 o = st.O[q][dt] * rl; v2u w; w.x = pk2(o[0], o[1]); w.y = pk2(o[2], o[3]); *(v2u*)(op + 16 * dt) = w; } }
      } }
    { constexpr int NT = (M / 16) * 8;
      for (int id = gw; id < NT; id += NGW) {
          const int pair = id & 7, blk = id >> 3; const int row0 = blk * 16;
          const int seq0 = row0 < 4096 ? 0 : (row0 < 8192 ? 4096 : 8192); const int S = row0 < 8192 ? 4096 : 16384;
          const int t0 = row0 - seq0; const int tq[2] = {t0 + i, t0 + i};
          AttState2 st;
#pragma unroll
          for (int q = 0; q < 2; ++q) { st.m[q] = -1e30f; st.l[q] = 0.f;
#pragma unroll
              for (int dt = 0; dt < 8; ++dt) st.O[q][dt] = (f32x4){0.f, 0.f, 0.f, 0.f}; }
          const bf16* seqbase = QKV + (size_t)seq0 * QKVW; const int kvh = pair >> 1;
          bf16x8 qf[2][4];
#pragma unroll
          for (int q = 0; q < 2; ++q) { const bf16* qp = seqbase + (size_t)tq[q] * QKVW + 9216 + (2 * pair + q) * 128 + 8 * g;
#pragma unroll
              for (int s = 0; s < 4; ++s) qf[q][s] = *(const bf16x8*)(qp + 32 * s); }
          attn_keys2(st, qf, seqbase + 11264 + kvh * 128, seqbase + 11776 + kvh * 128, S, tq, t0 - 128, 1, 9, 128, vl, lane, AL);
#pragma unroll
          for (int q = 0; q < 2; ++q) { const int qh = 2 * pair + q; float l = st.l[q]; l += __shfl_xor(l, 16); l += __shfl_xor(l, 32);
              const float sk = P.sink[qh] * 1.4426950408889634f; const float m2 = fmaxf(st.m[q], sk); const float e1 = __builtin_amdgcn_exp2f(st.m[q] - m2);
              const float den = l * e1 + __builtin_amdgcn_exp2f(sk - m2); const float rl = e1 / den;
              bf16* op = YAB + (size_t)(seq0 + tq[q]) * YABW + 1024 + qh * 128 + 4 * g;
#pragma unroll
              for (int dt = 0; dt < 8; ++dt) { const f32x4 o = st.O[q][dt] * rl; v2u w; w.x = pk2(o[0], o[1]); w.y = pk2(o[2], o[3]); *(v2u*)(op + 16 * dt) = w; } }
      } }
}

__device__ __forceinline__ void final_norm(Frame& F, const Ptrs& P) {
    const int gw = F.vcu * NWAVES + F.wave, NGW = F.G * NWAVES; const float* ss3 = (const float*)(F.ctl + CW_SS3); const bf16* H3 = (const bf16*)(P.ws + WS_AB1);
    f32x4 gv[8][2];
#pragma unroll
    for (int j = 0; j < 8; ++j) { gv[j][0] = ((const f32x4*)P.gfin)[2 * (F.lane + 64 * j)]; gv[j][1] = ((const f32x4*)P.gfin)[2 * (F.lane + 64 * j) + 1]; }
    for (int m = gw; m < M; m += NGW) { const float rs = __builtin_amdgcn_rsqf(ss3[m] * (1.0f / 4096.0f) + 1e-6f);
        const GAS v4u* hi = (const GAS v4u*)(H3 + (size_t)m * D) + F.lane; GAS f32x4* o = (GAS f32x4*)(P.out + (size_t)m * D) + 2 * F.lane;
#pragma unroll
        for (int j = 0; j < 8; ++j) { const v4u w = hi[64 * j];
            const f32x4 v0 = {pg8::bf_lo(w.x), pg8::bf_hi(w.x), pg8::bf_lo(w.y), pg8::bf_hi(w.y)}, v1 = {pg8::bf_lo(w.z), pg8::bf_hi(w.z), pg8::bf_lo(w.w), pg8::bf_hi(w.w)};
            o[128 * j] = v0 * rs * gv[j][0]; o[128 * j + 1] = v1 * rs * gv[j][1]; } }
}

struct Args { const float* in[17]; float* out; unsigned char* ws; int ph_lo, ph_hi, li, pad; };
__global__ void __launch_bounds__(NWAVES * 64, 2) mk_fwd(Args args) {
    extern __shared__ __attribute__((aligned(16))) unsigned char lds[];
    Frame F;
    F.lds = (LAS unsigned char*)lds;
    F.MISC = (volatile LAS unsigned*)(F.lds + MISC_OFF);
    F.tid = threadIdx.x; F.lane = F.tid & 63; F.wave = __builtin_amdgcn_readfirstlane(F.tid >> 6);
    F.G = gridDim.x; { const int bx = blockIdx.x; F.vcu = (F.G % 8 == 0) ? (bx % 8) * (F.G / 8) + bx / 8 : bx; }
    unsigned char* ws = args.ws;
    F.ctl = (gu32*)(ws + WS_CTL);
    Ptrs P;
    P.xp = args.in[0]; P.xs = args.in[1]; P.g1 = args.in[2]; P.w1g = args.in[3]; P.w1u = args.in[4]; P.w1d = args.in[5]; P.gmix = args.in[6]; P.win = args.in[7]; P.sink = args.in[8];
    P.wa = args.in[9]; P.wb = args.in[10]; P.wout = args.in[11]; P.g2 = args.in[12]; P.w2g = args.in[13]; P.w2u = args.in[14]; P.w2d = args.in[15]; P.gfin = args.in[16];
    P.out = args.out; P.ws = ws;
    for (int u = F.tid; u < (LDS_BYTES - LDSCTL_OFF) / 4; u += NWAVES * 64) ((LAS unsigned*)(F.lds + LDSCTL_OFF))[u] = 0u;
    __syncthreads();
    XcdBarrier bar; bar.bar = (unsigned*)(F.ctl + CW_BAR); bar.x = 0; bar.st = nullptr;
    if (N_LAUNCHES != PER_PHASE) bar = xcd_barrier_post((unsigned*)(F.ctl + CW_BAR), F.MISC + 8);
#define GRID_BAR(seam) do { if (N_LAUNCHES != PER_PHASE) xcd_barrier(bar); } while (0)
    const int lo = args.ph_lo, hi = args.ph_hi;
#define IN(k) (lo <= (k) && (k) < hi)
#define BOTH(k) (IN(k) && IN((k) + 1))
    bf16* AB1 = (bf16*)(ws + WS_AB1); bf16* ACT = (bf16*)(ws + WS_ACT); bf16* QKVB = (bf16*)(ws + WS_QKV);
    bf16* WGU = (bf16*)(ws + WS_WGU); bf16* WDN = (bf16*)(ws + WS_WD); bf16* WIN = (bf16*)(ws + WS_WIN); bf16* WAB = (bf16*)(ws + WS_WAB); bf16* WOUT = (bf16*)(ws + WS_WOUT);
    float* ss0 = (float*)(ws + WS_SS0); float* ss1 = (float*)(F.ctl + CW_SS1); float* ss2 = (float*)(F.ctl + CW_SS2); float* ss3 = (float*)(F.ctl + CW_SS3);
    const float* rope = (const float*)(ws + WS_ROPE);

    if (IN(0)) { for (int rep = 0; rep < NREP(0); ++rep) p0_prologue(F, P); if (BOTH(0)) GRID_BAR(0); }
    if (IN(1)) { pg8::Gemm g{AB1, WGU, M, 2 * FF, D}; pg8::StaticOrder S; S.init(M, 2 * FF, F.G, (int)blockIdx.x, WGM_UP);
        pg8::EpiSwiglu E{ACT, FF, ss0, F.lds + SSL_OFF};
        for (int rep = 0; rep < NREP(1); ++rep)
        pg8::gemm_phase<pg8::EpiSwiglu, pg8::StaticOrder, PG8_ALIGN, PG8_SP2>(F.lds + RING_OFF, g, S, E);
        {
          const int nwg = (M / 256) * (2 * FF / 256), rem = nwg % F.G, c = (int)blockIdx.x;
          if (rem == 0) cvt_run<2>(F, P, c * NWAVES + F.wave, F.G * NWAVES);
          else if (c >= rem) cvt_run<2>(F, P, (c - rem) * NWAVES + F.wave, (F.G - rem) * NWAVES); }
        if (PROBE_REPEAT == 21) { pg8::FixedOrder S2; S2.init(M, 2 * FF, F.G, (int)blockIdx.x); pg8::EpiSwiglu E2{QKVB, FF, ss0, F.lds + SSL_OFF};
            pg8::gemm_phase<pg8::EpiSwiglu, pg8::FixedOrder, PG8_ALIGN, PG8_SP2>(F.lds + RING_OFF, g, S2, E2); }
        if (BOTH(1)) GRID_BAR(1); }
    if (IN(2) && PROBE_REPEAT >= 100 && PROBE_REPEAT < 104) {
        pg8::Gemm g{AB1, WGU, M, 2 * FF, D}; pg8::StaticOrder S; S.init(M, 2 * FF, F.G, (int)blockIdx.x, WGM_UP);
        pg8::EpiSwigluT<(PROBE_REPEAT >= 100 ? PROBE_REPEAT - 100 : 0)> E{QKVB, FF, ss0, F.lds + SSL_OFF};
        pg8::gemm_phase<pg8::EpiSwigluT<(PROBE_REPEAT >= 100 ? PROBE_REPEAT - 100 : 0)>, pg8::StaticOrder, PG8_ALIGN, PG8_SP2>(F.lds + RING_OFF, g, S, E);
        GRID_BAR(1); }
    if (IN(2)) { if (STAGGER_TICKS) xcd_stagger(STAGGER_TICKS); pg8::Gemm g{ACT, WDN, M, D, FF}; pg8::StaticOrder S; S.init(M, D, F.G, (int)blockIdx.x, WGM_DOWN);
        pg8::EpiResid<true, false, true> E{AB1, AB1, M, nullptr, AB1, ss1, 0.5f};
        pg8::gemm_phase<pg8::EpiResid<true, false, true>, pg8::StaticOrder, PG8_ALIGN, PG8_SP2>(F.lds + RING_OFF, g, S, E);
        if (BOTH(2)) GRID_BAR(2); }
    if (IN(3)) { pg8::Gemm g{AB1, WIN, M, NIN, D}; pg8::StaticOrder S; S.init(M, NIN, F.G, (int)blockIdx.x, WGM_IN);
        pg8::EpiProj E{QKVB, ACT, ss1, rope, F.lds + SSL_OFF};
        pg8::gemm_phase<pg8::EpiProj, pg8::StaticOrder, PG8_ALIGN, PG8_SP2>(F.lds + RING_OFF, g, S, E);
        if (NREP(3) == 2) pg8::gemm_phase<pg8::EpiProj, pg8::StaticOrder, PG8_ALIGN, PG8_SP2>(F.lds + RING_OFF, g, S, E);
        if (BOTH(3)) GRID_BAR(3); }
    if (IN(4)) { for (int rep = 0; rep < NREP(4); ++rep) attn_phase<(PROBE_REPEAT == 42) ? 1 : 0>(F, P); for (int rep = 0; rep < NREP(14); ++rep) p4_convert_w2(F, P); if (BOTH(4)) GRID_BAR(4); }
    if (IN(5)) { pg8::Gemm g{(const bf16*)P.out, WAB, M, D, YABW}; pg8::StaticOrder S; S.init(M, D, F.G, (int)blockIdx.x, WGM_DOWN);
        pg8::EpiMerge E{ACT, QKVB};
        for (int rep = 0; rep < NREP(5); ++rep)
        pg8::gemm_phase<pg8::EpiMerge, pg8::StaticOrder, PG8_ALIGN, PG8_SP2>(F.lds + RING_OFF, g, S, E);
        if (BOTH(5)) GRID_BAR(5); }
    if (IN(6)) { if (STAGGER_TICKS) xcd_stagger(STAGGER_TICKS); pg8::Gemm g{QKVB, WOUT, M, D, D}; pg8::StaticOrder S; S.init(M, D, F.G, (int)blockIdx.x, WGM_DOWN);
        pg8::EpiResid<true, false, true> E{AB1, AB1, M, nullptr, AB1, ss2, 1.0f};
        pg8::gemm_phase<pg8::EpiResid<true, false, true>, pg8::StaticOrder, PG8_ALIGN, PG8_SP2>(F.lds + RING_OFF, g, S, E);
        if (BOTH(6)) GRID_BAR(6); }
    if (IN(7)) { pg8::Gemm g{AB1, WGU, M, 2 * FF, D}; pg8::StaticOrder S; S.init(M, 2 * FF, F.G, (int)blockIdx.x, WGM_UP);
        pg8::EpiSwiglu E{ACT, FF, ss2, F.lds + SSL_OFF};
        pg8::gemm_phase<pg8::EpiSwiglu, pg8::StaticOrder, PG8_ALIGN, PG8_SP2>(F.lds + RING_OFF, g, S, E);
        {
          const int nwg = (M / 256) * (2 * FF / 256), rem = nwg % F.G, c = (int)blockIdx.x;
          if (rem == 0) cvt_run<3>(F, P, c * NWAVES + F.wave, F.G * NWAVES);
          else if (c >= rem) cvt_run<3>(F, P, (c - rem) * NWAVES + F.wave, (F.G - rem) * NWAVES); }
        if (BOTH(7)) GRID_BAR(7); }
    if (IN(8)) { if (STAGGER_TICKS) xcd_stagger(STAGGER_TICKS); pg8::Gemm g{ACT, WDN, M, D, FF}; pg8::StaticOrder S; S.init(M, D, F.G, (int)blockIdx.x, WGM_DOWN);
        pg8::EpiResid<true, false, true> E{AB1, AB1, M, nullptr, AB1, ss3, 0.5f};
        pg8::gemm_phase<pg8::EpiResid<true, false, true>, pg8::StaticOrder, PG8_ALIGN, PG8_SP2>(F.lds + RING_OFF, g, S, E);
        if (BOTH(8)) GRID_BAR(8); }
    if (IN(9)) { final_norm(F, P); }
#undef IN
#undef BOTH
#undef GRID_BAR
}

extern "C" void kernel_launch(void* const* d_in, const int* in_sizes, int n_in, void* d_out, int out_size, void* d_ws, size_t ws_size, hipStream_t stream) {
    static int grid = 0;
    if (grid == 0) {
        if (n_in != 17 || out_size != M * D || ws_size < WS_END) { fprintf(stderr, "kernel_launch: unexpected shapes (n_in %d, out %d, ws %zu, need %zu)\n", n_in, out_size, ws_size, (size_t)WS_END); grid = -1; return; }
        int dev = 0, cus = 0, per_cu = 0;
        if (hipGetDevice(&dev) != hipSuccess || hipDeviceGetAttribute(&cus, hipDeviceAttributeMultiprocessorCount, dev) != hipSuccess) { grid = -1; return; }
        if (hipFuncSetAttribute((const void*)mk_fwd, hipFuncAttributeMaxDynamicSharedMemorySize, LDS_BYTES) != hipSuccess) { fprintf(stderr, "kernel_launch: hipFuncSetAttribute failed\n"); grid = -1; return; }
        if (hipOccupancyMaxActiveBlocksPerMultiprocessor(&per_cu, (const void*)mk_fwd, NWAVES * 64, LDS_BYTES) != hipSuccess || per_cu < 1) { fprintf(stderr, "kernel_launch: occupancy query says %d\n", per_cu); }
        (void)hipGetLastError();
        grid = cus;
    }
    if (grid < 0) return;
    (void)hipMemsetAsync((char*)d_ws + WS_CTL, 0, CTL_ZERO_BYTES, stream);
    Args a{};
    for (int i = 0; i < 17; ++i) a.in[i] = (const float*)d_in[i];
    a.out = (float*)d_out; a.ws = (unsigned char*)d_ws; a.pad = 0;
    for (int li = 0; li < N_LAUNCHES; ++li) {
        a.ph_lo = (N_LAUNCHES == PER_PHASE) ? li : 0; a.ph_hi = (N_LAUNCHES == PER_PHASE) ? li + 1 : PER_PHASE; a.li = li;
        hipLaunchKernelGGL(mk_fwd, dim3(grid), dim3(NWAVES * 64), LDS_BYTES, stream, a);
    }
}
```

```cpp
#include <hip/hip_runtime.h>
#include <cstdio>
#include <cstdint>

#ifndef MK_N_LAUNCHES
#define MK_N_LAUNCHES 1
#endif
#ifndef PROBE_REPEAT
#define PROBE_REPEAT -1
#endif
#define NREP(k) ((PROBE_REPEAT == (k)) ? 2 : 1)
#ifndef WGM_DOWN
#define WGM_DOWN 4
#endif
#ifndef WGM_UP
#define WGM_UP 8
#endif
#ifndef WGM_IN
#define WGM_IN 8
#endif
#ifndef RES_DEPTH
#define RES_DEPTH 8
#endif
#ifndef RES_DEPTH_F
#define RES_DEPTH_F 4
#endif
#ifndef STAGGER_TICKS
#define STAGGER_TICKS 0
#endif

namespace pg8 {
#define PG8_LAS __attribute__((address_space(3)))
typedef unsigned short bf16_t;
typedef short bf16x8 __attribute__((ext_vector_type(8)));
typedef float f32x4 __attribute__((ext_vector_type(4)));
typedef unsigned u32x4 __attribute__((ext_vector_type(4)));
constexpr int BM = 256, BK = 64, HALF = 128, HTB = HALF * BK * 2, STAGE_BYTES = 8 * HTB, NXCD = 8, WGM = 8;

__host__ __device__ __forceinline__ int lds_byte(int r, int c) { const int st = (r >> 4) * 2 + (c >> 5), rr = r & 15, cc = c & 31, ob = rr * 64 + cc * 2; return st * 1024 + (ob ^ (((ob >> 9) & 1) << 5)); }
__host__ __device__ __forceinline__ void stage_rc(int b, int& R, int& C) { const int st = b / 1024, sb = b % 1024, swz = sb ^ (((sb >> 9) & 1) << 5); R = (st >> 1) * 16 + swz / 64; C = (st & 1) * 32 + (swz % 64) / 2; }
__host__ __device__ __forceinline__ int perm32(int rho) { const int n = rho >> 4, i = rho & 15; return 8 * (i >> 2) + 4 * n + (i & 3); }

struct Unit { int pm, pn; };
__device__ __forceinline__ void ss_prefetch(const float* ss, PG8_LAS unsigned char* ssl, int pm, int wid, int lane) {
    const float* src = ss + pm * 256 + (wid >> 2) * 64 + lane;
    __builtin_amdgcn_global_load_lds((const unsigned*)src, (PG8_LAS unsigned*)(ssl + wid * 512), 4, 0, 0);
    __builtin_amdgcn_global_load_lds((const unsigned*)(src + 128), (PG8_LAS unsigned*)(ssl + wid * 512 + 256), 4, 0, 0);
}
__device__ __forceinline__ float ss_lds(PG8_LAS unsigned char* ssl, int wr, int wc, int fr, int ai, int m) { return *(const PG8_LAS float*)(ssl + (wr * 4 + wc) * 512 + ai * 256 + (m * 16 + fr) * 4); }
struct Gemm { const bf16_t* A; const bf16_t* Bt; int M, N, K; };

struct StaticOrder {
    int nM, nN, nwg, G, c, wgm;
    __host__ __device__ void init(int M, int N, int G_, int c_, int wgm_ = WGM) { nM = M / BM; nN = N / BM; nwg = nM * nN; G = G_; c = c_; wgm = wgm_; }
    __host__ __device__ bool next(int i, Unit& u) const {
        const long L = (long)i * G + c; if (L >= nwg) return false;
        int wgid = (int)L; { const int q = nwg / NXCD, r = nwg % NXCD, xcd = wgid % NXCD, off = wgid / NXCD; wgid = (xcd < r ? xcd * (q + 1) : r * (q + 1) + (xcd - r) * q) + off; }
        const int nig = wgm * nN, gid = wgid / nig, fm = gid * wgm, gsz = (nM - fm) < wgm ? (nM - fm) : wgm;
        u.pm = fm + ((wgid % nig) % gsz); u.pn = (wgid % nig) / gsz; return true;
    }
    __device__ __forceinline__ void a_ready(const Unit&) const {}
    __device__ __forceinline__ void done(const Unit&) const {}
};

struct FixedOrder : StaticOrder {
    __host__ __device__ bool next(int i, Unit& u) const { Unit t; if (!StaticOrder::next(i, t)) return false; u.pm = 0; u.pn = 0; return true; }
};
__device__ __forceinline__ unsigned cvt_pk_bf16(float lo, float hi) { unsigned r; asm volatile("v_cvt_pk_bf16_f32 %0, %1, %2" : "=v"(r) : "v"(lo), "v"(hi)); return r; }
__device__ __forceinline__ float bf_lo(unsigned w) { return __uint_as_float(w << 16); }
__device__ __forceinline__ float bf_hi(unsigned w) { return __uint_as_float(w & 0xffff0000u); }
__device__ __forceinline__ float sigmoid_f(float x) { return __builtin_amdgcn_rcpf(1.0f + __builtin_amdgcn_exp2f(-1.44269504089f * x)); }


template <int MODE> struct EpiSwigluT {
    static constexpr bool PERM = true, AFTER_DRAIN = false, HAS_MID = false, SS_LDS = true; static constexpr int MID_T = 0, VM_TAIL = (MODE & 1) ? 0 : 8;
    bf16_t* O; int ldc; const float* ss; PG8_LAS unsigned char* ssl;
    __device__ __forceinline__ void mid(f32x4 (&)[2][2][4][2], const Unit&, int, int, int, int) const {}
    __device__ __forceinline__ void operator()(f32x4 (&acc)[2][2][4][2], const Unit& u, int wr, int wc, int fr, int fq) const {
        const int row0 = u.pm * BM + wr * 64 + fr, col0 = u.pn * HALF + wc * 32 + 8 * fq;
        float rs[2][4];
#pragma unroll
        for (int ai = 0; ai < 2; ++ai)
#pragma unroll
            for (int m = 0; m < 4; ++m) rs[ai][m] = (MODE & 2) ? 4096.0f * (float)(fr + 1) : ss_lds(ssl, wr, wc, fr, ai, m);
#pragma unroll
        for (int ai = 0; ai < 2; ++ai)
#pragma unroll
            for (int m = 0; m < 4; ++m) { const int r = row0 + ai * HALF + m * 16; const float rr = __builtin_amdgcn_rsqf(rs[ai][m] * (1.0f / 4096.0f) + 1e-6f);
                const float c1 = -1.44269504089f * rr, rr2 = rr * rr; f32x4 o[2];
#pragma unroll
                for (int n = 0; n < 2; ++n) { const f32x4 g = acc[ai][0][m][n], up = acc[ai][1][m][n]; const f32x4 t = g * c1;
                    f32x4 d = {__builtin_amdgcn_exp2f(t[0]), __builtin_amdgcn_exp2f(t[1]), __builtin_amdgcn_exp2f(t[2]), __builtin_amdgcn_exp2f(t[3])}; d = d + 1.0f;
                    const f32x4 q = {__builtin_amdgcn_rcpf(d[0]), __builtin_amdgcn_rcpf(d[1]), __builtin_amdgcn_rcpf(d[2]), __builtin_amdgcn_rcpf(d[3])};
                    o[n] = ((g * up) * rr2) * q; }
                u32x4 w; w.x = cvt_pk_bf16(o[0][0], o[0][1]); w.y = cvt_pk_bf16(o[0][2], o[0][3]); w.z = cvt_pk_bf16(o[1][0], o[1][1]); w.w = cvt_pk_bf16(o[1][2], o[1][3]);
                if (MODE & 1) asm volatile("" :: "v"(w.x), "v"(w.y), "v"(w.z), "v"(w.w)); else *(u32x4*)(O + (size_t)r * ldc + col0) = w; }
    }
};
using EpiSwiglu = EpiSwigluT<0>;

template <bool BASE_BF16, bool OUT_F32, bool HAS_OB> struct EpiResid {
    static constexpr bool PERM = true, AFTER_DRAIN = false, HAS_MID = false, SS_LDS = false; static constexpr int MID_T = 0, VM_TAIL = (HAS_OB || OUT_F32) ? 16 : 0;
    const void* base_lo; const void* base_hi; int split_row; float* out; bf16_t* ob; float* ss; float scale;
    __device__ __forceinline__ void mid(f32x4 (&)[2][2][4][2], const Unit&, int, int, int, int) const {}
    __device__ __forceinline__ void operator()(f32x4 (&acc)[2][2][4][2], const Unit& u, int wr, int wc, int fr, int fq) const {
        const int row0 = u.pm * BM + wr * 64 + fr, col0 = u.pn * BM + wc * 32 + 8 * fq;
        if constexpr (BASE_BF16) {
            const bf16_t* bb = (const bf16_t*)((u.pm * BM < split_row) ? base_lo : base_hi) - ((u.pm * BM < split_row) ? (size_t)0 : (size_t)split_row * 4096);
            u32x4 tb[RES_DEPTH][2];
#define RES_LOAD(k) do { const size_t off_ = (size_t)(row0 + ((k) >> 2) * HALF + ((k) & 3) * 16) * 4096 + col0; \
                tb[(k) % RES_DEPTH][0] = *(const u32x4*)(bb + off_); tb[(k) % RES_DEPTH][1] = *(const u32x4*)(bb + off_ + HALF); } while (0)
#pragma unroll
            for (int k = 0; k < RES_DEPTH - 1; ++k) RES_LOAD(k);
#pragma unroll
            for (int k = 0; k < 8; ++k) { const int ai = k >> 2, m = k & 3;
                if (k + RES_DEPTH - 1 < 8) RES_LOAD(k + RES_DEPTH - 1);
#pragma unroll
                for (int bj = 0; bj < 2; ++bj) { const u32x4 w = tb[k % RES_DEPTH][bj];
                    acc[ai][bj][m][0] = (f32x4){bf_lo(w.x), bf_hi(w.x), bf_lo(w.y), bf_hi(w.y)} + acc[ai][bj][m][0] * scale;
                    acc[ai][bj][m][1] = (f32x4){bf_lo(w.z), bf_hi(w.z), bf_lo(w.w), bf_hi(w.w)} + acc[ai][bj][m][1] * scale; }
                asm volatile("" : "+v"(acc[ai][0][m][0]), "+v"(acc[ai][0][m][1]), "+v"(acc[ai][1][m][0]), "+v"(acc[ai][1][m][1]));
                __builtin_amdgcn_sched_barrier(0); }
#undef RES_LOAD
        } else {
            const float* bb = (const float*)((u.pm * BM < split_row) ? base_lo : base_hi) - ((u.pm * BM < split_row) ? (size_t)0 : (size_t)split_row * 4096);
            f32x4 tb[RES_DEPTH_F][4];
#define RES_LOAD(k) do { const size_t off_ = (size_t)(row0 + ((k) >> 2) * HALF + ((k) & 3) * 16) * 4096 + col0; \
                tb[(k) % RES_DEPTH_F][0] = __builtin_nontemporal_load((const f32x4*)(bb + off_)); tb[(k) % RES_DEPTH_F][1] = __builtin_nontemporal_load((const f32x4*)(bb + off_ + 4)); tb[(k) % RES_DEPTH_F][2] = __builtin_nontemporal_load((const f32x4*)(bb + off_ + HALF)); tb[(k) % RES_DEPTH_F][3] = __builtin_nontemporal_load((const f32x4*)(bb + off_ + HALF + 4)); } while (0)
#pragma unroll
            for (int k = 0; k < RES_DEPTH_F - 1; ++k) RES_LOAD(k);
#pragma unroll
            for (int k = 0; k < 8; ++k) { const int ai = k >> 2, m = k & 3;
                if (k + RES_DEPTH_F - 1 < 8) RES_LOAD(k + RES_DEPTH_F - 1);
                acc[ai][0][m][0] = tb[k % RES_DEPTH_F][0] + acc[ai][0][m][0] * scale; acc[ai][0][m][1] = tb[k % RES_DEPTH_F][1] + acc[ai][0][m][1] * scale;
                acc[ai][1][m][0] = tb[k % RES_DEPTH_F][2] + acc[ai][1][m][0] * scale; acc[ai][1][m][1] = tb[k % RES_DEPTH_F][3] + acc[ai][1][m][1] * scale;
                asm volatile("" : "+v"(acc[ai][0][m][0]), "+v"(acc[ai][0][m][1]), "+v"(acc[ai][1][m][0]), "+v"(acc[ai][1][m][1]));
                __builtin_amdgcn_sched_barrier(0); }
#undef RES_LOAD
        }
#pragma unroll
        for (int ai = 0; ai < 2; ++ai)
#pragma unroll
            for (int m = 0; m < 4; ++m) { const int r = row0 + ai * HALF + m * 16; const size_t off = (size_t)r * 4096 + col0; float sq = 0.f;
#pragma unroll
                for (int bj = 0; bj < 2; ++bj) { const f32x4 v0 = acc[ai][bj][m][0], v1 = acc[ai][bj][m][1];
                    if (OUT_F32) { *(f32x4*)(out + off + bj * HALF) = v0; *(f32x4*)(out + off + bj * HALF + 4) = v1; }
                    sq += (v0[0] * v0[0] + v0[1] * v0[1]) + (v0[2] * v0[2] + v0[3] * v0[3]) + (v1[0] * v1[0] + v1[1] * v1[1]) + (v1[2] * v1[2] + v1[3] * v1[3]);
                    if (HAS_OB) { u32x4 w; w.x = cvt_pk_bf16(v0[0], v0[1]); w.y = cvt_pk_bf16(v0[2], v0[3]); w.z = cvt_pk_bf16(v1[0], v1[1]); w.w = cvt_pk_bf16(v1[2], v1[3]); *(u32x4*)(ob + off + bj * HALF) = w; } }
                sq += __shfl_xor(sq, 16); sq += __shfl_xor(sq, 32);
                if (fq == 0) __hip_atomic_fetch_add(ss + r, sq, __ATOMIC_RELAXED, __HIP_MEMORY_SCOPE_AGENT); }
    }
};

struct EpiProj {
    static constexpr bool PERM = true, AFTER_DRAIN = false, HAS_MID = false, SS_LDS = true; static constexpr int MID_T = 0, VM_TAIL = 16;
    bf16_t* qkv; bf16_t* gates; const float* ss; const float* rope; PG8_LAS unsigned char* ssl;
    __device__ __forceinline__ void mid(f32x4 (&)[2][2][4][2], const Unit&, int, int, int, int) const {}
    __device__ __forceinline__ void operator()(f32x4 (&acc)[2][2][4][2], const Unit& u, int wr, int wc, int fr, int fq) const {
        const int pn = u.pn; const bool is_gate = pn >= 48, is_rope = (pn < 24) || (pn >= 36 && pn < 46);
        const int row0 = u.pm * BM + wr * 64 + fr, cw = wc * 32 + 8 * fq;
        bf16_t* dst = is_gate ? gates + (pn - 48) * BM + cw : qkv + pn * BM + cw; const int ld = is_gate ? 8192 : 12288;
        const bool do_rope = is_rope && (wc == 0); const float sgn = fq < 2 ? -1.0f : 1.0f;
        float rs[2][4];
#pragma unroll
        for (int ai = 0; ai < 2; ++ai)
#pragma unroll
            for (int m = 0; m < 4; ++m) rs[ai][m] = ss_lds(ssl, wr, wc, fr, ai, m);
#pragma unroll
        for (int ai = 0; ai < 2; ++ai)
#pragma unroll
            for (int m = 0; m < 4; ++m) { const int r = row0 + ai * HALF + m * 16; const float rr = __builtin_amdgcn_rsqf(rs[ai][m] * (1.0f / 4096.0f) + 1e-6f);
#pragma unroll
                for (int bj = 0; bj < 2; ++bj) { acc[ai][bj][m][0] *= rr; acc[ai][bj][m][1] *= rr; }
                if (do_rope) { const int pos = r < 8192 ? (r & 4095) : r - 8192; const float* tp = rope + (size_t)pos * 32 + 8 * (fq & 1);
                    const f32x4 c0 = *(const f32x4*)tp, c1 = *(const f32x4*)(tp + 4), s0 = *(const f32x4*)(tp + 16), s1 = *(const f32x4*)(tp + 20);
#pragma unroll
                    for (int bj = 0; bj < 2; ++bj) { f32x4 v0 = acc[ai][bj][m][0], v1 = acc[ai][bj][m][1];
#pragma unroll
                        for (int j = 0; j < 4; ++j) { const float p0 = __shfl_xor(v0[j], 32), p1 = __shfl_xor(v1[j], 32); v0[j] = v0[j] * c0[j] + sgn * p0 * s0[j]; v1[j] = v1[j] * c1[j] + sgn * p1 * s1[j]; }
                        acc[ai][bj][m][0] = v0; acc[ai][bj][m][1] = v1; } } }
#pragma unroll
        for (int ai = 0; ai < 2; ++ai)
#pragma unroll
            for (int m = 0; m < 4; ++m) { const int r = row0 + ai * HALF + m * 16;
                if (is_gate) {
                    bf16_t* gd = gates + (size_t)r * 8192 + (pn - 48) * HALF + cw; f32x4 uu[2], sbv[2];
#pragma unroll
                    for (int n = 0; n < 2; ++n)
#pragma unroll
                        for (int j = 0; j < 4; ++j) { const float sa = sigmoid_f(acc[ai][0][m][n][j]), sb = sigmoid_f(acc[ai][1][m][n][j]); sbv[n][j] = sb; uu[n][j] = sa * __builtin_amdgcn_rcpf(fmaxf(sb, 1e-20f)); }
                    u32x4 w; w.x = cvt_pk_bf16(uu[0][0], uu[0][1]); w.y = cvt_pk_bf16(uu[0][2], uu[0][3]); w.z = cvt_pk_bf16(uu[1][0], uu[1][1]); w.w = cvt_pk_bf16(uu[1][2], uu[1][3]);
                    *(u32x4*)gd = w;
                    w.x = cvt_pk_bf16(sbv[0][0], sbv[0][1]); w.y = cvt_pk_bf16(sbv[0][2], sbv[0][3]); w.z = cvt_pk_bf16(sbv[1][0], sbv[1][1]); w.w = cvt_pk_bf16(sbv[1][2], sbv[1][3]);
                    *(u32x4*)(gd + 4096) = w;
                } else {
#pragma unroll
                    for (int bj = 0; bj < 2; ++bj) { const f32x4 v0 = acc[ai][bj][m][0], v1 = acc[ai][bj][m][1];
                        u32x4 w; w.x = cvt_pk_bf16(v0[0], v0[1]); w.y = cvt_pk_bf16(v0[2], v0[3]); w.z = cvt_pk_bf16(v1[0], v1[1]); w.w = cvt_pk_bf16(v1[2], v1[3]);
                        *(u32x4*)(dst + (size_t)r * ld + bj * HALF) = w; } } }
    }
};

struct EpiMerge {
    static constexpr bool PERM = true, AFTER_DRAIN = false, HAS_MID = true, SS_LDS = false; static constexpr int MID_T = 16, VM_TAIL = 16;
    const bf16_t* gates; bf16_t* O;
    static constexpr int MID_DEPTH = 4, END_DEPTH = 8;
    __device__ __forceinline__ void mid(f32x4 (&acc)[2][2][4][2], const Unit& u, int wr, int wc, int fr, int fq) const {
        const __amdgpu_buffer_rsrc_t rsG = __builtin_amdgcn_make_buffer_rsrc((void*)gates, (short)0, (int)0xffffffffu, 0x00020000);
        int vo = ((u.pm * BM + wr * 64 + fr) * 8192 + u.pn * BM + wc * 32 + 8 * fq) * 2; asm volatile("" : "+v"(vo));
        u32x4 ta[MID_DEPTH][2];
#define MG_LOAD(k) do { const int o_ = vo + (((k) >> 2) * HALF + ((k) & 3) * 16) * 16384; _Pragma("unroll") for (int bj = 0; bj < 2; ++bj) ta[(k) % MID_DEPTH][bj] = __builtin_amdgcn_raw_buffer_load_b128(rsG, o_ + bj * 256, 0, 0); } while (0)
#pragma unroll
        for (int k = 0; k < MID_DEPTH - 1; ++k) MG_LOAD(k);
#pragma unroll
        for (int k = 0; k < 8; ++k) { const int ai = k >> 2, m = k & 3;
            if (k + MID_DEPTH - 1 < 8) MG_LOAD(k + MID_DEPTH - 1);
#pragma unroll
            for (int bj = 0; bj < 2; ++bj) { const u32x4 a = ta[k % MID_DEPTH][bj];
                acc[ai][bj][m][0] *= (f32x4){bf_lo(a.x), bf_hi(a.x), bf_lo(a.y), bf_hi(a.y)}; acc[ai][bj][m][1] *= (f32x4){bf_lo(a.z), bf_hi(a.z), bf_lo(a.w), bf_hi(a.w)}; }
            asm volatile("" : "+v"(acc[ai][0][m][0]), "+v"(acc[ai][0][m][1]), "+v"(acc[ai][1][m][0]), "+v"(acc[ai][1][m][1]));
            __builtin_amdgcn_sched_barrier(0); }
#undef MG_LOAD
    }
    __device__ __forceinline__ void operator()(f32x4 (&acc)[2][2][4][2], const Unit& u, int wr, int wc, int fr, int fq) const {
        const int row0 = u.pm * BM + wr * 64 + fr, col0 = u.pn * BM + wc * 32 + 8 * fq;
        { const __amdgpu_buffer_rsrc_t rsG = __builtin_amdgcn_make_buffer_rsrc((void*)gates, (short)0, (int)0xffffffffu, 0x00020000);
          const int vo = (row0 * 8192 + col0) * 2;
          u32x4 tb[END_DEPTH][2];
#define MG_LOAD(k) do { const int o_ = vo + (((k) >> 2) * HALF + ((k) & 3) * 16) * 16384; _Pragma("unroll") for (int bj = 0; bj < 2; ++bj) tb[(k) % END_DEPTH][bj] = __builtin_amdgcn_raw_buffer_load_b128(rsG, o_ + bj * 256, 8192, 0); } while (0)
#pragma unroll
          for (int k = 0; k < END_DEPTH - 1; ++k) MG_LOAD(k);
#pragma unroll
          for (int k = 0; k < 8; ++k) { const int ai = k >> 2, m = k & 3;
              if (k + END_DEPTH - 1 < 8) MG_LOAD(k + END_DEPTH - 1);
#pragma unroll
              for (int bj = 0; bj < 2; ++bj) { const u32x4 b = tb[k % END_DEPTH][bj]; f32x4 g0, g1;
                  g0[0] = fmaxf(bf_lo(b.x), 1e-20f); g0[1] = fmaxf(bf_hi(b.x), 1e-20f); g0[2] = fmaxf(bf_lo(b.y), 1e-20f); g0[3] = fmaxf(bf_hi(b.y), 1e-20f);
                  g1[0] = fmaxf(bf_lo(b.z), 1e-20f); g1[1] = fmaxf(bf_hi(b.z), 1e-20f); g1[2] = fmaxf(bf_lo(b.w), 1e-20f); g1[3] = fmaxf(bf_hi(b.w), 1e-20f);
                  acc[ai][bj][m][0] *= g0; acc[ai][bj][m][1] *= g1; }
              asm volatile("" : "+v"(acc[ai][0][m][0]), "+v"(acc[ai][0][m][1]), "+v"(acc[ai][1][m][0]), "+v"(acc[ai][1][m][1]));
              __builtin_amdgcn_sched_barrier(0); }
#undef MG_LOAD
        }
#pragma unroll
        for (int ai = 0; ai < 2; ++ai)
#pragma unroll
            for (int m = 0; m < 4; ++m) { const int r = row0 + ai * HALF + m * 16;
#pragma unroll
                for (int bj = 0; bj < 2; ++bj) { const f32x4 a0 = acc[ai][bj][m][0], a1 = acc[ai][bj][m][1];
                    u32x4 w; w.x = cvt_pk_bf16(a0[0], a0[1]); w.y = cvt_pk_bf16(a0[2], a0[3]); w.z = cvt_pk_bf16(a1[0], a1[1]); w.w = cvt_pk_bf16(a1[2], a1[3]);
                    *(u32x4*)(O + (size_t)r * 4096 + col0 + bj * HALF) = w; } }
    }
};

template <class Epi, class Sched, bool ALIGN_EPI = false, bool SP2 = false>
__device__ __forceinline__ void gemm_phase(PG8_LAS unsigned char* lds, const Gemm g, const Sched& S, const Epi& E) {
    const int tid = threadIdx.x, wid = __builtin_amdgcn_readfirstlane(tid >> 6), lane = tid & 63, wr = wid >> 2, wc = wid & 3, fr = lane & 15, fq = lane >> 4;
    const int K = g.K, nt = K / BK;
    unsigned voffA[2], voffB[2];
#pragma unroll
    for (int i = 0; i < 2; ++i) { int R, C; stage_rc(tid * 16 + i * 8192, R, C); const int Rb = Epi::PERM ? ((R & ~31) + perm32(R & 31)) : R;
        voffA[i] = (unsigned)(R * K + C) * 2u; voffB[i] = (unsigned)(Rb * K + C) * 2u; }
    const unsigned kstep = (unsigned)(BK * 2);
    const unsigned hstep = (unsigned)HALF * (unsigned)K * 2u;
    const unsigned tstep = 2u * hstep;
    const __amdgpu_buffer_rsrc_t rsA = __builtin_amdgcn_make_buffer_rsrc((void*)g.A, (short)0, (int)0xffffffffu, 0x00020000);
    const __amdgpu_buffer_rsrc_t rsB = __builtin_amdgcn_make_buffer_rsrc((void*)g.Bt, (short)0, (int)0xffffffffu, 0x00020000);
    const unsigned ldsw = (unsigned)wid * 1024u;
    const int aoff = lds_byte(wr * 64 + fr, fq * 8), boff = lds_byte(wc * 32 + fr, fq * 8);
#define PG8_SA(b, h) (((b) * 2 + (h)) * HTB)
#define PG8_SB(b, h) ((4 + (b) * 2 + (h)) * HTB)
#define PG8_STAGE(bufoff, rs, soff, voff) do { _Pragma("unroll") for (int _i = 0; _i < 2; ++_i) \
        __builtin_amdgcn_raw_ptr_buffer_load_lds(rs, (PG8_LAS unsigned*)(lds + (bufoff) + ldsw + _i * 8192), 16, (int)(voff)[_i], (int)(soff), 0, 0); } while (0)
#define PG8_LDA(dst, b, h) do { _Pragma("unroll") for (int m = 0; m < 4; ++m) _Pragma("unroll") for (int k = 0; k < 2; ++k) dst[m][k] = *(const PG8_LAS bf16x8*)(lds + PG8_SA(b, h) + aoff + m * 2048 + k * 1024); } while (0)
#define PG8_LDB(dst, b, h) do { _Pragma("unroll") for (int n = 0; n < 2; ++n) _Pragma("unroll") for (int k = 0; k < 2; ++k) dst[n][k] = *(const PG8_LAS bf16x8*)(lds + PG8_SB(b, h) + boff + n * 2048 + k * 1024); } while (0)
#define PG8_MMA(ai, bj, At, Bt) do { __builtin_amdgcn_s_setprio(1); _Pragma("unroll") for (int m = 0; m < 4; ++m) _Pragma("unroll") for (int n = 0; n < 2; ++n) _Pragma("unroll") for (int k = 0; k < 2; ++k) \
        acc[ai][bj][m][n] = __builtin_amdgcn_mfma_f32_16x16x32_bf16(Bt[n][k], At[m][k], acc[ai][bj][m][n], 0, 0, 0); __builtin_amdgcn_s_setprio(0); } while (0)
#define PG8_WAIT_V(n) asm volatile("s_waitcnt vmcnt(" #n ")" ::: "memory")
#define PG8_WAIT_VN(N) asm volatile("s_waitcnt vmcnt(%0)" :: "n"(N) : "memory")
#define PG8_WAIT_L(n) asm volatile("s_waitcnt lgkmcnt(" #n ")" ::: "memory")
#define PG8_BAR __builtin_amdgcn_s_barrier()
#define PG8_SCHED __builtin_amdgcn_sched_barrier(0)
    Unit cur, nxt; int ui = 0;
    if (!S.next(0, cur)) return;
    f32x4 acc[2][2][4][2];
#pragma unroll
    for (int a = 0; a < 2; ++a)
#pragma unroll
        for (int b = 0; b < 2; ++b)
#pragma unroll
            for (int m = 0; m < 4; ++m)
#pragma unroll
                for (int n = 0; n < 2; ++n) acc[a][b][m][n] = (f32x4){0.f, 0.f, 0.f, 0.f};
    bf16x8 At[4][2], B0[2][2], B1[2][2];
    unsigned cA = __builtin_amdgcn_readfirstlane((unsigned)cur.pm * tstep), cB = __builtin_amdgcn_readfirstlane((unsigned)cur.pn * tstep);
    S.a_ready(cur);
    if constexpr (Epi::SS_LDS) ss_prefetch(E.ss, E.ssl, cur.pm, wid, lane);
    if constexpr (SP2) {
        PG8_STAGE(PG8_SB(0, 0), rsB, cB, voffB); PG8_STAGE(PG8_SB(0, 1), rsB, cB + hstep, voffB); PG8_STAGE(PG8_SA(0, 0), rsA, cA, voffA); PG8_STAGE(PG8_SA(0, 1), rsA, cA + hstep, voffA);
        if (wr == 1) PG8_BAR;
        PG8_WAIT_V(2); PG8_BAR;
        PG8_STAGE(PG8_SB(1, 0), rsB, cB + kstep, voffB); PG8_STAGE(PG8_SA(1, 0), rsA, cA + kstep, voffA); PG8_STAGE(PG8_SB(1, 1), rsB, cB + hstep + kstep, voffB);
        PG8_WAIT_V(0); PG8_BAR;
    } else {
        PG8_STAGE(PG8_SB(0, 0), rsB, cB, voffB); PG8_STAGE(PG8_SA(0, 0), rsA, cA, voffA); PG8_STAGE(PG8_SB(0, 1), rsB, cB + hstep, voffB); PG8_STAGE(PG8_SA(0, 1), rsA, cA + hstep, voffA);
        if (wr == 1) PG8_BAR;
        PG8_WAIT_V(4); PG8_BAR;
        PG8_STAGE(PG8_SB(1, 0), rsB, cB + kstep, voffB); PG8_STAGE(PG8_SA(1, 0), rsA, cA + kstep, voffA); PG8_STAGE(PG8_SB(1, 1), rsB, cB + hstep + kstep, voffB);
        PG8_WAIT_V(6); PG8_BAR;
    }
    for (;;) {
        const bool has_next = S.next(ui + 1, nxt);
        const unsigned nA = __builtin_amdgcn_readfirstlane(has_next ? (unsigned)nxt.pm * tstep : cA), nB = __builtin_amdgcn_readfirstlane(has_next ? (unsigned)nxt.pn * tstep : cB);
#define PG8_KADDR const bool last = (t == nt - 2); const unsigned a1 = cA + (unsigned)(t + 1) * kstep; \
            const unsigned a2 = last ? nA : cA + (unsigned)(t + 2) * kstep, b2 = last ? nB : cB + (unsigned)(t + 2) * kstep, a3 = a2 + kstep, b3 = b2 + kstep; \
            if (last && has_next) S.a_ready(nxt); \
            if constexpr (Epi::HAS_MID) { if (t == Epi::MID_T) E.mid(acc, cur, wr, wc, fr, fq); }
#define PG8_KPAIR_SP2(W12) do { \
            PG8_LDB(B0, 0, 0); PG8_LDB(B1, 0, 1); PG8_SCHED; PG8_LDA(At, 0, 0); PG8_STAGE(PG8_SA(1, 1), rsA, a1 + hstep, voffA); \
            PG8_WAIT_VN(W12); PG8_WAIT_L(0); PG8_BAR; PG8_MMA(0, 0, At, B0); PG8_MMA(0, 1, At, B1); PG8_BAR; PG8_SCHED; \
            PG8_LDA(At, 0, 1); PG8_STAGE(PG8_SB(0, 0), rsB, b2, voffB); PG8_STAGE(PG8_SB(0, 1), rsB, b2 + hstep, voffB); PG8_STAGE(PG8_SA(0, 0), rsA, a2, voffA); \
            PG8_WAIT_VN(W12); PG8_WAIT_L(0); PG8_BAR; PG8_MMA(1, 0, At, B0); PG8_MMA(1, 1, At, B1); PG8_BAR; PG8_SCHED; \
            PG8_LDB(B0, 1, 0); PG8_LDB(B1, 1, 1); PG8_SCHED; PG8_LDA(At, 1, 0); PG8_STAGE(PG8_SA(0, 1), rsA, a2 + hstep, voffA); \
            PG8_WAIT_V(8); PG8_WAIT_L(0); PG8_BAR; PG8_MMA(0, 0, At, B0); PG8_MMA(0, 1, At, B1); PG8_BAR; PG8_SCHED; \
            PG8_LDA(At, 1, 1); PG8_STAGE(PG8_SB(1, 0), rsB, b3, voffB); PG8_STAGE(PG8_SB(1, 1), rsB, b3 + hstep, voffB); PG8_STAGE(PG8_SA(1, 0), rsA, a3, voffA); \
            PG8_WAIT_V(8); PG8_WAIT_L(0); PG8_BAR; PG8_MMA(1, 0, At, B0); PG8_MMA(1, 1, At, B1); PG8_BAR; PG8_SCHED; } while (0)
        if constexpr (SP2) {
            { const int t = 0; PG8_KADDR; PG8_KPAIR_SP2(8 + Epi::VM_TAIL); }
            for (int t = 2; t < nt; t += 2) { PG8_KADDR; PG8_KPAIR_SP2(8); }
        } else {
        for (int t = 0; t < nt; t += 2) {
            PG8_KADDR;
            PG8_LDB(B0, 0, 0); PG8_SCHED; PG8_LDA(At, 0, 0); PG8_STAGE(PG8_SA(1, 1), rsA, a1 + hstep, voffA);
            PG8_WAIT_L(8); PG8_BAR; PG8_WAIT_L(0); PG8_MMA(0, 0, At, B0); PG8_BAR; PG8_SCHED;
            PG8_LDB(B1, 0, 1); PG8_STAGE(PG8_SB(0, 0), rsB, b2, voffB);
            PG8_BAR; PG8_WAIT_L(0); PG8_MMA(0, 1, At, B1); PG8_BAR;
            PG8_LDA(At, 0, 1); PG8_STAGE(PG8_SA(0, 0), rsA, a2, voffA);
            PG8_BAR; PG8_WAIT_L(0); PG8_MMA(1, 0, At, B0); PG8_BAR; PG8_SCHED;
            PG8_STAGE(PG8_SB(0, 1), rsB, b2 + hstep, voffB);
            PG8_WAIT_V(6); PG8_BAR; PG8_MMA(1, 1, At, B1); PG8_BAR;
            PG8_LDB(B0, 1, 0); PG8_SCHED; PG8_LDA(At, 1, 0); PG8_STAGE(PG8_SA(0, 1), rsA, a2 + hstep, voffA);
            PG8_WAIT_L(8); PG8_BAR; PG8_WAIT_L(0); PG8_MMA(0, 0, At, B0); PG8_BAR; PG8_SCHED;
            PG8_LDB(B1, 1, 1); PG8_STAGE(PG8_SB(1, 0), rsB, b3, voffB);
            PG8_BAR; PG8_WAIT_L(0); PG8_MMA(0, 1, At, B1); PG8_BAR;
            PG8_LDA(At, 1, 1); PG8_STAGE(PG8_SA(1, 0), rsA, a3, voffA);
            PG8_BAR; PG8_WAIT_L(0); PG8_MMA(1, 0, At, B0); PG8_BAR; PG8_SCHED;
            PG8_STAGE(PG8_SB(1, 1), rsB, b3 + hstep, voffB);
            PG8_WAIT_V(6); PG8_BAR; PG8_MMA(1, 1, At, B1); PG8_BAR;
        }
        }
        if constexpr (ALIGN_EPI) { if (wr == 0) PG8_BAR; }
        if constexpr (!Epi::AFTER_DRAIN) { E(acc, cur, wr, wc, fr, fq); S.done(cur); }
        if (!has_next) break;
#pragma unroll
        for (int a = 0; a < 2; ++a)
#pragma unroll
            for (int b = 0; b < 2; ++b)
#pragma unroll
                for (int m = 0; m < 4; ++m)
#pragma unroll
                    for (int n = 0; n < 2; ++n) acc[a][b][m][n] = (f32x4){0.f, 0.f, 0.f, 0.f};
        cur = nxt; cA = nA; cB = nB; ++ui;
        if constexpr (Epi::SS_LDS) ss_prefetch(E.ss, E.ssl, cur.pm, wid, lane);
        if constexpr (ALIGN_EPI) { if (wr == 1) PG8_BAR; }
    }
    PG8_WAIT_V(0);
    if constexpr (!ALIGN_EPI) { if (wr == 0) PG8_BAR; }
    PG8_BAR;
#undef PG8_SA
#undef PG8_SB
#undef PG8_STAGE
#undef PG8_LDA
#undef PG8_LDB
#undef PG8_MMA
#undef PG8_WAIT_V
#undef PG8_WAIT_L
#undef PG8_WAIT_VN
#undef PG8_KADDR
#undef PG8_KPAIR_SP2
#undef PG8_BAR
#undef PG8_SCHED
}
}

#ifndef PG8_SP2
#define PG8_SP2 true
#endif
#ifndef PG8_ALIGN
#define PG8_ALIGN true
#endif

constexpr int NWAVES = 8;
constexpr int N_LAUNCHES = MK_N_LAUNCHES;
constexpr int PER_PHASE = 10;
constexpr int D = 4096, FF = 11008, NIN = 20480, QKVW = 12288, GATEW = 8192, YABW = 3072;
constexpr int M_P = 8192, M_S = 16384, M = M_P + M_S;
constexpr float QSCALE = 0.08838834764831845f * 1.4426950408889634f;

constexpr size_t MiB = 1u << 20;
constexpr size_t WS_CTL = 0, CTL_ZERO_BYTES = 1 * MiB;
constexpr size_t WS_SS0 = 1 * MiB;
constexpr size_t WS_ROPE = 2 * MiB;
constexpr size_t WS_WIN = 4 * MiB;
constexpr size_t WS_WAB = WS_WIN + (size_t)NIN * D * 2;
constexpr size_t WS_WOUT = WS_WAB + (size_t)D * YABW * 2;
constexpr size_t WS_WGU = WS_WOUT + (size_t)D * D * 2;
constexpr size_t WS_WD = WS_WGU + (size_t)2 * FF * D * 2;
constexpr size_t WS_AB1 = WS_WD + (size_t)D * FF * 2;
constexpr size_t WS_ACT = WS_AB1 + (size_t)M * D * 2;
constexpr size_t WS_QKV = WS_ACT + (size_t)M * FF * 2;
constexpr size_t WS_END = WS_QKV + (size_t)M * QKVW * 2;
constexpr int CW_BAR = 4096;
constexpr int CW_SS1 = 16384, CW_SS2 = CW_SS1 + M, CW_SS3 = CW_SS2 + M;
static_assert((size_t)(CW_SS3 + M) * 4 <= CTL_ZERO_BYTES, "CTL words inside the memset region");
static_assert(WS_SS0 + (size_t)M * 4 <= WS_ROPE && WS_ROPE + (size_t)16384 * 32 * 4 <= WS_WIN, "ws map");

constexpr int RING_OFF = 0, RING_BYTES = 131072;
constexpr int LDSCTL_OFF = RING_BYTES, MISC_OFF = LDSCTL_OFF + 320;
constexpr int SSL_OFF = MISC_OFF + 1024;
constexpr int LDS_BYTES = 147456;

#define GAS __attribute__((address_space(1)))
#define LAS __attribute__((address_space(3)))
typedef unsigned short bf16;
typedef unsigned v4u __attribute__((ext_vector_type(4)));
typedef unsigned v2u __attribute__((ext_vector_type(2)));
typedef float f32x4 __attribute__((ext_vector_type(4)));
typedef short bf16x8 __attribute__((ext_vector_type(8)));
typedef short s16x4 __attribute__((ext_vector_type(4)));
typedef GAS unsigned gu32;
#define RLX_AGENT __ATOMIC_RELAXED, __HIP_MEMORY_SCOPE_AGENT
#define LDS_WAIT() asm volatile("s_waitcnt lgkmcnt(0)" ::: "memory")
#define VM_WAIT() asm volatile("s_waitcnt vmcnt(0)" ::: "memory")
__device__ __forceinline__ unsigned pk2(float lo, float hi) { return pg8::cvt_pk_bf16(lo, hi); }

#define XB_TMO      128
#define XB_XCNT(j)  (256  + 64 * (j))
#define XB_XSUB(j)  (1280 + 64 * (j))
#define XB_XGEN(j)  (2304 + 64 * (j))
#define XB_TOP      3328
#define XB_TOPGEN   3392
#define XCD_BAR_WORDS 3456
#define XB_SPIN_CAP (1u << 18)

__device__ __forceinline__ unsigned xb_ld(unsigned* p)              { return __hip_atomic_load(p, __ATOMIC_RELAXED, __HIP_MEMORY_SCOPE_AGENT); }
__device__ __forceinline__ unsigned xb_add(unsigned* p, unsigned v) { return __hip_atomic_fetch_add(p, v, __ATOMIC_RELAXED, __HIP_MEMORY_SCOPE_AGENT); }
__device__ __forceinline__ unsigned xb_xcc_id() { return (unsigned)__builtin_amdgcn_s_getreg((3 << 11) | 20) & 0xFu; }
#define XB_SPIN(cond, bar) do { unsigned _sp = 0; while (cond) { __builtin_amdgcn_s_sleep(1); \
    if ((++_sp & 255u) == 0u) { if (xb_ld(&(bar)[XB_TMO])) break; if (_sp > XB_SPIN_CAP) { atomicAdd(&(bar)[XB_TMO], 1u); break; } } } } while (0)

struct XcdBarrier {
    unsigned* bar; unsigned x;
    volatile LAS unsigned* st;
};
__device__ __forceinline__ XcdBarrier xcd_barrier_post(unsigned* bar, volatile LAS unsigned* st) {
    XcdBarrier b; b.bar = bar; b.x = xb_xcc_id(); b.st = st;
    if (threadIdx.x == 0) (void)xb_add(&bar[XB_XCNT(b.x)], 1u);
    return b;
}
__device__ __forceinline__ void xcd_barrier_complete(unsigned* bar, unsigned x, unsigned& nloc, unsigned& nx) {
    const unsigned G = gridDim.x * gridDim.y * gridDim.z;
    unsigned sum, cnt, mine, sp = 0u;
    for (;;) {
        sum = 0u; cnt = 0u; mine = 0u;
#pragma unroll
        for (unsigned j = 0; j < 16; ++j) { const unsigned c = xb_ld(&bar[XB_XCNT(j)]); sum += c; cnt += (c > 0u) ? 1u : 0u; mine = (j == x) ? c : mine; }
        if (sum == G) break;
        __builtin_amdgcn_s_sleep(1);
        if ((++sp & 255u) == 0u) { if (xb_ld(&bar[XB_TMO])) break; if (sp > XB_SPIN_CAP) { atomicAdd(&bar[XB_TMO], 1u); break; } }
    }
    nloc = mine > 0u ? mine : 1u; nx = cnt > 0u ? cnt : 1u;
}
__device__ __forceinline__ void xcd_barrier(const XcdBarrier& b) {
    asm volatile("s_waitcnt vmcnt(0)" ::: "memory");
    __syncthreads();
    if (threadIdx.x == 0) {
        unsigned* bar = b.bar;
        __builtin_amdgcn_s_waitcnt(0);
        unsigned nloc = b.st[0], nx = b.st[1];
        if (nloc == 0u) { xcd_barrier_complete(bar, b.x, nloc, nx); b.st[0] = nloc; b.st[1] = nx; }
        const unsigned old = xb_add(&bar[XB_XSUB(b.x)], 1u);
        const unsigned gen = old / nloc;
        if (old + 1u == (gen + 1u) * nloc) {
            __builtin_amdgcn_fence(__ATOMIC_RELEASE, "agent");
            asm volatile("s_waitcnt vmcnt(0)" ::: "memory");
            const unsigned og = xb_add(&bar[XB_TOP], 1u);
            const unsigned tg = og / nx;
            if (og + 1u == (tg + 1u) * nx) xb_add(&bar[XB_TOPGEN], 1u);
            else XB_SPIN(xb_ld(&bar[XB_TOPGEN]) == tg, bar);
            __builtin_amdgcn_fence(__ATOMIC_ACQUIRE, "agent");
            xb_add(&bar[XB_XGEN(b.x)], 1u);
            asm volatile("s_waitcnt vmcnt(0)" ::: "memory");
        } else {
            XB_SPIN(xb_ld(&bar[XB_XGEN(b.x)]) == gen, bar);
            __builtin_amdgcn_fence(__ATOMIC_ACQUIRE, "agent");
            asm volatile("s_waitcnt vmcnt(0)" ::: "memory");
        }
    }
    __syncthreads();
}

__device__ __forceinline__ void xcd_stagger(unsigned ticks) {
    const unsigned long long dt = (unsigned long long)(xb_xcc_id() & 7u) * ticks, t0 = __builtin_amdgcn_s_memrealtime();
    while (__builtin_amdgcn_s_memrealtime() - t0 < dt) __builtin_amdgcn_s_sleep(8);
}

struct Frame {
    LAS unsigned char* lds;
    volatile LAS unsigned* MISC;
    gu32* ctl;
    int tid, lane, wave;
    int vcu, G;
};

__device__ __forceinline__ float wave_sum(float v) {
#pragma unroll
    for (int o = 1; o < 64; o <<= 1) v += __shfl_xor(v, o);
    return v;
}

struct CvtJob { const float* W; const float* gain; bf16* WT; int N, ldT, drow, kcol0, k0, n0; float cs; };
__device__ __forceinline__ void cvt_job(CvtJob& J, const float* W, int N, const float* gain, bf16* WT, int ldT, int koff, int mode, int item) {
    const int nblk = N / 64, kb = item / nblk, nb = item % nblk, k0 = 64 * kb, n0 = 64 * nb;
    J.W = W; J.gain = gain; J.WT = WT; J.N = N; J.ldT = ldT; J.k0 = k0; J.n0 = n0; J.kcol0 = koff + k0;
    J.cs = (mode == 3 && (n0 < 3072 || (n0 >= 9216 && n0 < 11264))) ? QSCALE : 1.0f;
    J.drow = (mode == 1 || mode == 2) ? 256 * (n0 >> 7) + (n0 & 127) + (mode == 2 ? 128 : 0) : n0;
    if (mode == 3 && n0 >= 12288) { const int c = n0 - 12288, c2 = c & 4095;
        J.drow = 12288 + 256 * (c2 >> 7) + (c2 & 127) + (c >= 4096 ? 128 : 0); }
}
__device__ __forceinline__ void cvt_load(const CvtJob& J, int lane, f32x4 (&v)[16]) {
    const float* p = J.W + (size_t)(J.k0 + 16 * (lane >> 4)) * J.N + J.n0 + 4 * (lane & 15);
#pragma unroll
    for (int i = 0; i < 16; ++i) v[i] = __builtin_nontemporal_load((const f32x4*)(p + (size_t)i * J.N));
}
__device__ __forceinline__ void cvt_store(const CvtJob& J, const f32x4 (&v)[16], LAS unsigned char* img, int lane) {
    const int g = lane >> 4, i15 = lane & 15;
    f32x4 gq[4];
#pragma unroll
    for (int j = 0; j < 4; ++j) gq[j] = J.gain ? *(const f32x4*)(J.gain + J.k0 + 16 * g + 4 * j) * J.cs : (f32x4){J.cs, J.cs, J.cs, J.cs};
#pragma unroll
    for (int e = 0; e < 4; ++e) { v4u lo, hi;
        lo.x = pk2(v[0][e] * gq[0][0], v[1][e] * gq[0][1]);   lo.y = pk2(v[2][e] * gq[0][2], v[3][e] * gq[0][3]);   lo.z = pk2(v[4][e] * gq[1][0], v[5][e] * gq[1][1]);   lo.w = pk2(v[6][e] * gq[1][2], v[7][e] * gq[1][3]);
        hi.x = pk2(v[8][e] * gq[2][0], v[9][e] * gq[2][1]);   hi.y = pk2(v[10][e] * gq[2][2], v[11][e] * gq[2][3]); hi.z = pk2(v[12][e] * gq[3][0], v[13][e] * gq[3][1]); hi.w = pk2(v[14][e] * gq[3][2], v[15][e] * gq[3][3]);
        LAS unsigned char* wp = img + (4 * i15 + e) * 144 + 32 * g;
        *(LAS v4u*)wp = lo; *(LAS v4u*)(wp + 16) = hi; }
    const int r = lane >> 3, c = lane & 7;
    bf16* op = J.WT + (size_t)(J.drow + r) * J.ldT + J.kcol0 + 8 * c;
#pragma unroll
    for (int j = 0; j < 8; ++j) {
        const v4u o = *(const LAS v4u*)(img + (8 * j + r) * 144 + 16 * c);
        *(v4u*)(op + (size_t)(8 * j) * J.ldT) = o;
    }
}
struct Ptrs;
template <int SET> __device__ __forceinline__ void cvt_decode(const Ptrs& P, int it, CvtJob& J);

__device__ __forceinline__ void sincos_acc(float a, float& s, float& c) {
    const double x = (double)a;
    const double kq = __builtin_rint(x * 0.63661977236758134308);
    double r = __builtin_fma(-kq, 1.57079632679489655800e+00, x);
    r = __builtin_fma(-kq, 6.12323399573676603587e-17, r);
    const int q = (int)((long long)kq) & 3;
    const double r2 = r * r;
    const double sp = r * (1.0 + r2 * (-1.0 / 6.0 + r2 * (1.0 / 120.0 + r2 * (-1.0 / 5040.0 + r2 * (1.0 / 362880.0 + r2 * (-1.0 / 39916800.0 + r2 * (1.0 / 6227020800.0)))))));
    const double cp = 1.0 + r2 * (-0.5 + r2 * (1.0 / 24.0 + r2 * (-1.0 / 720.0 + r2 * (1.0 / 40320.0 + r2 * (-1.0 / 3628800.0 + r2 * (1.0 / 479001600.0))))));
    const double ss = (q & 1) ? cp : sp, cc = (q & 1) ? sp : cp;
    s = (float)((q & 2) ? -ss : ss);
    c = (float)(((q + 1) & 2) ? -cc : cc);
}

struct Ptrs {
    const float* xp; const float* xs; const float* g1; const float* w1g; const float* w1u; const float* w1d; const float* gmix; const float* win; const float* sink;
    const float* wa; const float* wb; const float* wout; const float* g2; const float* w2g; const float* w2u; const float* w2d; const float* gfin;
    float* out; unsigned char* ws;
};

constexpr int CI_GU = (D / 64) * (FF / 64), CI_D = (FF / 64) * (D / 64), CI_IN = (D / 64) * (NIN / 64), CI_A = (1024 / 64) * (D / 64), CI_B = (2048 / 64) * (D / 64), CI_O = (D / 64) * (D / 64);
constexpr int CI_IN0 = CI_IN / 2;
template <> __device__ __forceinline__ void cvt_decode<0>(const Ptrs& P, int it, CvtJob& J) {
    bf16* WGU = (bf16*)(P.ws + WS_WGU); bf16* WD = (bf16*)(P.ws + WS_WD); bf16* WIN = (bf16*)(P.ws + WS_WIN);
    int r = it;
    if (r < CI_GU) { cvt_job(J, P.w1g, FF, P.g1, WGU, D, 0, 1, r); return; } r -= CI_GU;
    if (r < CI_GU) { cvt_job(J, P.w1u, FF, P.g1, WGU, D, 0, 2, r); return; } r -= CI_GU;
    if (r < CI_D)  { cvt_job(J, P.w1d, D, nullptr, WD, FF, 0, 0, r); return; } r -= CI_D;
    cvt_job(J, P.win, NIN, P.gmix, WIN, D, 0, 3, r);
}
template <> __device__ __forceinline__ void cvt_decode<2>(const Ptrs& P, int it, CvtJob& J) {
    bf16* WIN = (bf16*)(P.ws + WS_WIN); bf16* WAB = (bf16*)(P.ws + WS_WAB); bf16* WOUT = (bf16*)(P.ws + WS_WOUT);
    int r = it;
    if (r < CI_IN - CI_IN0) { cvt_job(J, P.win, NIN, P.gmix, WIN, D, 0, 3, r + CI_IN0); return; } r -= CI_IN - CI_IN0;
    if (r < CI_A)  { cvt_job(J, P.wa, D, nullptr, WAB, YABW, 0, 0, r); return; } r -= CI_A;
    if (r < CI_B)  { cvt_job(J, P.wb, D, nullptr, WAB, YABW, 1024, 0, r); return; } r -= CI_B;
    cvt_job(J, P.wout, D, nullptr, WOUT, D, 0, 0, r);
}
template <> __device__ __forceinline__ void cvt_decode<1>(const Ptrs& P, int it, CvtJob& J) {
    bf16* WGU = (bf16*)(P.ws + WS_WGU); bf16* WD = (bf16*)(P.ws + WS_WD);
    int r = it;
    if (r < CI_GU) { cvt_job(J, P.w2g, FF, P.g2, WGU, D, 0, 1, r); return; } r -= CI_GU;
    cvt_job(J, P.w2u, FF, P.g2, WGU, D, 0, 2, r);
}
template <> __device__ __forceinline__ void cvt_decode<3>(const Ptrs& P, int it, CvtJob& J) { cvt_job(J, P.w2d, D, nullptr, (bf16*)(P.ws + WS_WD), FF, 0, 0, it); }
template <int SET> __device__ __forceinline__ void cvt_run(Frame& F, const Ptrs& P, int gw, int NGW) {
    constexpr int NITEMS = SET == 0 ? 2 * CI_GU + CI_D + CI_IN0 : (SET == 1 ? 2 * CI_GU : (SET == 3 ? CI_D : (CI_IN - CI_IN0) + CI_A + CI_B + CI_O));
    LAS unsigned char* img = F.lds + RING_OFF + F.wave * 16384;
    const int lane = F.lane;
    f32x4 va[16], vb[16]; CvtJob Ja, Jb;
    int it = gw;
    if (it >= NITEMS) return;
    cvt_decode<SET>(P, it, Ja); cvt_load(Ja, lane, va);
    for (;;) {
        int nx = it + NGW;
        cvt_decode<SET>(P, nx < NITEMS ? nx : NITEMS - 1, Jb); cvt_load(Jb, lane, vb);
        cvt_store(Ja, va, img, lane);
        it = nx; if (it >= NITEMS) break;
        nx = it + NGW;
        cvt_decode<SET>(P, nx < NITEMS ? nx : NITEMS - 1, Ja); cvt_load(Ja, lane, va);
        cvt_store(Jb, vb, img, lane);
        it = nx; if (it >= NITEMS) break;
    }
}
__device__ __forceinline__ void p0_prologue(Frame& F, const Ptrs& P) {
    const int gw = F.vcu * NWAVES + F.wave, NGW = F.G * NWAVES;
    { float* tab = (float*)(P.ws + WS_ROPE);
      const float inv[16] = {1.000000000e+00f, 4.403665960e-01f, 1.939227432e-01f, 8.539710194e-02f, 3.760603070e-02f, 1.656044088e-02f, 7.292664610e-03f, 3.211446106e-03f,
                             1.414213562e-03f, 6.227724371e-04f, 2.742481884e-04f, 1.207697351e-04f, 5.318295734e-05f, 2.341999971e-05f, 1.031338525e-05f, 4.541670478e-06f};
      for (int pos = gw * 64 + F.lane; pos < 16384; pos += NGW * 64) {
#pragma unroll
          for (int i = 0; i < 16; ++i) { const float ang = (float)pos * inv[i]; float s, c; sincos_acc(ang, s, c); tab[(size_t)pos * 32 + i] = c; tab[(size_t)pos * 32 + 16 + i] = s; } } }
    { bf16* XB = (bf16*)(P.ws + WS_AB1); float* ss0 = (float*)(P.ws + WS_SS0);
      for (int m = gw; m < M; m += NGW) { const float* xrow = (m < M_P) ? P.xp + (size_t)m * D : P.xs + (size_t)(m - M_P) * D;
          const GAS f32x4* xr = (const GAS f32x4*)xrow + F.lane; GAS v2u* o8 = (GAS v2u*)(XB + (size_t)m * D) + F.lane; float s = 0.f;
#pragma unroll
          for (int j = 0; j < 16; ++j) { const f32x4 v = __builtin_nontemporal_load(xr + 64 * j); s += (v.x * v.x + v.y * v.y) + (v.z * v.z + v.w * v.w); v2u w; w.x = pk2(v.x, v.y); w.y = pk2(v.z, v.w); o8[64 * j] = w; }
          s = wave_sum(s); if (F.lane == 0) ss0[m] = s; } }
    cvt_run<0>(F, P, gw, NGW);
}
__device__ __forceinline__ void p4_convert_w2(Frame& F, const Ptrs& P) { cvt_run<1>(F, P, F.vcu * NWAVES + F.wave, F.G * NWAVES); }

__device__ __forceinline__ unsigned off_b(unsigned row, unsigned ch) { return 256u * row + 16u * (ch ^ (((row & 3) << 2) | ((row >> 2) & 3))); }
struct AttState2 { float m[2], l[2]; f32x4 O[2][8]; };

struct AttLane { unsigned choff[4]; };
__device__ __forceinline__ void att_lane_init(AttLane& L, int lane) {
    const unsigned i = lane & 15, g = lane >> 4;
#pragma unroll
    for (int j = 0; j < 4; ++j) L.choff[j] = 16u * (i ^ ((g << 2) | (unsigned)j));
}
__device__ __forceinline__ void k_load(bf16x8 (&kf)[2][4], const bf16* Kb, int S, int tb, int dil, int lane) {
    const int i = lane & 15, g = lane >> 4;
    const int kk_a = 8 * (i >> 2) + (i & 3);
#pragma unroll
    for (int t = 0; t < 2; ++t) { int tk = tb + dil * (kk_a + 4 * t); tk = max(0, min(tk, S - 1)); const bf16* kp = Kb + (size_t)tk * QKVW + 8 * g;
#pragma unroll
        for (int s = 0; s < 4; ++s) kf[t][s] = *(const bf16x8*)(kp + 32 * s); }
}
__device__ __forceinline__ void v_dma(LAS unsigned char* vbuf, const bf16* Vb, int S, int tb, int dil, int lane, const AttLane& L) {
    const int g = lane >> 4;
    if (tb >= 0 && tb + 31 * dil < S) {
        const char* p0 = (const char*)(Vb + (size_t)(tb + dil * g) * QKVW); const size_t rstep = (size_t)(4 * dil) * QKVW * 2;
#pragma unroll
        for (int c = 0; c < 8; ++c) __builtin_amdgcn_global_load_lds((const unsigned*)(p0 + c * rstep + L.choff[c & 3]), (LAS unsigned*)(vbuf + 1024 * c), 16, 0, 0);
    } else {
#pragma unroll
        for (int c = 0; c < 8; ++c) { int tk = tb + dil * (4 * c + g); tk = max(0, min(tk, S - 1));
            __builtin_amdgcn_global_load_lds((const unsigned*)((const char*)(Vb + (size_t)tk * QKVW) + L.choff[c & 3]), (LAS unsigned*)(vbuf + 1024 * c), 16, 0, 0); }
    }
    asm volatile("" ::: "memory");
}
template <int BUF>
__device__ __forceinline__ void kv_compute2(AttState2& st, bf16x8 (&kf)[2][4], const bf16x8 (&qf)[2][4], int S, int tb, int dil, const int (&mlo)[2], const unsigned (&mspan)[2],
                                            LAS unsigned char* vl, int lane, const AttLane& L, bool pf, const bf16* Kb, const bf16* Vb, int tbn) {
    const int g = lane >> 4;
    f32x4 sc[2][2];
#pragma unroll
    for (int q = 0; q < 2; ++q)
#pragma unroll
        for (int t = 0; t < 2; ++t) { sc[q][t] = (f32x4){0.f, 0.f, 0.f, 0.f};
#pragma unroll
            for (int s = 0; s < 4; ++s) sc[q][t] = __builtin_amdgcn_mfma_f32_16x16x32_bf16(kf[t][s], qf[q][s], sc[q][t], 0, 0, 0); }
    if (pf) v_dma(vl + (BUF ? 0 : 8192), Vb, S, tbn, dil, lane, L);
    bf16x8 pf16[2];
#pragma unroll
    for (int q = 0; q < 2; ++q) {
        const int x0 = tb + dil * 8 * g - mlo[q];
        float mx = -__builtin_inff();
#pragma unroll
        for (int t = 0; t < 2; ++t)
#pragma unroll
            for (int r = 0; r < 4; ++r) { const bool ok = (unsigned)(x0 + dil * (4 * t + r)) <= mspan[q]; sc[q][t][r] = ok ? sc[q][t][r] : -__builtin_inff(); mx = fmaxf(mx, sc[q][t][r]); }
        mx = fmaxf(mx, __shfl_xor(mx, 16)); mx = fmaxf(mx, __shfl_xor(mx, 32));
        if (__builtin_amdgcn_ballot_w64(mx > st.m[q] + 8.0f) != 0ull) {
            const float mn = fmaxf(st.m[q], mx), alpha = __builtin_amdgcn_exp2f(st.m[q] - mn);
            st.l[q] *= alpha; st.m[q] = mn;
#pragma unroll
            for (int dt = 0; dt < 8; ++dt) st.O[q][dt] *= alpha;
        }
        float ps = 0.f; float p[8];
#pragma unroll
        for (int t = 0; t < 2; ++t)
#pragma unroll
            for (int r = 0; r < 4; ++r) { p[4 * t + r] = __builtin_amdgcn_exp2f(sc[q][t][r] - st.m[q]); ps += p[4 * t + r]; }
        st.l[q] += ps;
        v4u pw; pw.x = pk2(p[0], p[1]); pw.y = pk2(p[2], p[3]); pw.z = pk2(p[4], p[5]); pw.w = pk2(p[6], p[7]);
        pf16[q] = __builtin_bit_cast(bf16x8, pw);
    }
    if (pf) asm volatile("s_waitcnt vmcnt(8)" ::: "memory"); else asm volatile("s_waitcnt vmcnt(0)" ::: "memory");
    const unsigned vb = (unsigned)(uintptr_t)vl;
#define TR4(k) asm volatile("ds_read_b64_tr_b16 %0, %4 offset:%8\n\tds_read_b64_tr_b16 %1, %5 offset:%8\n\tds_read_b64_tr_b16 %2, %6 offset:%8\n\tds_read_b64_tr_b16 %3, %7 offset:%8" \
        : "=&v"(f[k]), "=&v"(f[k + 1]), "=&v"(f[k + 2]), "=&v"(f[k + 3]) : "v"(a[k]), "v"(a[k + 1]), "v"(a[k + 2]), "v"(a[k + 3]), "i"(BUF ? 8192 : 0) : "memory")
#pragma unroll
    for (int hf = 0; hf < 2; ++hf) {
        unsigned a[8]; s16x4 f[8];
        int ln = lane; asm volatile("" : "+v"(ln));
        const unsigned g2 = ln >> 4, q2 = (ln & 15) >> 2, pp = ln & 3;
#pragma unroll
        for (int k = 0; k < 4; ++k) { const int dt = 4 * hf + k; a[2 * k] = vb + off_b(8 * g2 + q2, 2 * dt + (pp >> 1)) + 8 * (pp & 1); a[2 * k + 1] = vb + off_b(8 * g2 + 4 + q2, 2 * dt + (pp >> 1)) + 8 * (pp & 1); }
        TR4(0); TR4(4);
        asm volatile("s_waitcnt lgkmcnt(0)" : "+v"(f[0]), "+v"(f[1]), "+v"(f[2]), "+v"(f[3]), "+v"(f[4]), "+v"(f[5]), "+v"(f[6]), "+v"(f[7]) :: "memory");
#pragma unroll
        for (int k = 0; k < 4; ++k) { const int dt = 4 * hf + k;
            const bf16x8 vf = __builtin_shufflevector(f[2 * k], f[2 * k + 1], 0, 1, 2, 3, 4, 5, 6, 7);
            st.O[0][dt] = __builtin_amdgcn_mfma_f32_16x16x32_bf16(vf, pf16[0], st.O[0][dt], 0, 0, 0);
            st.O[1][dt] = __builtin_amdgcn_mfma_f32_16x16x32_bf16(vf, pf16[1], st.O[1][dt], 0, 0, 0); }
    }
#undef TR4
    if (pf) { asm volatile("" ::: "memory"); k_load(kf, Kb, S, tbn, dil, lane); }
}
__device__ __forceinline__ void attn_keys2(AttState2& st, const bf16x8 (&qf)[2][4], const bf16* Kb, const bf16* Vb, int S, const int (&tq)[2], int kstart, int dil, int ntiles, int W,
                                           LAS unsigned char* vl, int lane, const AttLane& L) {
    bf16x8 kf[2][4]; const int tstep = 32 * dil;
    int mlo[2]; unsigned mspan[2];
#pragma unroll
    for (int q = 0; q < 2; ++q) { mlo[q] = max(tq[q] - W, 0); mspan[q] = (unsigned)(min(tq[q] + W, S - 1) - mlo[q]); }
    v_dma(vl, Vb, S, kstart, dil, lane, L); k_load(kf, Kb, S, kstart, dil, lane);
    for (int tile = 0; tile < ntiles; tile += 2) {
        const int tb = kstart + tile * tstep;
        const bool m1 = tile + 1 < ntiles;
        kv_compute2<0>(st, kf, qf, S, tb, dil, mlo, mspan, vl, lane, L, m1, Kb, Vb, tb + tstep);
        if (!m1) break;
        const bool m2 = tile + 2 < ntiles;
        kv_compute2<1>(st, kf, qf, S, tb + tstep, dil, mlo, mspan, vl, lane, L, m2, Kb, Vb, tb + 2 * tstep);
    }
}

template <int HALFW> __device__ __forceinline__ void attn_phase(Frame& F, const Ptrs& P) {
    if (HALFW && F.wave >= 4) return;
    const bf16* QKV = (const bf16*)(P.ws + WS_QKV); bf16* YAB = (bf16*)P.out;
    LAS unsigned char* vl = F.lds + RING_OFF + F.wave * 16384;
    const int gw = HALFW ? F.vcu * 4 + F.wave : F.vcu * NWAVES + F.wave, NGW = HALFW ? F.G * 4 : F.G * NWAVES, lane = F.lane, i = lane & 15, g = lane >> 4;
    AttLane AL; att_lane_init(AL, lane);
    { constexpr int NT = (M / 512) * 8 * 16;
      for (int id = gw; id < NT; id += NGW) {
          const int r16 = id & 15, h = (id >> 4) & 7, rb = id >> 7;
          const int row_blk = rb * 512; const int seq0 = row_blk < 4096 ? 0 : (row_blk < 8192 ? 4096 : 8192); const int S = row_blk < 8192 ? 4096 : 16384;
          const int t0 = row_blk - seq0 + r16; const int tq[2] = {t0 + 16 * i, t0 + 256 + 16 * i};
          AttState2 st;
#pragma unroll
          for (int q = 0; q < 2; ++q) { st.m[q] = -1e30f; st.l[q] = 0.f;
#pragma unroll
              for (int dt = 0; dt < 8; ++dt) st.O[q][dt] = (f32x4){0.f, 0.f, 0.f, 0.f}; }
          const bf16* seqbase = QKV + (size_t)seq0 * QKVW;
#pragma unroll 1
          for (int grp = 0; grp < 3; ++grp) {
              const int dil = grp == 0 ? 1 : (grp == 1 ? 4 : 16); const int ntiles = grp == 0 ? 20 : (grp == 1 ? 8 : 5);
              const int hc = grp * 1024 + h * 128;
              bf16x8 qf[2][4];
#pragma unroll
              for (int q = 0; q < 2; ++q) { const bf16* qp = seqbase + (size_t)tq[q] * QKVW + hc + 8 * g;
#pragma unroll
                  for (int s = 0; s < 4; ++s) qf[q][s] = *(const bf16x8*)(qp + 32 * s); }
              attn_keys2(st, qf, seqbase + 3072 + hc, seqbase + 6144 + hc, S, tq, t0 - 64 * dil, dil, ntiles, 64 * dil, vl, lane, AL);
          }
#pragma unroll
          for (int q = 0; q < 2; ++q) { float l = st.l[q]; l += __shfl_xor(l, 16); l += __shfl_xor(l, 32); const float rl = 1.0f / l;
              bf16* op = YAB + (size_t)(seq0 + tq[q]) * YABW + h * 128 + 4 * g;
#pragma unroll
              for (int dt = 0; dt < 8; ++dt) { const f32x4 o = st.O[q][dt] * rl; v2u w; w.x = pk2(o[0], o[1]); w.y = pk2(o[2], o[3]); *(v2u*)(op + 16 * dt) = w; } }
      } }
    { constexpr int NT = (M / 16) * 8;
      for (int id = gw; id < NT; id += NGW) {
          const int pair = id & 7, blk = id >> 3; const int row0 = blk * 16;
          const int seq0 = row0 < 4096 ? 0 : (row0 < 8192 ? 4096 : 8192); const int S = row0 < 8192 ? 4096 : 16384;
          const int t0 = row0 - seq0; const int tq[2] = {t0 + i, t0 + i};
          AttState2 st;
#pragma unroll
          for (int q = 0; q < 2; ++q) { st.m[q] = -1e30f; st.l[q] = 0.f;
#pragma unroll
              for (int dt = 0; dt < 8; ++dt) st.O[q][dt] = (f32x4){0.f, 0.f, 0.f, 0.f}; }
          const bf16* seqbase = QKV + (size_t)seq0 * QKVW; const int kvh = pair >> 1;
          bf16x8 qf[2][4];
#pragma unroll
          for (int q = 0; q < 2; ++q) { const bf16* qp = seqbase + (size_t)tq[q] * QKVW + 9216 + (2 * pair + q) * 128 + 8 * g;
#pragma unroll
              for (int s = 0; s < 4; ++s) qf[q][s] = *(const bf16x8*)(qp + 32 * s); }
          attn_keys2(st, qf, seqbase + 11264 + kvh * 128, seqbase + 11776 + kvh * 128, S, tq, t0 - 128, 1, 9, 128, vl, lane, AL);
#pragma unroll
          for (int q = 0; q < 2; ++q) { const int qh = 2 * pair + q; float l = st.l[q]; l += __shfl_xor(l, 16); l += __shfl_xor(l, 32);
              const float sk = P.sink[qh] * 1.4426950408889634f; const float m2 = fmaxf(st.m[q], sk); const float e1 = __builtin_amdgcn_exp2f(st.m[q] - m2);
              const float den = l * e1 + __builtin_amdgcn_exp2f(sk - m2); const float rl = e1 / den;
              bf16* op = YAB + (size_t)(seq0 + tq[q]) * YABW + 1024 + qh * 128 + 4 * g;
#pragma unroll
              for (int dt = 0; dt < 8; ++dt) { const f32x4 o = st.O[q][dt] * rl; v2u w; w.x = pk2(o[0], o[1]); w.y = pk2(o[2], o[3]); *(v2u*)(op + 16 * dt) = w; } }
      } }
}

__device__ __forceinline__ void final_norm(Frame& F, const Ptrs& P) {
    const int gw = F.vcu * NWAVES + F.wave, NGW = F.G * NWAVES; const float* ss3 = (const float*)(F.ctl + CW_SS3); const bf16* H3 = (const bf16*)(P.ws + WS_AB1);
    f32x4 gv[8][2];
#pragma unroll
    for (int j = 0; j < 8; ++j) { gv[j][0] = ((const f32x4*)P.gfin)[2 * (F.lane + 64 * j)]; gv[j][1] = ((const f32x4*)P.gfin)[2 * (F.lane + 64 * j) + 1]; }
    for (int m = gw; m < M; m += NGW) { const float rs = __builtin_amdgcn_rsqf(ss3[m] * (1.0f / 4096.0f) + 1e-6f);
        const GAS v4u* hi = (const GAS v4u*)(H3 + (size_t)m * D) + F.lane; GAS f32x4* o = (GAS f32x4*)(P.out + (size_t)m * D) + 2 * F.lane;
#pragma unroll
        for (int j = 0; j < 8; ++j) { const v4u w = hi[64 * j];
            const f32x4 v0 = {pg8::bf_lo(w.x), pg8::bf_hi(w.x), pg8::bf_lo(w.y), pg8::bf_hi(w.y)}, v1 = {pg8::bf_lo(w.z), pg8::bf_hi(w.z), pg8::bf_lo(w.w), pg8::bf_hi(w.w)};
            o[128 * j] = v0 * rs * gv[j][0]; o[128 * j + 1] = v1 * rs * gv[j][1]; } }
}

struct Args { const float* in[17]; float* out; unsigned char* ws; int ph_lo, ph_hi, li, pad; };
__global__ void __launch_bounds__(NWAVES * 64, 2) mk_fwd(Args args) {
    extern __shared__ __attribute__((aligned(16))) unsigned char lds[];
    Frame F;
    F.lds = (LAS unsigned char*)lds;
    F.MISC = (volatile LAS unsigned*)(F.lds + MISC_OFF);
    F.tid = threadIdx.x; F.lane = F.tid & 63; F.wave = __builtin_amdgcn_readfirstlane(F.tid >> 6);
    F.G = gridDim.x; { const int bx = blockIdx.x; F.vcu = (F.G % 8 == 0) ? (bx % 8) * (F.G / 8) + bx / 8 : bx; }
    unsigned char* ws = args.ws;
    F.ctl = (gu32*)(ws + WS_CTL);
    Ptrs P;
    P.xp = args.in[0]; P.xs = args.in[1]; P.g1 = args.in[2]; P.w1g = args.in[3]; P.w1u = args.in[4]; P.w1d = args.in[5]; P.gmix = args.in[6]; P.win = args.in[7]; P.sink = args.in[8];
    P.wa = args.in[9]; P.wb = args.in[10]; P.wout = args.in[11]; P.g2 = args.in[12]; P.w2g = args.in[13]; P.w2u = args.in[14]; P.w2d = args.in[15]; P.gfin = args.in[16];
    P.out = args.out; P.ws = ws;
    for (int u = F.tid; u < (LDS_BYTES - LDSCTL_OFF) / 4; u += NWAVES * 64) ((LAS unsigned*)(F.lds + LDSCTL_OFF))[u] = 0u;
    __syncthreads();
    XcdBarrier bar; bar.bar = (unsigned*)(F.ctl + CW_BAR); bar.x = 0; bar.st = nullptr;
    if (N_LAUNCHES != PER_PHASE) bar = xcd_barrier_post((unsigned*)(F.ctl + CW_BAR), F.MISC + 8);
#define GRID_BAR(seam) do { if (N_LAUNCHES != PER_PHASE) xcd_barrier(bar); } while (0)
    const int lo = args.ph_lo, hi = args.ph_hi;
#define IN(k) (lo <= (k) && (k) < hi)
#define BOTH(k) (IN(k) && IN((k) + 1))
    bf16* AB1 = (bf16*)(ws + WS_AB1); bf16* ACT = (bf16*)(ws + WS_ACT); bf16* QKVB = (bf16*)(ws + WS_QKV);
    bf16* WGU = (bf16*)(ws + WS_WGU); bf16* WDN = (bf16*)(ws + WS_WD); bf16* WIN = (bf16*)(ws + WS_WIN); bf16* WAB = (bf16*)(ws + WS_WAB); bf16* WOUT = (bf16*)(ws + WS_WOUT);
    float* ss0 = (float*)(ws + WS_SS0); float* ss1 = (float*)(F.ctl + CW_SS1); float* ss2 = (float*)(F.ctl + CW_SS2); float* ss3 = (float*)(F.ctl + CW_SS3);
    const float* rope = (const float*)(ws + WS_ROPE);

    if (IN(0)) { for (int rep = 0; rep < NREP(0); ++rep) p0_prologue(F, P); if (BOTH(0)) GRID_BAR(0); }
    if (IN(1)) { pg8::Gemm g{AB1, WGU, M, 2 * FF, D}; pg8::StaticOrder S; S.init(M, 2 * FF, F.G, (int)blockIdx.x, WGM_UP);
        pg8::EpiSwiglu E{ACT, FF, ss0, F.lds + SSL_OFF};
        for (int rep = 0; rep < NREP(1); ++rep)
        pg8::gemm_phase<pg8::EpiSwiglu, pg8::StaticOrder, PG8_ALIGN, PG8_SP2>(F.lds + RING_OFF, g, S, E);
        {
          const int nwg = (M / 256) * (2 * FF / 256), rem = nwg % F.G, c = (int)blockIdx.x;
          if (rem == 0) cvt_run<2>(F, P, c * NWAVES + F.wave, F.G * NWAVES);
          else if (c >= rem) cvt_run<2>(F, P, (c - rem) * NWAVES + F.wave, (F.G - rem) * NWAVES); }
        if (PROBE_REPEAT == 21) { pg8::FixedOrder S2; S2.init(M, 2 * FF, F.G, (int)blockIdx.x); pg8::EpiSwiglu E2{QKVB, FF, ss0, F.lds + SSL_OFF};
            pg8::gemm_phase<pg8::EpiSwiglu, pg8::FixedOrder, PG8_ALIGN, PG8_SP2>(F.lds + RING_OFF, g, S2, E2); }
        if (BOTH(1)) GRID_BAR(1); }
    if (IN(2) && PROBE_REPEAT >= 100 && PROBE_REPEAT < 104) {
        pg8::Gemm g{AB1, WGU, M, 2 * FF, D}; pg8::StaticOrder S; S.init(M, 2 * FF, F.G, (int)blockIdx.x, WGM_UP);
        pg8::EpiSwigluT<(PROBE_REPEAT >= 100 ? PROBE_REPEAT - 100 : 0)> E{QKVB, FF, ss0, F.lds + SSL_OFF};
        pg8::gemm_phase<pg8::EpiSwigluT<(PROBE_REPEAT >= 100 ? PROBE_REPEAT - 100 : 0)>, pg8::StaticOrder, PG8_ALIGN, PG8_SP2>(F.lds + RING_OFF, g, S, E);
        GRID_BAR(1); }
    if (IN(2)) { if (STAGGER_TICKS) xcd_stagger(STAGGER_TICKS); pg8::Gemm g{ACT, WDN, M, D, FF}; pg8::StaticOrder S; S.init(M, D, F.G, (int)blockIdx.x, WGM_DOWN);
        pg8::EpiResid<true, false, true> E{AB1, AB1, M, nullptr, AB1, ss1, 0.5f};
        pg8::gemm_phase<pg8::EpiResid<true, false, true>, pg8::StaticOrder, PG8_ALIGN, PG8_SP2>(F.lds + RING_OFF, g, S, E);
        if (BOTH(2)) GRID_BAR(2); }
    if (IN(3)) { pg8::Gemm g{AB1, WIN, M, NIN, D}; pg8::StaticOrder S; S.init(M, NIN, F.G, (int)blockIdx.x, WGM_IN);
        pg8::EpiProj E{QKVB, ACT, ss1, rope, F.lds + SSL_OFF};
        pg8::gemm_phase<pg8::EpiProj, pg8::StaticOrder, PG8_ALIGN, PG8_SP2>(F.lds + RING_OFF, g, S, E);
        if (NREP(3) == 2) pg8::gemm_phase<pg8::EpiProj, pg8::StaticOrder, PG8_ALIGN, PG8_SP2>(F.lds + RING_OFF, g, S, E);
        if (BOTH(3)) GRID_BAR(3); }
    if (IN(4)) { for (int rep = 0; rep < NREP(4); ++rep) attn_phase<(PROBE_REPEAT == 42) ? 1 : 0>(F, P); for (int rep = 0; rep < NREP(14); ++rep) p4_convert_w2(F, P); if (BOTH(4)) GRID_BAR(4); }
    if (IN(5)) { pg8::Gemm g{(const bf16*)P.out, WAB, M, D, YABW}; pg8::StaticOrder S; S.init(M, D, F.G, (int)blockIdx.x, WGM_DOWN);
        pg8::EpiMerge E{ACT, QKVB};
        for (int rep = 0; rep < NREP(5); ++rep)
        pg8::gemm_phase<pg8::EpiMerge, pg8::StaticOrder, PG8_ALIGN, PG8_SP2>(F.lds + RING_OFF, g, S, E);
        if (BOTH(5)) GRID_BAR(5); }
    if (IN(6)) { if (STAGGER_TICKS) xcd_stagger(STAGGER_TICKS); pg8::Gemm g{QKVB, WOUT, M, D, D}; pg8::StaticOrder S; S.init(M, D, F.G, (int)blockIdx.x, WGM_DOWN);
        pg8::EpiResid<true, false, true> E{AB1, AB1, M, nullptr, AB1, ss2, 1.0f};
        pg8::gemm_phase<pg8::EpiResid<true, false, true>, pg8::StaticOrder, PG8_ALIGN, PG8_SP2>(F.lds + RING_OFF, g, S, E);
        if (BOTH(6)) GRID_BAR(6); }
    if (IN(7)) { pg8::Gemm g{AB1, WGU, M, 2 * FF, D}; pg8::StaticOrder S; S.init(M, 2 * FF, F.G, (int)blockIdx.x, WGM_UP);
        pg8::EpiSwiglu E{ACT, FF, ss2, F.lds + SSL_OFF};
        pg8::gemm_phase<pg8::EpiSwiglu, pg8::StaticOrder, PG8_ALIGN, PG8_SP2>(F.lds + RING_OFF, g, S, E);
        {
          const int nwg = (M / 256) * (2 * FF / 256), rem = nwg % F.G, c = (int)blockIdx.x;
          if (rem == 0) cvt_run<3>(F, P, c * NWAVES + F.wave, F.G * NWAVES);
          else if (c >= rem) cvt_run<3>(F, P, (c - rem) * NWAVES + F.wave, (F.G - rem) * NWAVES); }
        if (BOTH(7)) GRID_BAR(7); }
    if (IN(8)) { if (STAGGER_TICKS) xcd_stagger(STAGGER_TICKS); pg8::Gemm g{ACT, WDN, M, D, FF}; pg8::StaticOrder S; S.init(M, D, F.G, (int)blockIdx.x, WGM_DOWN);
        pg8::EpiResid<true, false, true> E{AB1, AB1, M, nullptr, AB1, ss3, 0.5f};
        pg8::gemm_phase<pg8::EpiResid<true, false, true>, pg8::StaticOrder, PG8_ALIGN, PG8_SP2>(F.lds + RING_OFF, g, S, E);
        if (BOTH(8)) GRID_BAR(8); }
    if (IN(9)) { final_norm(F, P); }
#undef IN
#undef BOTH
#undef GRID_BAR
}

extern "C" void kernel_launch(void* const* d_in, const int* in_sizes, int n_in, void* d_out, int out_size, void* d_ws, size_t ws_size, hipStream_t stream) {
    static int grid = 0;
    if (grid == 0) {
        if (n_in != 17 || out_size != M * D || ws_size < WS_END) { fprintf(stderr, "kernel_launch: unexpected shapes (n_in %d, out %d, ws %zu, need %zu)\n", n_in, out_size, ws_size, (size_t)WS_END); grid = -1; return; }
        int dev = 0, cus = 0, per_cu = 0;
        if (hipGetDevice(&dev) != hipSuccess || hipDeviceGetAttribute(&cus, hipDeviceAttributeMultiprocessorCount, dev) != hipSuccess) { grid = -1; return; }
        if (hipFuncSetAttribute((const void*)mk_fwd, hipFuncAttributeMaxDynamicSharedMemorySize, LDS_BYTES) != hipSuccess) { fprintf(stderr, "kernel_launch: hipFuncSetAttribute failed\n"); grid = -1; return; }
        if (hipOccupancyMaxActiveBlocksPerMultiprocessor(&per_cu, (const void*)mk_fwd, NWAVES * 64, LDS_BYTES) != hipSuccess || per_cu < 1) { fprintf(stderr, "kernel_launch: occupancy query says %d\n", per_cu); }
        (void)hipGetLastError();
        grid = cus;
    }
    if (grid < 0) return;
    (void)hipMemsetAsync((char*)d_ws + WS_CTL, 0, CTL_ZERO_BYTES, stream);
    Args a{};
    for (int i = 0; i < 17; ++i) a.in[i] = (const float*)d_in[i];
    a.out = (float*)d_out; a.ws = (unsigned char*)d_ws; a.pad = 0;
    for (int li = 0; li < N_LAUNCHES; ++li) {
        a.ph_lo = (N_LAUNCHES == PER_PHASE) ? li : 0; a.ph_hi = (N_LAUNCHES == PER_PHASE) ? li + 1 : PER_PHASE; a.li = li;
        hipLaunchKernelGGL(mk_fwd, dim3(grid), dim3(NWAVES * 64), LDS_BYTES, stream, a);
    }
}
```

```cpp
#include <hip/hip_runtime.h>
#include <cstdio>
#include <cstdint>

#ifndef MK_N_LAUNCHES
#define MK_N_LAUNCHES 1
#endif
#ifndef PROBE_REPEAT
#define PROBE_REPEAT -1
#endif
#define NREP(k) ((PROBE_REPEAT == (k)) ? 2 : 1)
#ifndef WGM_DOWN
#define WGM_DOWN 4
#endif
#ifndef WGM_UP
#define WGM_UP 8
#endif
#ifndef WGM_IN
#define WGM_IN 8
#endif
#ifndef RES_DEPTH
#define RES_DEPTH 8
#endif
#ifndef RES_DEPTH_F
#define RES_DEPTH_F 4
#endif
#ifndef STAGGER_TICKS
#define STAGGER_TICKS 0
#endif

namespace pg8 {
#define PG8_LAS __attribute__((address_space(3)))
typedef unsigned short bf16_t;
typedef short bf16x8 __attribute__((ext_vector_type(8)));
typedef float f32x4 __attribute__((ext_vector_type(4)));
typedef unsigned u32x4 __attribute__((ext_vector_type(4)));
constexpr int BM = 256, BK = 64, HALF = 128, HTB = HALF * BK * 2, STAGE_BYTES = 8 * HTB, NXCD = 8, WGM = 8;

__host__ __device__ __forceinline__ int lds_byte(int r, int c) { const int st = (r >> 4) * 2 + (c >> 5), rr = r & 15, cc = c & 31, ob = rr * 64 + cc * 2; return st * 1024 + (ob ^ (((ob >> 9) & 1) << 5)); }
__host__ __device__ __forceinline__ void stage_rc(int b, int& R, int& C) { const int st = b / 1024, sb = b % 1024, swz = sb ^ (((sb >> 9) & 1) << 5); R = (st >> 1) * 16 + swz / 64; C = (st & 1) * 32 + (swz % 64) / 2; }
__host__ __device__ __forceinline__ int perm32(int rho) { const int n = rho >> 4, i = rho & 15; return 8 * (i >> 2) + 4 * n + (i & 3); }

struct Unit { int pm, pn; };
__device__ __forceinline__ void ss_prefetch(const float* ss, PG8_LAS unsigned char* ssl, int pm, int wid, int lane) {
    const float* src = ss + pm * 256 + (wid >> 2) * 64 + lane;
    __builtin_amdgcn_global_load_lds((const unsigned*)src, (PG8_LAS unsigned*)(ssl + wid * 512), 4, 0, 0);
    __builtin_amdgcn_global_load_lds((const unsigned*)(src + 128), (PG8_LAS unsigned*)(ssl + wid * 512 + 256), 4, 0, 0);
}
__device__ __forceinline__ float ss_lds(PG8_LAS unsigned char* ssl, int wr, int wc, int fr, int ai, int m) { return *(const PG8_LAS float*)(ssl + (wr * 4 + wc) * 512 + ai * 256 + (m * 16 + fr) * 4); }
struct Gemm { const bf16_t* A; const bf16_t* Bt; int M, N, K; };

struct StaticOrder {
    int nM, nN, nwg, G, c, wgm;
    __host__ __device__ void init(int M, int N, int G_, int c_, int wgm_ = WGM) { nM = M / BM; nN = N / BM; nwg = nM * nN; G = G_; c = c_; wgm = wgm_; }
    __host__ __device__ bool next(int i, Unit& u) const {
        const long L = (long)i * G + c; if (L >= nwg) return false;
        int wgid = (int)L; { const int q = nwg / NXCD, r = nwg % NXCD, xcd = wgid % NXCD, off = wgid / NXCD; wgid = (xcd < r ? xcd * (q + 1) : r * (q + 1) + (xcd - r) * q) + off; }
        const int nig = wgm * nN, gid = wgid / nig, fm = gid * wgm, gsz = (nM - fm) < wgm ? (nM - fm) : wgm;
        u.pm = fm + ((wgid % nig) % gsz); u.pn = (wgid % nig) / gsz; return true;
    }
    __device__ __forceinline__ void a_ready(const Unit&) const {}
    __device__ __forceinline__ void done(const Unit&) const {}
};

struct FixedOrder : StaticOrder {
    __host__ __device__ bool next(int i, Unit& u) const { Unit t; if (!StaticOrder::next(i, t)) return false; u.pm = 0; u.pn = 0; return true; }
};
__device__ __forceinline__ unsigned cvt_pk_bf16(float lo, float hi) { unsigned r; asm volatile("v_cvt_pk_bf16_f32 %0, %1, %2" : "=v"(r) : "v"(lo), "v"(hi)); return r; }
__device__ __forceinline__ float bf_lo(unsigned w) { return __uint_as_float(w << 16); }
__device__ __forceinline__ float bf_hi(unsigned w) { return __uint_as_float(w & 0xffff0000u); }
__device__ __forceinline__ float sigmoid_f(float x) { return __builtin_amdgcn_rcpf(1.0f + __builtin_amdgcn_exp2f(-1.44269504089f * x)); }

__device__ __forceinline__ unsigned ror8(unsigned x) { return (unsigned)__builtin_amdgcn_mov_dpp((int)x, 0x128, 0xf, 0xf, true); }
__device__ __forceinline__ u32x4 ror8(const u32x4 v) { u32x4 r; r.x = ror8(v.x); r.y = ror8(v.y); r.z = ror8(v.z); r.w = ror8(v.w); return r; }
__device__ __forceinline__ u32x4 sel4(bool c, const u32x4 a, const u32x4 b) { u32x4 r; r.x = c ? a.x : b.x; r.y = c ? a.y : b.y; r.z = c ? a.z : b.z; r.w = c ? a.w : b.w; return r; }
__device__ __forceinline__ void pair_to_lines(const u32x4 X, const u32x4 Y, bool lo8, u32x4& D1, u32x4& D2) { D1 = sel4(lo8, X, ror8(Y)); D2 = sel4(lo8, ror8(X), Y); }
__device__ __forceinline__ void lines_to_pair(const u32x4 L1, const u32x4 L2, bool lo8, u32x4& X, u32x4& Y) { X = sel4(lo8, L1, ror8(L2)); Y = sel4(lo8, ror8(L1), L2); }


template <int MODE> struct EpiSwigluT {
    static constexpr bool PERM = true, AFTER_DRAIN = false, HAS_MID = false, SS_LDS = true, ADJ = false; static constexpr int MID_T = 0, VM_TAIL = (MODE & 1) ? 0 : 8;
    bf16_t* O; int ldc; const float* ss; PG8_LAS unsigned char* ssl;
    __device__ __forceinline__ void mid(f32x4 (&)[2][2][4][2], const Unit&, int, int, int, int) const {}
    __device__ __forceinline__ void operator()(f32x4 (&acc)[2][2][4][2], const Unit& u, int wr, int wc, int fr, int fq) const {
        const int row0 = u.pm * BM + wr * 64 + fr, col0 = u.pn * HALF + wc * 32 + 8 * fq;
        float rs[2][4];
#pragma unroll
        for (int ai = 0; ai < 2; ++ai)
#pragma unroll
            for (int m = 0; m < 4; ++m) rs[ai][m] = (MODE & 2) ? 4096.0f * (float)(fr + 1) : ss_lds(ssl, wr, wc, fr, ai, m);
#pragma unroll
        for (int ai = 0; ai < 2; ++ai)
#pragma unroll
            for (int m = 0; m < 4; ++m) { const int r = row0 + ai * HALF + m * 16; const float rr = __builtin_amdgcn_rsqf(rs[ai][m] * (1.0f / 4096.0f) + 1e-6f);
                const float c1 = -1.44269504089f * rr, rr2 = rr * rr; f32x4 o[2];
#pragma unroll
                for (int n = 0; n < 2; ++n) { const f32x4 g = acc[ai][0][m][n], up = acc[ai][1][m][n]; const f32x4 t = g * c1;
                    f32x4 d = {__builtin_amdgcn_exp2f(t[0]), __builtin_amdgcn_exp2f(t[1]), __builtin_amdgcn_exp2f(t[2]), __builtin_amdgcn_exp2f(t[3])}; d = d + 1.0f;
                    const f32x4 q = {__builtin_amdgcn_rcpf(d[0]), __builtin_amdgcn_rcpf(d[1]), __builtin_amdgcn_rcpf(d[2]), __builtin_amdgcn_rcpf(d[3])};
                    o[n] = ((g * up) * rr2) * q; }
                u32x4 w; w.x = cvt_pk_bf16(o[0][0], o[0][1]); w.y = cvt_pk_bf16(o[0][2], o[0][3]); w.z = cvt_pk_bf16(o[1][0], o[1][1]); w.w = cvt_pk_bf16(o[1][2], o[1][3]);
                if (MODE & 1) asm volatile("" :: "v"(w.x), "v"(w.y), "v"(w.z), "v"(w.w)); else *(u32x4*)(O + (size_t)r * ldc + col0) = w; }
    }
};
using EpiSwiglu = EpiSwigluT<0>;

template <bool BASE_BF16, bool OUT_F32, bool HAS_OB, bool ADJ_ = false> struct EpiResid {
    static constexpr bool PERM = true, AFTER_DRAIN = false, HAS_MID = false, SS_LDS = false, ADJ = ADJ_; static constexpr int MID_T = 0, VM_TAIL = (HAS_OB || OUT_F32) ? 16 : 0;
    const void* base_lo; const void* base_hi; int split_row; float* out; bf16_t* ob; float* ss; float scale;
    __device__ __forceinline__ void mid(f32x4 (&)[2][2][4][2], const Unit&, int, int, int, int) const {}
    __device__ __forceinline__ void operator()(f32x4 (&acc)[2][2][4][2], const Unit& u, int wr, int wc, int fr, int fq) const {
        if constexpr (ADJ_) {
            static_assert(BASE_BF16 && HAS_OB && !OUT_F32, "ADJ residual epilogue: bf16 base, bf16 output");
            const bool lo8 = fr < 8; const int rb = u.pm * BM + wr * 64, row0 = rb + fr;
            const size_t lane_off = (size_t)(rb + (fr & 7)) * 4096 + u.pn * BM + wc * 64 + 32 * (fr >> 3) + 8 * fq;
            const bf16_t* bb = (const bf16_t*)((u.pm * BM < split_row) ? base_lo : base_hi) - ((u.pm * BM < split_row) ? (size_t)0 : (size_t)split_row * 4096);
            u32x4 tb[8][2];
#pragma unroll
            for (int k = 0; k < 8; ++k) { const size_t o_ = lane_off + (size_t)((k >> 2) * HALF + (k & 3) * 16) * 4096; tb[k][0] = *(const u32x4*)(bb + o_); tb[k][1] = *(const u32x4*)(bb + o_ + 8 * 4096); }
#pragma unroll
            for (int k = 0; k < 8; ++k) { const int ai = k >> 2, m = k & 3; u32x4 w[2]; lines_to_pair(tb[k][0], tb[k][1], lo8, w[0], w[1]);
#pragma unroll
                for (int bj = 0; bj < 2; ++bj) {
                    acc[ai][bj][m][0] = (f32x4){bf_lo(w[bj].x), bf_hi(w[bj].x), bf_lo(w[bj].y), bf_hi(w[bj].y)} + acc[ai][bj][m][0] * scale;
                    acc[ai][bj][m][1] = (f32x4){bf_lo(w[bj].z), bf_hi(w[bj].z), bf_lo(w[bj].w), bf_hi(w[bj].w)} + acc[ai][bj][m][1] * scale; }
                asm volatile("" : "+v"(acc[ai][0][m][0]), "+v"(acc[ai][0][m][1]), "+v"(acc[ai][1][m][0]), "+v"(acc[ai][1][m][1]));
                __builtin_amdgcn_sched_barrier(0); }
#pragma unroll
            for (int k = 0; k < 8; ++k) { const int ai = k >> 2, m = k & 3; const int r = row0 + ai * HALF + m * 16; float sq = 0.f; u32x4 w[2];
#pragma unroll
                for (int bj = 0; bj < 2; ++bj) { const f32x4 v0 = acc[ai][bj][m][0], v1 = acc[ai][bj][m][1];
                    sq += (v0[0] * v0[0] + v0[1] * v0[1]) + (v0[2] * v0[2] + v0[3] * v0[3]) + (v1[0] * v1[0] + v1[1] * v1[1]) + (v1[2] * v1[2] + v1[3] * v1[3]);
                    w[bj].x = cvt_pk_bf16(v0[0], v0[1]); w[bj].y = cvt_pk_bf16(v0[2], v0[3]); w[bj].z = cvt_pk_bf16(v1[0], v1[1]); w[bj].w = cvt_pk_bf16(v1[2], v1[3]); }
                u32x4 d1, d2; pair_to_lines(w[0], w[1], lo8, d1, d2);
                const size_t o_ = lane_off + (size_t)(ai * HALF + m * 16) * 4096; *(u32x4*)(ob + o_) = d1; *(u32x4*)(ob + o_ + 8 * 4096) = d2;
                sq += __shfl_xor(sq, 16); sq += __shfl_xor(sq, 32);
                if (fq == 0) __hip_atomic_fetch_add(ss + r, sq, __ATOMIC_RELAXED, __HIP_MEMORY_SCOPE_AGENT); }
            return;
        }
        const int row0 = u.pm * BM + wr * 64 + fr, col0 = u.pn * BM + wc * 32 + 8 * fq;
        if constexpr (BASE_BF16) {
            const bf16_t* bb = (const bf16_t*)((u.pm * BM < split_row) ? base_lo : base_hi) - ((u.pm * BM < split_row) ? (size_t)0 : (size_t)split_row * 4096);
            u32x4 tb[RES_DEPTH][2];
#define RES_LOAD(k) do { const size_t off_ = (size_t)(row0 + ((k) >> 2) * HALF + ((k) & 3) * 16) * 4096 + col0; \
                tb[(k) % RES_DEPTH][0] = *(const u32x4*)(bb + off_); tb[(k) % RES_DEPTH][1] = *(const u32x4*)(bb + off_ + HALF); } while (0)
#pragma unroll
            for (int k = 0; k < RES_DEPTH - 1; ++k) RES_LOAD(k);
#pragma unroll
            for (int k = 0; k < 8; ++k) { const int ai = k >> 2, m = k & 3;
                if (k + RES_DEPTH - 1 < 8) RES_LOAD(k + RES_DEPTH - 1);
#pragma unroll
                for (int bj = 0; bj < 2; ++bj) { const u32x4 w = tb[k % RES_DEPTH][bj];
                    acc[ai][bj][m][0] = (f32x4){bf_lo(w.x), bf_hi(w.x), bf_lo(w.y), bf_hi(w.y)} + acc[ai][bj][m][0] * scale;
                    acc[ai][bj][m][1] = (f32x4){bf_lo(w.z), bf_hi(w.z), bf_lo(w.w), bf_hi(w.w)} + acc[ai][bj][m][1] * scale; }
                asm volatile("" : "+v"(acc[ai][0][m][0]), "+v"(acc[ai][0][m][1]), "+v"(acc[ai][1][m][0]), "+v"(acc[ai][1][m][1]));
                __builtin_amdgcn_sched_barrier(0); }
#undef RES_LOAD
        } else {
            const float* bb = (const float*)((u.pm * BM < split_row) ? base_lo : base_hi) - ((u.pm * BM < split_row) ? (size_t)0 : (size_t)split_row * 4096);
            f32x4 tb[RES_DEPTH_F][4];
#define RES_LOAD(k) do { const size_t off_ = (size_t)(row0 + ((k) >> 2) * HALF + ((k) & 3) * 16) * 4096 + col0; \
                tb[(k) % RES_DEPTH_F][0] = __builtin_nontemporal_load((const f32x4*)(bb + off_)); tb[(k) % RES_DEPTH_F][1] = __builtin_nontemporal_load((const f32x4*)(bb + off_ + 4)); tb[(k) % RES_DEPTH_F][2] = __builtin_nontemporal_load((const f32x4*)(bb + off_ + HALF)); tb[(k) % RES_DEPTH_F][3] = __builtin_nontemporal_load((const f32x4*)(bb + off_ + HALF + 4)); } while (0)
#pragma unroll
            for (int k = 0; k < RES_DEPTH_F - 1; ++k) RES_LOAD(k);
#pragma unroll
            for (int k = 0; k < 8; ++k) { const int ai = k >> 2, m = k & 3;
                if (k + RES_DEPTH_F - 1 < 8) RES_LOAD(k + RES_DEPTH_F - 1);
                acc[ai][0][m][0] = tb[k % RES_DEPTH_F][0] + acc[ai][0][m][0] * scale; acc[ai][0][m][1] = tb[k % RES_DEPTH_F][1] + acc[ai][0][m][1] * scale;
                acc[ai][1][m][0] = tb[k % RES_DEPTH_F][2] + acc[ai][1][m][0] * scale; acc[ai][1][m][1] = tb[k % RES_DEPTH_F][3] + acc[ai][1][m][1] * scale;
                asm volatile("" : "+v"(acc[ai][0][m][0]), "+v"(acc[ai][0][m][1]), "+v"(acc[ai][1][m][0]), "+v"(acc[ai][1][m][1]));
                __builtin_amdgcn_sched_barrier(0); }
#undef RES_LOAD
        }
#pragma unroll
        for (int ai = 0; ai < 2; ++ai)
#pragma unroll
            for (int m = 0; m < 4; ++m) { const int r = row0 + ai * HALF + m * 16; const size_t off = (size_t)r * 4096 + col0; float sq = 0.f;
#pragma unroll
                for (int bj = 0; bj < 2; ++bj) { const f32x4 v0 = acc[ai][bj][m][0], v1 = acc[ai][bj][m][1];
                    if (OUT_F32) { *(f32x4*)(out + off + bj * HALF) = v0; *(f32x4*)(out + off + bj * HALF + 4) = v1; }
                    sq += (v0[0] * v0[0] + v0[1] * v0[1]) + (v0[2] * v0[2] + v0[3] * v0[3]) + (v1[0] * v1[0] + v1[1] * v1[1]) + (v1[2] * v1[2] + v1[3] * v1[3]);
                    if (HAS_OB) { u32x4 w; w.x = cvt_pk_bf16(v0[0], v0[1]); w.y = cvt_pk_bf16(v0[2], v0[3]); w.z = cvt_pk_bf16(v1[0], v1[1]); w.w = cvt_pk_bf16(v1[2], v1[3]); *(u32x4*)(ob + off + bj * HALF) = w; } }
                sq += __shfl_xor(sq, 16); sq += __shfl_xor(sq, 32);
                if (fq == 0) __hip_atomic_fetch_add(ss + r, sq, __ATOMIC_RELAXED, __HIP_MEMORY_SCOPE_AGENT); }
    }
};

struct EpiProj {
    static constexpr bool PERM = true, AFTER_DRAIN = false, HAS_MID = false, SS_LDS = true, ADJ = false; static constexpr int MID_T = 0, VM_TAIL = 16;
    bf16_t* qkv; bf16_t* gates; const float* ss; const float* rope; PG8_LAS unsigned char* ssl;
    __device__ __forceinline__ void mid(f32x4 (&)[2][2][4][2], const Unit&, int, int, int, int) const {}
    __device__ __forceinline__ void operator()(f32x4 (&acc)[2][2][4][2], const Unit& u, int wr, int wc, int fr, int fq) const {
        const int pn = u.pn; const bool is_gate = pn >= 48, is_rope = (pn < 24) || (pn >= 36 && pn < 46);
        const int row0 = u.pm * BM + wr * 64 + fr, cw = wc * 32 + 8 * fq;
        bf16_t* dst = is_gate ? gates + (pn - 48) * BM + cw : qkv + pn * BM + cw; const int ld = is_gate ? 8192 : 12288;
        const bool do_rope = is_rope && (wc == 0); const float sgn = fq < 2 ? -1.0f : 1.0f;
        float rs[2][4];
#pragma unroll
        for (int ai = 0; ai < 2; ++ai)
#pragma unroll
            for (int m = 0; m < 4; ++m) rs[ai][m] = ss_lds(ssl, wr, wc, fr, ai, m);
#pragma unroll
        for (int ai = 0; ai < 2; ++ai)
#pragma unroll
            for (int m = 0; m < 4; ++m) { const int r = row0 + ai * HALF + m * 16; const float rr = __builtin_amdgcn_rsqf(rs[ai][m] * (1.0f / 4096.0f) + 1e-6f);
#pragma unroll
                for (int bj = 0; bj < 2; ++bj) { acc[ai][bj][m][0] *= rr; acc[ai][bj][m][1] *= rr; }
                if (do_rope) { const int pos = r < 8192 ? (r & 4095) : r - 8192; const float* tp = rope + (size_t)pos * 32 + 8 * (fq & 1);
                    const f32x4 c0 = *(const f32x4*)tp, c1 = *(const f32x4*)(tp + 4), s0 = *(const f32x4*)(tp + 16), s1 = *(const f32x4*)(tp + 20);
#pragma unroll
                    for (int bj = 0; bj < 2; ++bj) { f32x4 v0 = acc[ai][bj][m][0], v1 = acc[ai][bj][m][1];
#pragma unroll
                        for (int j = 0; j < 4; ++j) { const float p0 = __shfl_xor(v0[j], 32), p1 = __shfl_xor(v1[j], 32); v0[j] = v0[j] * c0[j] + sgn * p0 * s0[j]; v1[j] = v1[j] * c1[j] + sgn * p1 * s1[j]; }
                        acc[ai][bj][m][0] = v0; acc[ai][bj][m][1] = v1; } } }
#pragma unroll
        for (int ai = 0; ai < 2; ++ai)
#pragma unroll
            for (int m = 0; m < 4; ++m) { const int r = row0 + ai * HALF + m * 16;
                if (is_gate) {
                    bf16_t* gd = gates + (size_t)r * 8192 + (pn - 48) * HALF + cw; f32x4 uu[2], sbv[2];
#pragma unroll
                    for (int n = 0; n < 2; ++n)
#pragma unroll
                        for (int j = 0; j < 4; ++j) { const float sa = sigmoid_f(acc[ai][0][m][n][j]), sb = sigmoid_f(acc[ai][1][m][n][j]); sbv[n][j] = sb; uu[n][j] = sa * __builtin_amdgcn_rcpf(fmaxf(sb, 1e-20f)); }
                    u32x4 w; w.x = cvt_pk_bf16(uu[0][0], uu[0][1]); w.y = cvt_pk_bf16(uu[0][2], uu[0][3]); w.z = cvt_pk_bf16(uu[1][0], uu[1][1]); w.w = cvt_pk_bf16(uu[1][2], uu[1][3]);
                    *(u32x4*)gd = w;
                    w.x = cvt_pk_bf16(sbv[0][0], sbv[0][1]); w.y = cvt_pk_bf16(sbv[0][2], sbv[0][3]); w.z = cvt_pk_bf16(sbv[1][0], sbv[1][1]); w.w = cvt_pk_bf16(sbv[1][2], sbv[1][3]);
                    *(u32x4*)(gd + 4096) = w;
                } else {
#pragma unroll
                    for (int bj = 0; bj < 2; ++bj) { const f32x4 v0 = acc[ai][bj][m][0], v1 = acc[ai][bj][m][1];
                        u32x4 w; w.x = cvt_pk_bf16(v0[0], v0[1]); w.y = cvt_pk_bf16(v0[2], v0[3]); w.z = cvt_pk_bf16(v1[0], v1[1]); w.w = cvt_pk_bf16(v1[2], v1[3]);
                        *(u32x4*)(dst + (size_t)r * ld + bj * HALF) = w; } } }
    }
};

struct EpiMerge {
    static constexpr bool PERM = true, AFTER_DRAIN = false, HAS_MID = true, SS_LDS = false, ADJ = false; static constexpr int MID_T = 16, VM_TAIL = 16;
    const bf16_t* gates; bf16_t* O;
    static constexpr int MID_DEPTH = 4, END_DEPTH = 8;
    __device__ __forceinline__ void mid(f32x4 (&acc)[2][2][4][2], const Unit& u, int wr, int wc, int fr, int fq) const {
        const __amdgpu_buffer_rsrc_t rsG = __builtin_amdgcn_make_buffer_rsrc((void*)gates, (short)0, (int)0xffffffffu, 0x00020000);
        int vo = ((u.pm * BM + wr * 64 + fr) * 8192 + u.pn * BM + wc * 32 + 8 * fq) * 2; asm volatile("" : "+v"(vo));
        u32x4 ta[MID_DEPTH][2];
#define MG_LOAD(k) do { const int o_ = vo + (((k) >> 2) * HALF + ((k) & 3) * 16) * 16384; _Pragma("unroll") for (int bj = 0; bj < 2; ++bj) ta[(k) % MID_DEPTH][bj] = __builtin_amdgcn_raw_buffer_load_b128(rsG, o_ + bj * 256, 0, 0); } while (0)
#pragma unroll
        for (int k = 0; k < MID_DEPTH - 1; ++k) MG_LOAD(k);
#pragma unroll
        for (int k = 0; k < 8; ++k) { const int ai = k >> 2, m = k & 3;
            if (k + MID_DEPTH - 1 < 8) MG_LOAD(k + MID_DEPTH - 1);
#pragma unroll
            for (int bj = 0; bj < 2; ++bj) { const u32x4 a = ta[k % MID_DEPTH][bj];
                acc[ai][bj][m][0] *= (f32x4){bf_lo(a.x), bf_hi(a.x), bf_lo(a.y), bf_hi(a.y)}; acc[ai][bj][m][1] *= (f32x4){bf_lo(a.z), bf_hi(a.z), bf_lo(a.w), bf_hi(a.w)}; }
            asm volatile("" : "+v"(acc[ai][0][m][0]), "+v"(acc[ai][0][m][1]), "+v"(acc[ai][1][m][0]), "+v"(acc[ai][1][m][1]));
            __builtin_amdgcn_sched_barrier(0); }
#undef MG_LOAD
    }
    __device__ __forceinline__ void operator()(f32x4 (&acc)[2][2][4][2], const Unit& u, int wr, int wc, int fr, int fq) const {
        const int row0 = u.pm * BM + wr * 64 + fr, col0 = u.pn * BM + wc * 32 + 8 * fq;
        { const __amdgpu_buffer_rsrc_t rsG = __builtin_amdgcn_make_buffer_rsrc((void*)gates, (short)0, (int)0xffffffffu, 0x00020000);
          const int vo = (row0 * 8192 + col0) * 2;
          u32x4 tb[END_DEPTH][2];
#define MG_LOAD(k) do { const int o_ = vo + (((k) >> 2) * HALF + ((k) & 3) * 16) * 16384; _Pragma("unroll") for (int bj = 0; bj < 2; ++bj) tb[(k) % END_DEPTH][bj] = __builtin_amdgcn_raw_buffer_load_b128(rsG, o_ + bj * 256, 8192, 0); } while (0)
#pragma unroll
          for (int k = 0; k < END_DEPTH - 1; ++k) MG_LOAD(k);
#pragma unroll
          for (int k = 0; k < 8; ++k) { const int ai = k >> 2, m = k & 3;
              if (k + END_DEPTH - 1 < 8) MG_LOAD(k + END_DEPTH - 1);
#pragma unroll
              for (int bj = 0; bj < 2; ++bj) { const u32x4 b = tb[k % END_DEPTH][bj]; f32x4 g0, g1;
                  g0[0] = fmaxf(bf_lo(b.x), 1e-20f); g0[1] = fmaxf(bf_hi(b.x), 1e-20f); g0[2] = fmaxf(bf_lo(b.y), 1e-20f); g0[3] = fmaxf(bf_hi(b.y), 1e-20f);
                  g1[0] = fmaxf(bf_lo(b.z), 1e-20f); g1[1] = fmaxf(bf_hi(b.z), 1e-20f); g1[2] = fmaxf(bf_lo(b.w), 1e-20f); g1[3] = fmaxf(bf_hi(b.w), 1e-20f);
                  acc[ai][bj][m][0] *= g0; acc[ai][bj][m][1] *= g1; }
              asm volatile("" : "+v"(acc[ai][0][m][0]), "+v"(acc[ai][0][m][1]), "+v"(acc[ai][1][m][0]), "+v"(acc[ai][1][m][1]));
              __builtin_amdgcn_sched_barrier(0); }
#undef MG_LOAD
        }
#pragma unroll
        for (int ai = 0; ai < 2; ++ai)
#pragma unroll
            for (int m = 0; m < 4; ++m) { const int r = row0 + ai * HALF + m * 16;
#pragma unroll
                for (int bj = 0; bj < 2; ++bj) { const f32x4 a0 = acc[ai][bj][m][0], a1 = acc[ai][bj][m][1];
                    u32x4 w; w.x = cvt_pk_bf16(a0[0], a0[1]); w.y = cvt_pk_bf16(a0[2], a0[3]); w.z = cvt_pk_bf16(a1[0], a1[1]); w.w = cvt_pk_bf16(a1[2], a1[3]);
                    *(u32x4*)(O + (size_t)r * 4096 + col0 + bj * HALF) = w; } }
    }
};

template <class Epi, class Sched, bool ALIGN_EPI = false, bool SP2 = false>
__device__ __forceinline__ void gemm_phase(PG8_LAS unsigned char* lds, const Gemm g, const Sched& S, const Epi& E) {
    const int tid = threadIdx.x, wid = __builtin_amdgcn_readfirstlane(tid >> 6), lane = tid & 63, wr = wid >> 2, wc = wid & 3, fr = lane & 15, fq = lane >> 4;
    const int K = g.K, nt = K / BK;
    unsigned voffA[2], voffB[2];
#pragma unroll
    for (int i = 0; i < 2; ++i) { int R, C; stage_rc(tid * 16 + i * 8192, R, C); const int Rb = Epi::PERM ? ((R & ~31) + perm32(R & 31)) : R;
        const int Rj = Epi::ADJ ? 64 * (R >> 5) + perm32(R & 31) : Rb;
        voffA[i] = (unsigned)(R * K + C) * 2u; voffB[i] = (unsigned)(Rj * K + C) * 2u; }
    const unsigned kstep = (unsigned)(BK * 2);
    const unsigned hstep = (unsigned)HALF * (unsigned)K * 2u;
    const unsigned tstep = 2u * hstep;
    const unsigned hB = Epi::ADJ ? 32u * (unsigned)K * 2u : hstep;
    const __amdgpu_buffer_rsrc_t rsA = __builtin_amdgcn_make_buffer_rsrc((void*)g.A, (short)0, (int)0xffffffffu, 0x00020000);
    const __amdgpu_buffer_rsrc_t rsB = __builtin_amdgcn_make_buffer_rsrc((void*)g.Bt, (short)0, (int)0xffffffffu, 0x00020000);
    const unsigned ldsw = (unsigned)wid * 1024u;
    const int aoff = lds_byte(wr * 64 + fr, fq * 8), boff = lds_byte(wc * 32 + fr, fq * 8);
#define PG8_SA(b, h) (((b) * 2 + (h)) * HTB)
#define PG8_SB(b, h) ((4 + (b) * 2 + (h)) * HTB)
#define PG8_STAGE(bufoff, rs, soff, voff) do { _Pragma("unroll") for (int _i = 0; _i < 2; ++_i) \
        __builtin_amdgcn_raw_ptr_buffer_load_lds(rs, (PG8_LAS unsigned*)(lds + (bufoff) + ldsw + _i * 8192), 16, (int)(voff)[_i], (int)(soff), 0, 0); } while (0)
#define PG8_LDA(dst, b, h) do { _Pragma("unroll") for (int m = 0; m < 4; ++m) _Pragma("unroll") for (int k = 0; k < 2; ++k) dst[m][k] = *(const PG8_LAS bf16x8*)(lds + PG8_SA(b, h) + aoff + m * 2048 + k * 1024); } while (0)
#define PG8_LDB(dst, b, h) do { _Pragma("unroll") for (int n = 0; n < 2; ++n) _Pragma("unroll") for (int k = 0; k < 2; ++k) dst[n][k] = *(const PG8_LAS bf16x8*)(lds + PG8_SB(b, h) + boff + n * 2048 + k * 1024); } while (0)
#define PG8_MMA(ai, bj, At, Bt) do { __builtin_amdgcn_s_setprio(1); _Pragma("unroll") for (int m = 0; m < 4; ++m) _Pragma("unroll") for (int n = 0; n < 2; ++n) _Pragma("unroll") for (int k = 0; k < 2; ++k) \
        acc[ai][bj][m][n] = __builtin_amdgcn_mfma_f32_16x16x32_bf16(Bt[n][k], At[m][k], acc[ai][bj][m][n], 0, 0, 0); __builtin_amdgcn_s_setprio(0); } while (0)
#define PG8_WAIT_V(n) asm volatile("s_waitcnt vmcnt(" #n ")" ::: "memory")
#define PG8_WAIT_VN(N) asm volatile("s_waitcnt vmcnt(%0)" :: "n"(N) : "memory")
#define PG8_WAIT_L(n) asm volatile("s_waitcnt lgkmcnt(" #n ")" ::: "memory")
#define PG8_BAR __builtin_amdgcn_s_barrier()
#define PG8_SCHED __builtin_amdgcn_sched_barrier(0)
    Unit cur, nxt; int ui = 0;
    if (!S.next(0, cur)) return;
    f32x4 acc[2][2][4][2];
#pragma unroll
    for (int a = 0; a < 2; ++a)
#pragma unroll
        for (int b = 0; b < 2; ++b)
#pragma unroll
            for (int m = 0; m < 4; ++m)
#pragma unroll
                for (int n = 0; n < 2; ++n) acc[a][b][m][n] = (f32x4){0.f, 0.f, 0.f, 0.f};
    bf16x8 At[4][2], B0[2][2], B1[2][2];
    unsigned cA = __builtin_amdgcn_readfirstlane((unsigned)cur.pm * tstep), cB = __builtin_amdgcn_readfirstlane((unsigned)cur.pn * tstep);
    S.a_ready(cur);
    if constexpr (Epi::SS_LDS) ss_prefetch(E.ss, E.ssl, cur.pm, wid, lane);
    if constexpr (SP2) {
        PG8_STAGE(PG8_SB(0, 0), rsB, cB, voffB); PG8_STAGE(PG8_SB(0, 1), rsB, cB + hB, voffB); PG8_STAGE(PG8_SA(0, 0), rsA, cA, voffA); PG8_STAGE(PG8_SA(0, 1), rsA, cA + hstep, voffA);
        if (wr == 1) PG8_BAR;
        PG8_WAIT_V(2); PG8_BAR;
        PG8_STAGE(PG8_SB(1, 0), rsB, cB + kstep, voffB); PG8_STAGE(PG8_SA(1, 0), rsA, cA + kstep, voffA); PG8_STAGE(PG8_SB(1, 1), rsB, cB + hB + kstep, voffB);
        PG8_WAIT_V(0); PG8_BAR;
    } else {
        PG8_STAGE(PG8_SB(0, 0), rsB, cB, voffB); PG8_STAGE(PG8_SA(0, 0), rsA, cA, voffA); PG8_STAGE(PG8_SB(0, 1), rsB, cB + hB, voffB); PG8_STAGE(PG8_SA(0, 1), rsA, cA + hstep, voffA);
        if (wr == 1) PG8_BAR;
        PG8_WAIT_V(4); PG8_BAR;
        PG8_STAGE(PG8_SB(1, 0), rsB, cB + kstep, voffB); PG8_STAGE(PG8_SA(1, 0), rsA, cA + kstep, voffA); PG8_STAGE(PG8_SB(1, 1), rsB, cB + hB + kstep, voffB);
        PG8_WAIT_V(6); PG8_BAR;
    }
    for (;;) {
        const bool has_next = S.next(ui + 1, nxt);
        const unsigned nA = __builtin_amdgcn_readfirstlane(has_next ? (unsigned)nxt.pm * tstep : cA), nB = __builtin_amdgcn_readfirstlane(has_next ? (unsigned)nxt.pn * tstep : cB);
#define PG8_KADDR const bool last = (t == nt - 2); const unsigned a1 = cA + (unsigned)(t + 1) * kstep; \
            const unsigned a2 = last ? nA : cA + (unsigned)(t + 2) * kstep, b2 = last ? nB : cB + (unsigned)(t + 2) * kstep, a3 = a2 + kstep, b3 = b2 + kstep; \
            if (last && has_next) S.a_ready(nxt); \
            if constexpr (Epi::HAS_MID) { if (t == Epi::MID_T) E.mid(acc, cur, wr, wc, fr, fq); }
#define PG8_KPAIR_SP2(W12) do { \
            PG8_LDB(B0, 0, 0); PG8_LDB(B1, 0, 1); PG8_SCHED; PG8_LDA(At, 0, 0); PG8_STAGE(PG8_SA(1, 1), rsA, a1 + hstep, voffA); \
            PG8_WAIT_VN(W12); PG8_WAIT_L(0); PG8_BAR; PG8_MMA(0, 0, At, B0); PG8_MMA(0, 1, At, B1); PG8_BAR; PG8_SCHED; \
            PG8_LDA(At, 0, 1); PG8_STAGE(PG8_SB(0, 0), rsB, b2, voffB); PG8_STAGE(PG8_SB(0, 1), rsB, b2 + hB, voffB); PG8_STAGE(PG8_SA(0, 0), rsA, a2, voffA); \
            PG8_WAIT_VN(W12); PG8_WAIT_L(0); PG8_BAR; PG8_MMA(1, 0, At, B0); PG8_MMA(1, 1, At, B1); PG8_BAR; PG8_SCHED; \
            PG8_LDB(B0, 1, 0); PG8_LDB(B1, 1, 1); PG8_SCHED; PG8_LDA(At, 1, 0); PG8_STAGE(PG8_SA(0, 1), rsA, a2 + hstep, voffA); \
            PG8_WAIT_V(8); PG8_WAIT_L(0); PG8_BAR; PG8_MMA(0, 0, At, B0); PG8_MMA(0, 1, At, B1); PG8_BAR; PG8_SCHED; \
            PG8_LDA(At, 1, 1); PG8_STAGE(PG8_SB(1, 0), rsB, b3, voffB); PG8_STAGE(PG8_SB(1, 1), rsB, b3 + hB, voffB); PG8_STAGE(PG8_SA(1, 0), rsA, a3, voffA); \
            PG8_WAIT_V(8); PG8_WAIT_L(0); PG8_BAR; PG8_MMA(1, 0, At, B0); PG8_MMA(1, 1, At, B1); PG8_BAR; PG8_SCHED; } while (0)
        if constexpr (SP2) {
            { const int t = 0; PG8_KADDR; PG8_KPAIR_SP2(8 + Epi::VM_TAIL); }
            for (int t = 2; t < nt; t += 2) { PG8_KADDR; PG8_KPAIR_SP2(8); }
        } else {
        for (int t = 0; t < nt; t += 2) {
            PG8_KADDR;
            PG8_LDB(B0, 0, 0); PG8_SCHED; PG8_LDA(At, 0, 0); PG8_STAGE(PG8_SA(1, 1), rsA, a1 + hstep, voffA);
            PG8_WAIT_L(8); PG8_BAR; PG8_WAIT_L(0); PG8_MMA(0, 0, At, B0); PG8_BAR; PG8_SCHED;
            PG8_LDB(B1, 0, 1); PG8_STAGE(PG8_SB(0, 0), rsB, b2, voffB);
            PG8_BAR; PG8_WAIT_L(0); PG8_MMA(0, 1, At, B1); PG8_BAR;
            PG8_LDA(At, 0, 1); PG8_STAGE(PG8_SA(0, 0), rsA, a2, voffA);
            PG8_BAR; PG8_WAIT_L(0); PG8_MMA(1, 0, At, B0); PG8_BAR; PG8_SCHED;
            PG8_STAGE(PG8_SB(0, 1), rsB, b2 + hB, voffB);
            PG8_WAIT_V(6); PG8_BAR; PG8_MMA(1, 1, At, B1); PG8_BAR;
            PG8_LDB(B0, 1, 0); PG8_SCHED; PG8_LDA(At, 1, 0); PG8_STAGE(PG8_SA(0, 1), rsA, a2 + hstep, voffA);
            PG8_WAIT_L(8); PG8_BAR; PG8_WAIT_L(0); PG8_MMA(0, 0, At, B0); PG8_BAR; PG8_SCHED;
            PG8_LDB(B1, 1, 1); PG8_STAGE(PG8_SB(1, 0), rsB, b3, voffB);
            PG8_BAR; PG8_WAIT_L(0); PG8_MMA(0, 1, At, B1); PG8_BAR;
            PG8_LDA(At, 1, 1); PG8_STAGE(PG8_SA(1, 0), rsA, a3, voffA);
            PG8_BAR; PG8_WAIT_L(0); PG8_MMA(1, 0, At, B0); PG8_BAR; PG8_SCHED;
            PG8_STAGE(PG8_SB(1, 1), rsB, b3 + hB, voffB);
            PG8_WAIT_V(6); PG8_BAR; PG8_MMA(1, 1, At, B1); PG8_BAR;
        }
        }
        if constexpr (ALIGN_EPI) { if (wr == 0) PG8_BAR; }
        if constexpr (!Epi::AFTER_DRAIN) { E(acc, cur, wr, wc, fr, fq); S.done(cur); }
        if (!has_next) break;
#pragma unroll
        for (int a = 0; a < 2; ++a)
#pragma unroll
            for (int b = 0; b < 2; ++b)
#pragma unroll
                for (int m = 0; m < 4; ++m)
#pragma unroll
                    for (int n = 0; n < 2; ++n) acc[a][b][m][n] = (f32x4){0.f, 0.f, 0.f, 0.f};
        cur = nxt; cA = nA; cB = nB; ++ui;
        if constexpr (Epi::SS_LDS) ss_prefetch(E.ss, E.ssl, cur.pm, wid, lane);
        if constexpr (ALIGN_EPI) { if (wr == 1) PG8_BAR; }
    }
    PG8_WAIT_V(0);
    if constexpr (!ALIGN_EPI) { if (wr == 0) PG8_BAR; }
    PG8_BAR;
#undef PG8_SA
#undef PG8_SB
#undef PG8_STAGE
#undef PG8_LDA
#undef PG8_LDB
#undef PG8_MMA
#undef PG8_WAIT_V
#undef PG8_WAIT_L
#undef PG8_WAIT_VN
#undef PG8_KADDR
#undef PG8_KPAIR_SP2
#undef PG8_BAR
#undef PG8_SCHED
}
}

#ifndef PG8_SP2
#define PG8_SP2 true
#endif
#ifndef PG8_ALIGN
#define PG8_ALIGN true
#endif

constexpr int NWAVES = 8;
constexpr int N_LAUNCHES = MK_N_LAUNCHES;
constexpr int PER_PHASE = 10;
constexpr int D = 4096, FF = 11008, NIN = 20480, QKVW = 12288, GATEW = 8192, YABW = 3072;
constexpr int M_P = 8192, M_S = 16384, M = M_P + M_S;
constexpr float QSCALE = 0.08838834764831845f * 1.4426950408889634f;

constexpr size_t MiB = 1u << 20;
constexpr size_t WS_CTL = 0, CTL_ZERO_BYTES = 1 * MiB;
constexpr size_t WS_SS0 = 1 * MiB;
constexpr size_t WS_ROPE = 2 * MiB;
constexpr size_t WS_WIN = 4 * MiB;
constexpr size_t WS_WAB = WS_WIN + (size_t)NIN * D * 2;
constexpr size_t WS_WOUT = WS_WAB + (size_t)D * YABW * 2;
constexpr size_t WS_WGU = WS_WOUT + (size_t)D * D * 2;
constexpr size_t WS_WD = WS_WGU + (size_t)2 * FF * D * 2;
constexpr size_t WS_AB1 = WS_WD + (size_t)D * FF * 2;
constexpr size_t WS_ACT = WS_AB1 + (size_t)M * D * 2;
constexpr size_t WS_QKV = WS_ACT + (size_t)M * FF * 2;
constexpr size_t WS_END = WS_QKV + (size_t)M * QKVW * 2;
constexpr int CW_BAR = 4096;
constexpr int CW_SS1 = 16384, CW_SS2 = CW_SS1 + M, CW_SS3 = CW_SS2 + M;
static_assert((size_t)(CW_SS3 + M) * 4 <= CTL_ZERO_BYTES, "CTL words inside the memset region");
static_assert(WS_SS0 + (size_t)M * 4 <= WS_ROPE && WS_ROPE + (size_t)16384 * 32 * 4 <= WS_WIN, "ws map");

constexpr int RING_OFF = 0, RING_BYTES = 131072;
constexpr int LDSCTL_OFF = RING_BYTES, MISC_OFF = LDSCTL_OFF + 320;
constexpr int SSL_OFF = MISC_OFF + 1024;
constexpr int LDS_BYTES = 147456;

#define GAS __attribute__((address_space(1)))
#define LAS __attribute__((address_space(3)))
typedef unsigned short bf16;
typedef unsigned v4u __attribute__((ext_vector_type(4)));
typedef unsigned v2u __attribute__((ext_vector_type(2)));
typedef float f32x4 __attribute__((ext_vector_type(4)));
typedef short bf16x8 __attribute__((ext_vector_type(8)));
typedef short s16x4 __attribute__((ext_vector_type(4)));
typedef GAS unsigned gu32;
#define RLX_AGENT __ATOMIC_RELAXED, __HIP_MEMORY_SCOPE_AGENT
#define LDS_WAIT() asm volatile("s_waitcnt lgkmcnt(0)" ::: "memory")
#define VM_WAIT() asm volatile("s_waitcnt vmcnt(0)" ::: "memory")
__device__ __forceinline__ unsigned pk2(float lo, float hi) { return pg8::cvt_pk_bf16(lo, hi); }

#define XB_TMO      128
#define XB_XCNT(j)  (256  + 64 * (j))
#define XB_XSUB(j)  (1280 + 64 * (j))
#define XB_XGEN(j)  (2304 + 64 * (j))
#define XB_TOP      3328
#define XB_TOPGEN   3392
#define XCD_BAR_WORDS 3456
#define XB_SPIN_CAP (1u << 18)

__device__ __forceinline__ unsigned xb_ld(unsigned* p)              { return __hip_atomic_load(p, __ATOMIC_RELAXED, __HIP_MEMORY_SCOPE_AGENT); }
__device__ __forceinline__ unsigned xb_add(unsigned* p, unsigned v) { return __hip_atomic_fetch_add(p, v, __ATOMIC_RELAXED, __HIP_MEMORY_SCOPE_AGENT); }
__device__ __forceinline__ unsigned xb_xcc_id() { return (unsigned)__builtin_amdgcn_s_getreg((3 << 11) | 20) & 0xFu; }
#define XB_SPIN(cond, bar) do { unsigned _sp = 0; while (cond) { __builtin_amdgcn_s_sleep(1); \
    if ((++_sp & 255u) == 0u) { if (xb_ld(&(bar)[XB_TMO])) break; if (_sp > XB_SPIN_CAP) { atomicAdd(&(bar)[XB_TMO], 1u); break; } } } } while (0)

struct XcdBarrier {
    unsigned* bar; unsigned x;
    volatile LAS unsigned* st;
};
__device__ __forceinline__ XcdBarrier xcd_barrier_post(unsigned* bar, volatile LAS unsigned* st) {
    XcdBarrier b; b.bar = bar; b.x = xb_xcc_id(); b.st = st;
    if (threadIdx.x == 0) (void)xb_add(&bar[XB_XCNT(b.x)], 1u);
    return b;
}
__device__ __forceinline__ void xcd_barrier_complete(unsigned* bar, unsigned x, unsigned& nloc, unsigned& nx) {
    const unsigned G = gridDim.x * gridDim.y * gridDim.z;
    unsigned sum, cnt, mine, sp = 0u;
    for (;;) {
        sum = 0u; cnt = 0u; mine = 0u;
#pragma unroll
        for (unsigned j = 0; j < 16; ++j) { const unsigned c = xb_ld(&bar[XB_XCNT(j)]); sum += c; cnt += (c > 0u) ? 1u : 0u; mine = (j == x) ? c : mine; }
        if (sum == G) break;
        __builtin_amdgcn_s_sleep(1);
        if ((++sp & 255u) == 0u) { if (xb_ld(&bar[XB_TMO])) break; if (sp > XB_SPIN_CAP) { atomicAdd(&bar[XB_TMO], 1u); break; } }
    }
    nloc = mine > 0u ? mine : 1u; nx = cnt > 0u ? cnt : 1u;
}
__device__ __forceinline__ void xcd_barrier(const XcdBarrier& b) {
    asm volatile("s_waitcnt vmcnt(0)" ::: "memory");
    __syncthreads();
    if (threadIdx.x == 0) {
        unsigned* bar = b.bar;
        __builtin_amdgcn_s_waitcnt(0);
        unsigned nloc = b.st[0], nx = b.st[1];
        if (nloc == 0u) { xcd_barrier_complete(bar, b.x, nloc, nx); b.st[0] = nloc; b.st[1] = nx; }
        const unsigned old = xb_add(&bar[XB_XSUB(b.x)], 1u);
        const unsigned gen = old / nloc;
        if (old + 1u == (gen + 1u) * nloc) {
            __builtin_amdgcn_fence(__ATOMIC_RELEASE, "agent");
            asm volatile("s_waitcnt vmcnt(0)" ::: "memory");
            const unsigned og = xb_add(&bar[XB_TOP], 1u);
            const unsigned tg = og / nx;
            if (og + 1u == (tg + 1u) * nx) xb_add(&bar[XB_TOPGEN], 1u);
            else XB_SPIN(xb_ld(&bar[XB_TOPGEN]) == tg, bar);
            __builtin_amdgcn_fence(__ATOMIC_ACQUIRE, "agent");
            xb_add(&bar[XB_XGEN(b.x)], 1u);
            asm volatile("s_waitcnt vmcnt(0)" ::: "memory");
        } else {
            XB_SPIN(xb_ld(&bar[XB_XGEN(b.x)]) == gen, bar);
            __builtin_amdgcn_fence(__ATOMIC_ACQUIRE, "agent");
            asm volatile("s_waitcnt vmcnt(0)" ::: "memory");
        }
    }
    __syncthreads();
}

__device__ __forceinline__ void xcd_stagger(unsigned ticks) {
    const unsigned long long dt = (unsigned long long)(xb_xcc_id() & 7u) * ticks, t0 = __builtin_amdgcn_s_memrealtime();
    while (__builtin_amdgcn_s_memrealtime() - t0 < dt) __builtin_amdgcn_s_sleep(8);
}

struct Frame {
    LAS unsigned char* lds;
    volatile LAS unsigned* MISC;
    gu32* ctl;
    int tid, lane, wave;
    int vcu, G;
};

__device__ __forceinline__ float wave_sum(float v) {
#pragma unroll
    for (int o = 1; o < 64; o <<= 1) v += __shfl_xor(v, o);
    return v;
}

struct CvtJob { const float* W; const float* gain; bf16* WT; int N, ldT, drow, kcol0, k0, n0; float cs; };
__device__ __forceinline__ void cvt_job(CvtJob& J, const float* W, int N, const float* gain, bf16* WT, int ldT, int koff, int mode, int item) {
    const int nblk = N / 64, kb = item / nblk, nb = item % nblk, k0 = 64 * kb, n0 = 64 * nb;
    J.W = W; J.gain = gain; J.WT = WT; J.N = N; J.ldT = ldT; J.k0 = k0; J.n0 = n0; J.kcol0 = koff + k0;
    J.cs = (mode == 3 && (n0 < 3072 || (n0 >= 9216 && n0 < 11264))) ? QSCALE : 1.0f;
    J.drow = (mode == 1 || mode == 2) ? 256 * (n0 >> 7) + (n0 & 127) + (mode == 2 ? 128 : 0) : n0;
    if (mode == 3 && n0 >= 12288) { const int c = n0 - 12288, c2 = c & 4095;
        J.drow = 12288 + 256 * (c2 >> 7) + (c2 & 127) + (c >= 4096 ? 128 : 0); }
}
__device__ __forceinline__ void cvt_load(const CvtJob& J, int lane, f32x4 (&v)[16]) {
    const float* p = J.W + (size_t)(J.k0 + 16 * (lane >> 4)) * J.N + J.n0 + 4 * (lane & 15);
#pragma unroll
    for (int i = 0; i < 16; ++i) v[i] = __builtin_nontemporal_load((const f32x4*)(p + (size_t)i * J.N));
}
__device__ __forceinline__ void cvt_store(const CvtJob& J, const f32x4 (&v)[16], LAS unsigned char* img, int lane) {
    const int g = lane >> 4, i15 = lane & 15;
    f32x4 gq[4];
#pragma unroll
    for (int j = 0; j < 4; ++j) gq[j] = J.gain ? *(const f32x4*)(J.gain + J.k0 + 16 * g + 4 * j) * J.cs : (f32x4){J.cs, J.cs, J.cs, J.cs};
#pragma unroll
    for (int e = 0; e < 4; ++e) { v4u lo, hi;
        lo.x = pk2(v[0][e] * gq[0][0], v[1][e] * gq[0][1]);   lo.y = pk2(v[2][e] * gq[0][2], v[3][e] * gq[0][3]);   lo.z = pk2(v[4][e] * gq[1][0], v[5][e] * gq[1][1]);   lo.w = pk2(v[6][e] * gq[1][2], v[7][e] * gq[1][3]);
        hi.x = pk2(v[8][e] * gq[2][0], v[9][e] * gq[2][1]);   hi.y = pk2(v[10][e] * gq[2][2], v[11][e] * gq[2][3]); hi.z = pk2(v[12][e] * gq[3][0], v[13][e] * gq[3][1]); hi.w = pk2(v[14][e] * gq[3][2], v[15][e] * gq[3][3]);
        LAS unsigned char* wp = img + (4 * i15 + e) * 144 + 32 * g;
        *(LAS v4u*)wp = lo; *(LAS v4u*)(wp + 16) = hi; }
    const int r = lane >> 3, c = lane & 7;
    bf16* op = J.WT + (size_t)(J.drow + r) * J.ldT + J.kcol0 + 8 * c;
#pragma unroll
    for (int j = 0; j < 8; ++j) {
        const v4u o = *(const LAS v4u*)(img + (8 * j + r) * 144 + 16 * c);
        *(v4u*)(op + (size_t)(8 * j) * J.ldT) = o;
    }
}
struct Ptrs;
template <int SET> __device__ __forceinline__ void cvt_decode(const Ptrs& P, int it, CvtJob& J);

__device__ __forceinline__ void sincos_acc(float a, float& s, float& c) {
    const double x = (double)a;
    const double kq = __builtin_rint(x * 0.63661977236758134308);
    double r = __builtin_fma(-kq, 1.57079632679489655800e+00, x);
    r = __builtin_fma(-kq, 6.12323399573676603587e-17, r);
    const int q = (int)((long long)kq) & 3;
    const double r2 = r * r;
    const double sp = r * (1.0 + r2 * (-1.0 / 6.0 + r2 * (1.0 / 120.0 + r2 * (-1.0 / 5040.0 + r2 * (1.0 / 362880.0 + r2 * (-1.0 / 39916800.0 + r2 * (1.0 / 6227020800.0)))))));
    const double cp = 1.0 + r2 * (-0.5 + r2 * (1.0 / 24.0 + r2 * (-1.0 / 720.0 + r2 * (1.0 / 40320.0 + r2 * (-1.0 / 3628800.0 + r2 * (1.0 / 479001600.0))))));
    const double ss = (q & 1) ? cp : sp, cc = (q & 1) ? sp : cp;
    s = (float)((q & 2) ? -ss : ss);
    c = (float)(((q + 1) & 2) ? -cc : cc);
}

struct Ptrs {
    const float* xp; const float* xs; const float* g1; const float* w1g; const float* w1u; const float* w1d; const float* gmix; const float* win; const float* sink;
    const float* wa; const float* wb; const float* wout; const float* g2; const float* w2g; const float* w2u; const float* w2d; const float* gfin;
    float* out; unsigned char* ws;
};

constexpr int CI_GU = (D / 64) * (FF / 64), CI_D = (FF / 64) * (D / 64), CI_IN = (D / 64) * (NIN / 64), CI_A = (1024 / 64) * (D / 64), CI_B = (2048 / 64) * (D / 64), CI_O = (D / 64) * (D / 64);
constexpr int CI_IN0 = CI_IN / 2;
template <> __device__ __forceinline__ void cvt_decode<0>(const Ptrs& P, int it, CvtJob& J) {
    bf16* WGU = (bf16*)(P.ws + WS_WGU); bf16* WD = (bf16*)(P.ws + WS_WD); bf16* WIN = (bf16*)(P.ws + WS_WIN);
    int r = it;
    if (r < CI_GU) { cvt_job(J, P.w1g, FF, P.g1, WGU, D, 0, 1, r); return; } r -= CI_GU;
    if (r < CI_GU) { cvt_job(J, P.w1u, FF, P.g1, WGU, D, 0, 2, r); return; } r -= CI_GU;
    if (r < CI_D)  { cvt_job(J, P.w1d, D, nullptr, WD, FF, 0, 0, r); return; } r -= CI_D;
    cvt_job(J, P.win, NIN, P.gmix, WIN, D, 0, 3, r);
}
template <> __device__ __forceinline__ void cvt_decode<2>(const Ptrs& P, int it, CvtJob& J) {
    bf16* WIN = (bf16*)(P.ws + WS_WIN); bf16* WAB = (bf16*)(P.ws + WS_WAB); bf16* WOUT = (bf16*)(P.ws + WS_WOUT);
    int r = it;
    if (r < CI_IN - CI_IN0) { cvt_job(J, P.win, NIN, P.gmix, WIN, D, 0, 3, r + CI_IN0); return; } r -= CI_IN - CI_IN0;
    if (r < CI_A)  { cvt_job(J, P.wa, D, nullptr, WAB, YABW, 0, 0, r); return; } r -= CI_A;
    if (r < CI_B)  { cvt_job(J, P.wb, D, nullptr, WAB, YABW, 1024, 0, r); return; } r -= CI_B;
    cvt_job(J, P.wout, D, nullptr, WOUT, D, 0, 0, r);
}
template <> __device__ __forceinline__ void cvt_decode<1>(const Ptrs& P, int it, CvtJob& J) {
    bf16* WGU = (bf16*)(P.ws + WS_WGU); bf16* WD = (bf16*)(P.ws + WS_WD);
    int r = it;
    if (r < CI_GU) { cvt_job(J, P.w2g, FF, P.g2, WGU, D, 0, 1, r); return; } r -= CI_GU;
    cvt_job(J, P.w2u, FF, P.g2, WGU, D, 0, 2, r);
}
template <> __device__ __forceinline__ void cvt_decode<3>(const Ptrs& P, int it, CvtJob& J) { cvt_job(J, P.w2d, D, nullptr, (bf16*)(P.ws + WS_WD), FF, 0, 0, it); }
template <int SET> __device__ __forceinline__ void cvt_run(Frame& F, const Ptrs& P, int gw, int NGW) {
    constexpr int NITEMS = SET == 0 ? 2 * CI_GU + CI_D + CI_IN0 : (SET == 1 ? 2 * CI_GU : (SET == 3 ? CI_D : (CI_IN - CI_IN0) + CI_A + CI_B + CI_O));
    LAS unsigned char* img = F.lds + RING_OFF + F.wave * 16384;
    const int lane = F.lane;
    f32x4 va[16], vb[16]; CvtJob Ja, Jb;
    int it = gw;
    if (it >= NITEMS) return;
    cvt_decode<SET>(P, it, Ja); cvt_load(Ja, lane, va);
    for (;;) {
        int nx = it + NGW;
        cvt_decode<SET>(P, nx < NITEMS ? nx : NITEMS - 1, Jb); cvt_load(Jb, lane, vb);
        cvt_store(Ja, va, img, lane);
        it = nx; if (it >= NITEMS) break;
        nx = it + NGW;
        cvt_decode<SET>(P, nx < NITEMS ? nx : NITEMS - 1, Ja); cvt_load(Ja, lane, va);
        cvt_store(Jb, vb, img, lane);
        it = nx; if (it >= NITEMS) break;
    }
}
__device__ __forceinline__ void p0_prologue(Frame& F, const Ptrs& P) {
    const int gw = F.vcu * NWAVES + F.wave, NGW = F.G * NWAVES;
    { float* tab = (float*)(P.ws + WS_ROPE);
      const float inv[16] = {1.000000000e+00f, 4.403665960e-01f, 1.939227432e-01f, 8.539710194e-02f, 3.760603070e-02f, 1.656044088e-02f, 7.292664610e-03f, 3.211446106e-03f,
                             1.414213562e-03f, 6.227724371e-04f, 2.742481884e-04f, 1.207697351e-04f, 5.318295734e-05f, 2.341999971e-05f, 1.031338525e-05f, 4.541670478e-06f};
      for (int pos = gw * 64 + F.lane; pos < 16384; pos += NGW * 64) {
#pragma unroll
          for (int i = 0; i < 16; ++i) { const float ang = (float)pos * inv[i]; float s, c; sincos_acc(ang, s, c); tab[(size_t)pos * 32 + i] = c; tab[(size_t)pos * 32 + 16 + i] = s; } } }
    { bf16* XB = (bf16*)(P.ws + WS_AB1); float* ss0 = (float*)(P.ws + WS_SS0);
      for (int m = gw; m < M; m += NGW) { const float* xrow = (m < M_P) ? P.xp + (size_t)m * D : P.xs + (size_t)(m - M_P) * D;
          const GAS f32x4* xr = (const GAS f32x4*)xrow + F.lane; GAS v2u* o8 = (GAS v2u*)(XB + (size_t)m * D) + F.lane; float s = 0.f;
#pragma unroll
          for (int j = 0; j < 16; ++j) { const f32x4 v = __builtin_nontemporal_load(xr + 64 * j); s += (v.x * v.x + v.y * v.y) + (v.z * v.z + v.w * v.w); v2u w; w.x = pk2(v.x, v.y); w.y = pk2(v.z, v.w); o8[64 * j] = w; }
          s = wave_sum(s); if (F.lane == 0) ss0[m] = s; } }
    cvt_run<0>(F, P, gw, NGW);
}
__device__ __forceinline__ void p4_convert_w2(Frame& F, const Ptrs& P) { cvt_run<1>(F, P, F.vcu * NWAVES + F.wave, F.G * NWAVES); }

__device__ __forceinline__ unsigned off_b(unsigned row, unsigned ch) { return 256u * row + 16u * (ch ^ (((row & 3) << 2) | ((row >> 2) & 3))); }
struct AttState2 { float m[2], l[2]; f32x4 O[2][8]; };

struct AttLane { unsigned choff[4]; };
__device__ __forceinline__ void att_lane_init(AttLane& L, int lane) {
    const unsigned i = lane & 15, g = lane >> 4;
#pragma unroll
    for (int j = 0; j < 4; ++j) L.choff[j] = 16u * (i ^ ((g << 2) | (unsigned)j));
}
__device__ __forceinline__ void k_load(bf16x8 (&kf)[2][4], const bf16* Kb, int S, int tb, int dil, int lane) {
    const int i = lane & 15, g = lane >> 4;
    const int kk_a = 8 * (i >> 2) + (i & 3);
#pragma unroll
    for (int t = 0; t < 2; ++t) { int tk = tb + dil * (kk_a + 4 * t); tk = max(0, min(tk, S - 1)); const bf16* kp = Kb + (size_t)tk * QKVW + 8 * g;
#pragma unroll
        for (int s = 0; s < 4; ++s) kf[t][s] = *(const bf16x8*)(kp + 32 * s); }
}
__device__ __forceinline__ void v_dma(LAS unsigned char* vbuf, const bf16* Vb, int S, int tb, int dil, int lane, const AttLane& L) {
    const int g = lane >> 4;
    if (tb >= 0 && tb + 31 * dil < S) {
        const char* p0 = (const char*)(Vb + (size_t)(tb + dil * g) * QKVW); const size_t rstep = (size_t)(4 * dil) * QKVW * 2;
#pragma unroll
        for (int c = 0; c < 8; ++c) __builtin_amdgcn_global_load_lds((const unsigned*)(p0 + c * rstep + L.choff[c & 3]), (LAS unsigned*)(vbuf + 1024 * c), 16, 0, 0);
    } else {
#pragma unroll
        for (int c = 0; c < 8; ++c) { int tk = tb + dil * (4 * c + g); tk = max(0, min(tk, S - 1));
            __builtin_amdgcn_global_load_lds((const unsigned*)((const char*)(Vb + (size_t)tk * QKVW) + L.choff[c & 3]), (LAS unsigned*)(vbuf + 1024 * c), 16, 0, 0); }
    }
    asm volatile("" ::: "memory");
}
template <int BUF>
__device__ __forceinline__ void kv_compute2(AttState2& st, bf16x8 (&kf)[2][4], const bf16x8 (&qf)[2][4], int S, int tb, int dil, const int (&mlo)[2], const unsigned (&mspan)[2],
                                            LAS unsigned char* vl, int lane, const AttLane& L, bool pf, const bf16* Kb, const bf16* Vb, int tbn) {
    const int g = lane >> 4;
    f32x4 sc[2][2];
#pragma unroll
    for (int q = 0; q < 2; ++q)
#pragma unroll
        for (int t = 0; t < 2; ++t) { sc[q][t] = (f32x4){0.f, 0.f, 0.f, 0.f};
#pragma unroll
            for (int s = 0; s < 4; ++s) sc[q][t] = __builtin_amdgcn_mfma_f32_16x16x32_bf16(kf[t][s], qf[q][s], sc[q][t], 0, 0, 0); }
    if (pf) v_dma(vl + (BUF ? 0 : 8192), Vb, S, tbn, dil, lane, L);
    bf16x8 pf16[2];
#pragma unroll
    for (int q = 0; q < 2; ++q) {
        const int x0 = tb + dil * 8 * g - mlo[q];
        float mx = -__builtin_inff();
#pragma unroll
        for (int t = 0; t < 2; ++t)
#pragma unroll
            for (int r = 0; r < 4; ++r) { const bool ok = (unsigned)(x0 + dil * (4 * t + r)) <= mspan[q]; sc[q][t][r] = ok ? sc[q][t][r] : -__builtin_inff(); mx = fmaxf(mx, sc[q][t][r]); }
        mx = fmaxf(mx, __shfl_xor(mx, 16)); mx = fmaxf(mx, __shfl_xor(mx, 32));
        if (__builtin_amdgcn_ballot_w64(mx > st.m[q] + 8.0f) != 0ull) {
            const float mn = fmaxf(st.m[q], mx), alpha = __builtin_amdgcn_exp2f(st.m[q] - mn);
            st.l[q] *= alpha; st.m[q] = mn;
#pragma unroll
            for (int dt = 0; dt < 8; ++dt) st.O[q][dt] *= alpha;
        }
        float ps = 0.f; float p[8];
#pragma unroll
        for (int t = 0; t < 2; ++t)
#pragma unroll
            for (int r = 0; r < 4; ++r) { p[4 * t + r] = __builtin_amdgcn_exp2f(sc[q][t][r] - st.m[q]); ps += p[4 * t + r]; }
        st.l[q] += ps;
        v4u pw; pw.x = pk2(p[0], p[1]); pw.y = pk2(p[2], p[3]); pw.z = pk2(p[4], p[5]); pw.w = pk2(p[6], p[7]);
        pf16[q] = __builtin_bit_cast(bf16x8, pw);
    }
    if (pf) asm volatile("s_waitcnt vmcnt(8)" ::: "memory"); else asm volatile("s_waitcnt vmcnt(0)" ::: "memory");
    const unsigned vb = (unsigned)(uintptr_t)vl;
#define TR4(k) asm volatile("ds_read_b64_tr_b16 %0, %4 offset:%8\n\tds_read_b64_tr_b16 %1, %5 offset:%8\n\tds_read_b64_tr_b16 %2, %6 offset:%8\n\tds_read_b64_tr_b16 %3, %7 offset:%8" \
        : "=&v"(f[k]), "=&v"(f[k + 1]), "=&v"(f[k + 2]), "=&v"(f[k + 3]) : "v"(a[k]), "v"(a[k + 1]), "v"(a[k + 2]), "v"(a[k + 3]), "i"(BUF ? 8192 : 0) : "memory")
#pragma unroll
    for (int hf = 0; hf < 2; ++hf) {
        unsigned a[8]; s16x4 f[8];
        int ln = lane; asm volatile("" : "+v"(ln));
        const unsigned g2 = ln >> 4, q2 = (ln & 15) >> 2, pp = ln & 3;
#pragma unroll
        for (int k = 0; k < 4; ++k) { const int dt = 4 * hf + k; a[2 * k] = vb + off_b(8 * g2 + q2, 2 * dt + (pp >> 1)) + 8 * (pp & 1); a[2 * k + 1] = vb + off_b(8 * g2 + 4 + q2, 2 * dt + (pp >> 1)) + 8 * (pp & 1); }
        TR4(0); TR4(4);
        asm volatile("s_waitcnt lgkmcnt(0)" : "+v"(f[0]), "+v"(f[1]), "+v"(f[2]), "+v"(f[3]), "+v"(f[4]), "+v"(f[5]), "+v"(f[6]), "+v"(f[7]) :: "memory");
#pragma unroll
        for (int k = 0; k < 4; ++k) { const int dt = 4 * hf + k;
            const bf16x8 vf = __builtin_shufflevector(f[2 * k], f[2 * k + 1], 0, 1, 2, 3, 4, 5, 6, 7);
            st.O[0][dt] = __builtin_amdgcn_mfma_f32_16x16x32_bf16(vf, pf16[0], st.O[0][dt], 0, 0, 0);
            st.O[1][dt] = __builtin_amdgcn_mfma_f32_16x16x32_bf16(vf, pf16[1], st.O[1][dt], 0, 0, 0); }
    }
#undef TR4
    if (pf) { asm volatile("" ::: "memory"); k_load(kf, Kb, S, tbn, dil, lane); }
}
__device__ __forceinline__ void attn_keys2(AttState2& st, const bf16x8 (&qf)[2][4], const bf16* Kb, const bf16* Vb, int S, const int (&tq)[2], int kstart, int dil, int ntiles, int W,
                                           LAS unsigned char* vl, int lane, const AttLane& L) {
    bf16x8 kf[2][4]; const int tstep = 32 * dil;
    int mlo[2]; unsigned mspan[2];
#pragma unroll
    for (int q = 0; q < 2; ++q) { mlo[q] = max(tq[q] - W, 0); mspan[q] = (unsigned)(min(tq[q] + W, S - 1) - mlo[q]); }
    v_dma(vl, Vb, S, kstart, dil, lane, L); k_load(kf, Kb, S, kstart, dil, lane);
    for (int tile = 0; tile < ntiles; tile += 2) {
        const int tb = kstart + tile * tstep;
        const bool m1 = tile + 1 < ntiles;
        kv_compute2<0>(st, kf, qf, S, tb, dil, mlo, mspan, vl, lane, L, m1, Kb, Vb, tb + tstep);
        if (!m1) break;
        const bool m2 = tile + 2 < ntiles;
        kv_compute2<1>(st, kf, qf, S, tb + tstep, dil, mlo, mspan, vl, lane, L, m2, Kb, Vb, tb + 2 * tstep);
    }
}

template <int HALFW> __device__ __forceinline__ void attn_phase(Frame& F, const Ptrs& P) {
    if (HALFW && F.wave >= 4) return;
    const bf16* QKV = (const bf16*)(P.ws + WS_QKV); bf16* YAB = (bf16*)P.out;
    LAS unsigned char* vl = F.lds + RING_OFF + F.wave * 16384;
    const int gw = HALFW ? F.vcu * 4 + F.wave : F.vcu * NWAVES + F.wave, NGW = HALFW ? F.G * 4 : F.G * NWAVES, lane = F.lane, i = lane & 15, g = lane >> 4;
    AttLane AL; att_lane_init(AL, lane);
    { constexpr int NT = (M / 512) * 8 * 16;
      for (int id = gw; id < NT; id += NGW) {
          const int r16 = id & 15, h = (id >> 4) & 7, rb = id >> 7;
          const int row_blk = rb * 512; const int seq0 = row_blk < 4096 ? 0 : (row_blk < 8192 ? 4096 : 8192); const int S = row_blk < 8192 ? 4096 : 16384;
          const int t0 = row_blk - seq0 + r16; const int tq[2] = {t0 + 16 * i, t0 + 256 + 16 * i};
          AttState2 st;
#pragma unroll
          for (int q = 0; q < 2; ++q) { st.m[q] = -1e30f; st.l[q] = 0.f;
#pragma unroll
              for (int dt = 0; dt < 8; ++dt) st.O[q][dt] = (f32x4){0.f, 0.f, 0.f, 0.f}; }
          const bf16* seqbase = QKV + (size_t)seq0 * QKVW;
#pragma unroll 1
          for (int grp = 0; grp < 3; ++grp) {
              const int dil = grp == 0 ? 1 : (grp == 1 ? 4 : 16); const int ntiles = grp == 0 ? 20 : (grp == 1 ? 8 : 5);
              const int hc = grp * 1024 + h * 128;
              bf16x8 qf[2][4];
#pragma unroll
              for (int q = 0; q < 2; ++q) { const bf16* qp = seqbase + (size_t)tq[q] * QKVW + hc + 8 * g;
#pragma unroll
                  for (int s = 0; s < 4; ++s) qf[q][s] = *(const bf16x8*)(qp + 32 * s); }
              attn_keys2(st, qf, seqbase + 3072 + hc, seqbase + 6144 + hc, S, tq, t0 - 64 * dil, dil, ntiles, 64 * dil, vl, lane, AL);
          }
#pragma unroll
          for (int q = 0; q < 2; ++q) { float l = st.l[q]; l += __shfl_xor(l, 16); l += __shfl_xor(l, 32); const float rl = 1.0f / l;
              bf16* op = YAB + (size_t)(seq0 + tq[q]) * YABW + h * 128 + 4 * g;
#pragma unroll
              for (int dt = 0; dt < 8; ++dt) { const f32x4 o = st.O[q][dt] * rl; v2u w; w.x = pk2(o[0], o[1]); w.y = pk2(o[2], o[3]); *(v2u*)(op + 16 * dt) = w; } }
      } }
    { constexpr int NT = (M / 16) * 8;
      for (int id = gw; id < NT; id += NGW) {
          const int pair = id & 7, blk = id >> 3; const int row0 = blk * 16;
          const int seq0 = row0 < 4096 ? 0 : (row0 < 8192 ? 4096 : 8192); const int S = row0 < 8192 ? 4096 : 16384;
          const int t0 = row0 - seq0; const int tq[2] = {t0 + i, t0 + i};
          AttState2 st;
#pragma unroll
          for (int q = 0; q < 2; ++q) { st.m[q] = -1e30f; st.l[q] = 0.f;
#pragma unroll
              for (int dt = 0; dt < 8; ++dt) st.O[q][dt] = (f32x4){0.f, 0.f, 0.f, 0.f}; }
          const bf16* seqbase = QKV + (size_t)seq0 * QKVW; const int kvh = pair >> 1;
          bf16x8 qf[2][4];
#pragma unroll
          for (int q = 0; q < 2; ++q) { const bf16* qp = seqbase + (size_t)tq[q] * QKVW + 9216 + (2 * pair + q) * 128 + 8 * g;
#pragma unroll
              for (int s = 0; s < 4; ++s) qf[q][s] = *(const bf16x8*)(qp + 32 * s); }
          attn_keys2(st, qf, seqbase + 11264 + kvh * 128, seqbase + 11776 + kvh * 128, S, tq, t0 - 128, 1, 9, 128, vl, lane, AL);
#pragma unroll
          for (int q = 0; q < 2; ++q) { const int qh = 2 * pair + q; float l = st.l[q]; l += __shfl_xor(l, 16); l += __shfl_xor(l, 32);
              const float sk = P.sink[qh] * 1.4426950408889634f; const float m2 = fmaxf(st.m[q], sk); const float e1 = __builtin_amdgcn_exp2f(st.m[q] - m2);
              const float den = l * e1 + __builtin_amdgcn_exp2f(sk - m2); const float rl = e1 / den;
              bf16* op = YAB + (size_t)(seq0 + tq[q]) * YABW + 1024 + qh * 128 + 4 * g;
#pragma unroll
              for (int dt = 0; dt < 8; ++dt) { const f32x4 o = st.O[q][dt] * rl; v2u w; w.x = pk2(o[0], o[1]); w.y = pk2(o[2], o[3]); *(v2u*)(op + 16 * dt) = w; } }
      } }
}

__device__ __forceinline__ void final_norm(Frame& F, const Ptrs& P) {
    const int gw = F.vcu * NWAVES + F.wave, NGW = F.G * NWAVES; const float* ss3 = (const float*)(F.ctl + CW_SS3); const bf16* H3 = (const bf16*)(P.ws + WS_AB1);
    f32x4 gv[8][2];
#pragma unroll
    for (int j = 0; j < 8; ++j) { gv[j][0] = ((const f32x4*)P.gfin)[2 * (F.lane + 64 * j)]; gv[j][1] = ((const f32x4*)P.gfin)[2 * (F.lane + 64 * j) + 1]; }
    for (int m = gw; m < M; m += NGW) { const float rs = __builtin_amdgcn_rsqf(ss3[m] * (1.0f / 4096.0f) + 1e-6f);
        const GAS v4u* hi = (const GAS v4u*)(H3 + (size_t)m * D) + F.lane; GAS f32x4* o = (GAS f32x4*)(P.out + (size_t)m * D) + 2 * F.lane;
#pragma unroll
        for (int j = 0; j < 8; ++j) { const v4u w = hi[64 * j];
            const f32x4 v0 = {pg8::bf_lo(w.x), pg8::bf_hi(w.x), pg8::bf_lo(w.y), pg8::bf_hi(w.y)}, v1 = {pg8::bf_lo(w.z), pg8::bf_hi(w.z), pg8::bf_lo(w.w), pg8::bf_hi(w.w)};
            o[128 * j] = v0 * rs * gv[j][0]; o[128 * j + 1] = v1 * rs * gv[j][1]; } }
}

struct Args { const float* in[17]; float* out; unsigned char* ws; int ph_lo, ph_hi, li, pad; };
__global__ void __launch_bounds__(NWAVES * 64, 2) mk_fwd(Args args) {
    extern __shared__ __attribute__((aligned(16))) unsigned char lds[];
    Frame F;
    F.lds = (LAS unsigned char*)lds;
    F.MISC = (volatile LAS unsigned*)(F.lds + MISC_OFF);
    F.tid = threadIdx.x; F.lane = F.tid & 63; F.wave = __builtin_amdgcn_readfirstlane(F.tid >> 6);
    F.G = gridDim.x; { const int bx = blockIdx.x; F.vcu = (F.G % 8 == 0) ? (bx % 8) * (F.G / 8) + bx / 8 : bx; }
    unsigned char* ws = args.ws;
    F.ctl = (gu32*)(ws + WS_CTL);
    Ptrs P;
    P.xp = args.in[0]; P.xs = args.in[1]; P.g1 = args.in[2]; P.w1g = args.in[3]; P.w1u = args.in[4]; P.w1d = args.in[5]; P.gmix = args.in[6]; P.win = args.in[7]; P.sink = args.in[8];
    P.wa = args.in[9]; P.wb = args.in[10]; P.wout = args.in[11]; P.g2 = args.in[12]; P.w2g = args.in[13]; P.w2u = args.in[14]; P.w2d = args.in[15]; P.gfin = args.in[16];
    P.out = args.out; P.ws = ws;
    for (int u = F.tid; u < (LDS_BYTES - LDSCTL_OFF) / 4; u += NWAVES * 64) ((LAS unsigned*)(F.lds + LDSCTL_OFF))[u] = 0u;
    __syncthreads();
    XcdBarrier bar; bar.bar = (unsigned*)(F.ctl + CW_BAR); bar.x = 0; bar.st = nullptr;
    if (N_LAUNCHES != PER_PHASE) bar = xcd_barrier_post((unsigned*)(F.ctl + CW_BAR), F.MISC + 8);
#define GRID_BAR(seam) do { if (N_LAUNCHES != PER_PHASE) xcd_barrier(bar); } while (0)
    const int lo = args.ph_lo, hi = args.ph_hi;
#define IN(k) (lo <= (k) && (k) < hi)
#define BOTH(k) (IN(k) && IN((k) + 1))
    bf16* AB1 = (bf16*)(ws + WS_AB1); bf16* ACT = (bf16*)(ws + WS_ACT); bf16* QKVB = (bf16*)(ws + WS_QKV);
    bf16* WGU = (bf16*)(ws + WS_WGU); bf16* WDN = (bf16*)(ws + WS_WD); bf16* WIN = (bf16*)(ws + WS_WIN); bf16* WAB = (bf16*)(ws + WS_WAB); bf16* WOUT = (bf16*)(ws + WS_WOUT);
    float* ss0 = (float*)(ws + WS_SS0); float* ss1 = (float*)(F.ctl + CW_SS1); float* ss2 = (float*)(F.ctl + CW_SS2); float* ss3 = (float*)(F.ctl + CW_SS3);
    const float* rope = (const float*)(ws + WS_ROPE);

    if (IN(0)) { for (int rep = 0; rep < NREP(0); ++rep) p0_prologue(F, P); if (BOTH(0)) GRID_BAR(0); }
    if (IN(1)) { pg8::Gemm g{AB1, WGU, M, 2 * FF, D}; pg8::StaticOrder S; S.init(M, 2 * FF, F.G, (int)blockIdx.x, WGM_UP);
        pg8::EpiSwiglu E{ACT, FF, ss0, F.lds + SSL_OFF};
        for (int rep = 0; rep < NREP(1); ++rep)
        pg8::gemm_phase<pg8::EpiSwiglu, pg8::StaticOrder, PG8_ALIGN, PG8_SP2>(F.lds + RING_OFF, g, S, E);
        {
          const int nwg = (M / 256) * (2 * FF / 256), rem = nwg % F.G, c = (int)blockIdx.x;
          if (rem == 0) cvt_run<2>(F, P, c * NWAVES + F.wave, F.G * NWAVES);
          else if (c >= rem) cvt_run<2>(F, P, (c - rem) * NWAVES + F.wave, (F.G - rem) * NWAVES); }
        if (PROBE_REPEAT == 21) { pg8::FixedOrder S2; S2.init(M, 2 * FF, F.G, (int)blockIdx.x); pg8::EpiSwiglu E2{QKVB, FF, ss0, F.lds + SSL_OFF};
            pg8::gemm_phase<pg8::EpiSwiglu, pg8::FixedOrder, PG8_ALIGN, PG8_SP2>(F.lds + RING_OFF, g, S2, E2); }
        if (BOTH(1)) GRID_BAR(1); }
    if (IN(2) && PROBE_REPEAT >= 100 && PROBE_REPEAT < 104) {
        pg8::Gemm g{AB1, WGU, M, 2 * FF, D}; pg8::StaticOrder S; S.init(M, 2 * FF, F.G, (int)blockIdx.x, WGM_UP);
        pg8::EpiSwigluT<(PROBE_REPEAT >= 100 ? PROBE_REPEAT - 100 : 0)> E{QKVB, FF, ss0, F.lds + SSL_OFF};
        pg8::gemm_phase<pg8::EpiSwigluT<(PROBE_REPEAT >= 100 ? PROBE_REPEAT - 100 : 0)>, pg8::StaticOrder, PG8_ALIGN, PG8_SP2>(F.lds + RING_OFF, g, S, E);
        GRID_BAR(1); }
    if (IN(2)) { if (STAGGER_TICKS) xcd_stagger(STAGGER_TICKS); pg8::Gemm g{ACT, WDN, M, D, FF}; pg8::StaticOrder S; S.init(M, D, F.G, (int)blockIdx.x, WGM_DOWN);
        pg8::EpiResid<true, false, true, true> E{AB1, AB1, M, nullptr, AB1, ss1, 0.5f};
        pg8::gemm_phase<pg8::EpiResid<true, false, true, true>, pg8::StaticOrder, PG8_ALIGN, PG8_SP2>(F.lds + RING_OFF, g, S, E);
        if (BOTH(2)) GRID_BAR(2); }
    if (IN(3)) { pg8::Gemm g{AB1, WIN, M, NIN, D}; pg8::StaticOrder S; S.init(M, NIN, F.G, (int)blockIdx.x, WGM_IN);
        pg8::EpiProj E{QKVB, ACT, ss1, rope, F.lds + SSL_OFF};
        pg8::gemm_phase<pg8::EpiProj, pg8::StaticOrder, PG8_ALIGN, PG8_SP2>(F.lds + RING_OFF, g, S, E);
        if (NREP(3) == 2) pg8::gemm_phase<pg8::EpiProj, pg8::StaticOrder, PG8_ALIGN, PG8_SP2>(F.lds + RING_OFF, g, S, E);
        if (BOTH(3)) GRID_BAR(3); }
    if (IN(4)) { for (int rep = 0; rep < NREP(4); ++rep) attn_phase<(PROBE_REPEAT == 42) ? 1 : 0>(F, P); for (int rep = 0; rep < NREP(14); ++rep) p4_convert_w2(F, P); if (BOTH(4)) GRID_BAR(4); }
    if (IN(5)) { pg8::Gemm g{(const bf16*)P.out, WAB, M, D, YABW}; pg8::StaticOrder S; S.init(M, D, F.G, (int)blockIdx.x, WGM_DOWN);
        pg8::EpiMerge E{ACT, QKVB};
        for (int rep = 0; rep < NREP(5); ++rep)
        pg8::gemm_phase<pg8::EpiMerge, pg8::StaticOrder, PG8_ALIGN, PG8_SP2>(F.lds + RING_OFF, g, S, E);
        if (BOTH(5)) GRID_BAR(5); }
    if (IN(6)) { if (STAGGER_TICKS) xcd_stagger(STAGGER_TICKS); pg8::Gemm g{QKVB, WOUT, M, D, D}; pg8::StaticOrder S; S.init(M, D, F.G, (int)blockIdx.x, WGM_DOWN);
        pg8::EpiResid<true, false, true, true> E{AB1, AB1, M, nullptr, AB1, ss2, 1.0f};
        pg8::gemm_phase<pg8::EpiResid<true, false, true, true>, pg8::StaticOrder, PG8_ALIGN, PG8_SP2>(F.lds + RING_OFF, g, S, E);
        if (BOTH(6)) GRID_BAR(6); }
    if (IN(7)) { pg8::Gemm g{AB1, WGU, M, 2 * FF, D}; pg8::StaticOrder S; S.init(M, 2 * FF, F.G, (int)blockIdx.x, WGM_UP);
        pg8::EpiSwiglu E{ACT, FF, ss2, F.lds + SSL_OFF};
        pg8::gemm_phase<pg8::EpiSwiglu, pg8::StaticOrder, PG8_ALIGN, PG8_SP2>(F.lds + RING_OFF, g, S, E);
        {
          const int nwg = (M / 256) * (2 * FF / 256), rem = nwg % F.G, c = (int)blockIdx.x;
          if (rem == 0) cvt_run<3>(F, P, c * NWAVES + F.wave, F.G * NWAVES);
          else if (c >= rem) cvt_run<3>(F, P, (c - rem) * NWAVES + F.wave, (F.G - rem) * NWAVES); }
        if (BOTH(7)) GRID_BAR(7); }
    if (IN(8)) { if (STAGGER_TICKS) xcd_stagger(STAGGER_TICKS); pg8::Gemm g{ACT, WDN, M, D, FF}; pg8::StaticOrder S; S.init(M, D, F.G, (int)blockIdx.x, WGM_DOWN);
        pg8::EpiResid<true, false, true, true> E{AB1, AB1, M, nullptr, AB1, ss3, 0.5f};
        pg8::gemm_phase<pg8::EpiResid<true, false, true, true>, pg8::StaticOrder, PG8_ALIGN, PG8_SP2>(F.lds + RING_OFF, g, S, E);
        if (BOTH(8)) GRID_BAR(8); }
    if (IN(9)) { final_norm(F, P); }
#undef IN
#undef BOTH
#undef GRID_BAR
}

extern "C" void kernel_launch(void* const* d_in, const int* in_sizes, int n_in, void* d_out, int out_size, void* d_ws, size_t ws_size, hipStream_t stream) {
    static int grid = 0;
    if (grid == 0) {
        if (n_in != 17 || out_size != M * D || ws_size < WS_END) { fprintf(stderr, "kernel_launch: unexpected shapes (n_in %d, out %d, ws %zu, need %zu)\n", n_in, out_size, ws_size, (size_t)WS_END); grid = -1; return; }
        int dev = 0, cus = 0, per_cu = 0;
        if (hipGetDevice(&dev) != hipSuccess || hipDeviceGetAttribute(&cus, hipDeviceAttributeMultiprocessorCount, dev) != hipSuccess) { grid = -1; return; }
        if (hipFuncSetAttribute((const void*)mk_fwd, hipFuncAttributeMaxDynamicSharedMemorySize, LDS_BYTES) != hipSuccess) { fprintf(stderr, "kernel_launch: hipFuncSetAttribute failed\n"); grid = -1; return; }
        if (hipOccupancyMaxActiveBlocksPerMultiprocessor(&per_cu, (const void*)mk_fwd, NWAVES * 64, LDS_BYTES) != hipSuccess || per_cu < 1) { fprintf(stderr, "kernel_launch: occupancy query says %d\n", per_cu); }
        (void)hipGetLastError();
        grid = cus;
    }
    if (grid < 0) return;
    (void)hipMemsetAsync((char*)d_ws + WS_CTL, 0, CTL_ZERO_BYTES, stream);
    Args a{};
    for (int i = 0; i < 17; ++i) a.in[i] = (const float*)d_in[i];
    a.out = (float*)d_out; a.ws = (unsigned char*)d_ws; a.pad = 0;
    for (int li = 0; li < N_LAUNCHES; ++li) {
        a.ph_lo = (N_LAUNCHES == PER_PHASE) ? li : 0; a.ph_hi = (N_LAUNCHES == PER_PHASE) ? li + 1 : PER_PHASE; a.li = li;
        hipLaunchKernelGGL(mk_fwd, dim3(grid), dim3(NWAVES * 64), LDS_BYTES, stream, a);
    }
}
```

```cpp
#include <hip/hip_runtime.h>
#include <cstdio>
#include <cstdint>

#ifndef MK_N_LAUNCHES
#define MK_N_LAUNCHES 1
#endif
#ifndef PROBE_REPEAT
#define PROBE_REPEAT -1
#endif
#define NREP(k) ((PROBE_REPEAT == (k)) ? 2 : 1)
#ifndef WGM_DOWN
#define WGM_DOWN 4
#endif
#ifndef WGM_UP
#define WGM_UP 8
#endif
#ifndef WGM_IN
#define WGM_IN 8
#endif
#ifndef RES_DEPTH
#define RES_DEPTH 8
#endif
#ifndef RES_DEPTH_F
#define RES_DEPTH_F 4
#endif
#ifndef STAGGER_TICKS
#define STAGGER_TICKS 0
#endif

namespace pg8 {
#define PG8_LAS __attribute__((address_space(3)))
typedef unsigned short bf16_t;
typedef short bf16x8 __attribute__((ext_vector_type(8)));
typedef float f32x4 __attribute__((ext_vector_type(4)));
typedef unsigned u32x4 __attribute__((ext_vector_type(4)));
constexpr int BM = 256, BK = 64, HALF = 128, HTB = HALF * BK * 2, STAGE_BYTES = 8 * HTB, NXCD = 8, WGM = 8;

__host__ __device__ __forceinline__ int lds_byte(int r, int c) { const int st = (r >> 4) * 2 + (c >> 5), rr = r & 15, cc = c & 31, ob = rr * 64 + cc * 2; return st * 1024 + (ob ^ (((ob >> 9) & 1) << 5)); }
__host__ __device__ __forceinline__ void stage_rc(int b, int& R, int& C) { const int st = b / 1024, sb = b % 1024, swz = sb ^ (((sb >> 9) & 1) << 5); R = (st >> 1) * 16 + swz / 64; C = (st & 1) * 32 + (swz % 64) / 2; }
__host__ __device__ __forceinline__ int perm32(int rho) { const int n = rho >> 4, i = rho & 15; return 8 * (i >> 2) + 4 * n + (i & 3); }

struct Unit { int pm, pn; };
__device__ __forceinline__ void ss_prefetch(const float* ss, PG8_LAS unsigned char* ssl, int pm, int wid, int lane) {
    const float* src = ss + pm * 256 + (wid >> 2) * 64 + lane;
    __builtin_amdgcn_global_load_lds((const unsigned*)src, (PG8_LAS unsigned*)(ssl + wid * 512), 4, 0, 0);
    __builtin_amdgcn_global_load_lds((const unsigned*)(src + 128), (PG8_LAS unsigned*)(ssl + wid * 512 + 256), 4, 0, 0);
}
__device__ __forceinline__ float ss_lds(PG8_LAS unsigned char* ssl, int wr, int wc, int fr, int ai, int m) { return *(const PG8_LAS float*)(ssl + (wr * 4 + wc) * 512 + ai * 256 + (m * 16 + fr) * 4); }
struct Gemm { const bf16_t* A; const bf16_t* Bt; int M, N, K; };

struct StaticOrder {
    int nM, nN, nwg, G, c, wgm;
    __host__ __device__ void init(int M, int N, int G_, int c_, int wgm_ = WGM) { nM = M / BM; nN = N / BM; nwg = nM * nN; G = G_; c = c_; wgm = wgm_; }
    __host__ __device__ bool next(int i, Unit& u) const {
        const long L = (long)i * G + c; if (L >= nwg) return false;
        int wgid = (int)L; { const int q = nwg / NXCD, r = nwg % NXCD, xcd = wgid % NXCD, off = wgid / NXCD; wgid = (xcd < r ? xcd * (q + 1) : r * (q + 1) + (xcd - r) * q) + off; }
        const int nig = wgm * nN, gid = wgid / nig, fm = gid * wgm, gsz = (nM - fm) < wgm ? (nM - fm) : wgm;
        u.pm = fm + ((wgid % nig) % gsz); u.pn = (wgid % nig) / gsz; return true;
    }
    __device__ __forceinline__ void a_ready(const Unit&) const {}
    __device__ __forceinline__ void done(const Unit&) const {}
};

struct FixedOrder : StaticOrder {
    __host__ __device__ bool next(int i, Unit& u) const { Unit t; if (!StaticOrder::next(i, t)) return false; u.pm = 0; u.pn = 0; return true; }
};
__device__ __forceinline__ unsigned cvt_pk_bf16(float lo, float hi) { unsigned r; asm volatile("v_cvt_pk_bf16_f32 %0, %1, %2" : "=v"(r) : "v"(lo), "v"(hi)); return r; }
__device__ __forceinline__ float bf_lo(unsigned w) { return __uint_as_float(w << 16); }
__device__ __forceinline__ float bf_hi(unsigned w) { return __uint_as_float(w & 0xffff0000u); }
__device__ __forceinline__ float sigmoid_f(float x) { return __builtin_amdgcn_rcpf(1.0f + __builtin_amdgcn_exp2f(-1.44269504089f * x)); }

__device__ __forceinline__ unsigned ror8(unsigned x) { return (unsigned)__builtin_amdgcn_mov_dpp((int)x, 0x128, 0xf, 0xf, true); }
__device__ __forceinline__ u32x4 ror8(const u32x4 v) { u32x4 r; r.x = ror8(v.x); r.y = ror8(v.y); r.z = ror8(v.z); r.w = ror8(v.w); return r; }
__device__ __forceinline__ u32x4 sel4(bool c, const u32x4 a, const u32x4 b) { u32x4 r; r.x = c ? a.x : b.x; r.y = c ? a.y : b.y; r.z = c ? a.z : b.z; r.w = c ? a.w : b.w; return r; }
__device__ __forceinline__ void pair_to_lines(const u32x4 X, const u32x4 Y, bool lo8, u32x4& D1, u32x4& D2) { D1 = sel4(lo8, X, ror8(Y)); D2 = sel4(lo8, ror8(X), Y); }
__device__ __forceinline__ void lines_to_pair(const u32x4 L1, const u32x4 L2, bool lo8, u32x4& X, u32x4& Y) { X = sel4(lo8, L1, ror8(L2)); Y = sel4(lo8, ror8(L1), L2); }


template <int MODE> struct EpiSwigluT {
    static constexpr bool PERM = true, AFTER_DRAIN = false, HAS_MID = false, SS_LDS = true, ADJ = false; static constexpr int MID_T = 0, VM_TAIL = (MODE & 1) ? 0 : 8;
    bf16_t* O; int ldc; const float* ss; PG8_LAS unsigned char* ssl;
    __device__ __forceinline__ void mid(f32x4 (&)[2][2][4][2], const Unit&, int, int, int, int) const {}
    __device__ __forceinline__ void operator()(f32x4 (&acc)[2][2][4][2], const Unit& u, int wr, int wc, int fr, int fq) const {
        const int row0 = u.pm * BM + wr * 64 + fr, col0 = u.pn * HALF + wc * 32 + 8 * fq;
        float rs[2][4];
#pragma unroll
        for (int ai = 0; ai < 2; ++ai)
#pragma unroll
            for (int m = 0; m < 4; ++m) rs[ai][m] = (MODE & 2) ? 4096.0f * (float)(fr + 1) : ss_lds(ssl, wr, wc, fr, ai, m);
#pragma unroll
        for (int ai = 0; ai < 2; ++ai)
#pragma unroll
            for (int m = 0; m < 4; ++m) { const int r = row0 + ai * HALF + m * 16; const float rr = __builtin_amdgcn_rsqf(rs[ai][m] * (1.0f / 4096.0f) + 1e-6f);
                const float c1 = -1.44269504089f * rr, rr2 = rr * rr; f32x4 o[2];
#pragma unroll
                for (int n = 0; n < 2; ++n) { const f32x4 g = acc[ai][0][m][n], up = acc[ai][1][m][n]; const f32x4 t = g * c1;
                    f32x4 d = {__builtin_amdgcn_exp2f(t[0]), __builtin_amdgcn_exp2f(t[1]), __builtin_amdgcn_exp2f(t[2]), __builtin_amdgcn_exp2f(t[3])}; d = d + 1.0f;
                    const f32x4 q = {__builtin_amdgcn_rcpf(d[0]), __builtin_amdgcn_rcpf(d[1]), __builtin_amdgcn_rcpf(d[2]), __builtin_amdgcn_rcpf(d[3])};
                    o[n] = ((g * up) * rr2) * q; }
                u32x4 w; w.x = cvt_pk_bf16(o[0][0], o[0][1]); w.y = cvt_pk_bf16(o[0][2], o[0][3]); w.z = cvt_pk_bf16(o[1][0], o[1][1]); w.w = cvt_pk_bf16(o[1][2], o[1][3]);
                if (MODE & 1) asm volatile("" :: "v"(w.x), "v"(w.y), "v"(w.z), "v"(w.w)); else *(u32x4*)(O + (size_t)r * ldc + col0) = w; }
    }
};
using EpiSwiglu = EpiSwigluT<0>;

template <bool BASE_BF16, bool OUT_F32, bool HAS_OB, bool ADJ_ = false> struct EpiResid {
    static constexpr bool PERM = true, AFTER_DRAIN = false, HAS_MID = false, SS_LDS = false, ADJ = ADJ_; static constexpr int MID_T = 0, VM_TAIL = (HAS_OB || OUT_F32) ? 16 : 0;
    const void* base_lo; const void* base_hi; int split_row; float* out; bf16_t* ob; float* ss; float scale;
    __device__ __forceinline__ void mid(f32x4 (&)[2][2][4][2], const Unit&, int, int, int, int) const {}
    __device__ __forceinline__ void operator()(f32x4 (&acc)[2][2][4][2], const Unit& u, int wr, int wc, int fr, int fq) const {
        if constexpr (ADJ_) {
            static_assert(BASE_BF16 && HAS_OB && !OUT_F32, "ADJ residual epilogue: bf16 base, bf16 output");
            const bool lo8 = fr < 8; const int rb = u.pm * BM + wr * 64, row0 = rb + fr;
            const size_t lane_off = (size_t)(rb + (fr & 7)) * 4096 + u.pn * BM + wc * 64 + 32 * (fr >> 3) + 8 * fq;
            const bf16_t* bb = (const bf16_t*)((u.pm * BM < split_row) ? base_lo : base_hi) - ((u.pm * BM < split_row) ? (size_t)0 : (size_t)split_row * 4096);
            u32x4 tb[8][2];
#pragma unroll
            for (int k = 0; k < 8; ++k) { const size_t o_ = lane_off + (size_t)((k >> 2) * HALF + (k & 3) * 16) * 4096; tb[k][0] = *(const u32x4*)(bb + o_); tb[k][1] = *(const u32x4*)(bb + o_ + 8 * 4096); }
#pragma unroll
            for (int k = 0; k < 8; ++k) { const int ai = k >> 2, m = k & 3; u32x4 w[2]; lines_to_pair(tb[k][0], tb[k][1], lo8, w[0], w[1]);
#pragma unroll
                for (int bj = 0; bj < 2; ++bj) {
                    acc[ai][bj][m][0] = (f32x4){bf_lo(w[bj].x), bf_hi(w[bj].x), bf_lo(w[bj].y), bf_hi(w[bj].y)} + acc[ai][bj][m][0] * scale;
                    acc[ai][bj][m][1] = (f32x4){bf_lo(w[bj].z), bf_hi(w[bj].z), bf_lo(w[bj].w), bf_hi(w[bj].w)} + acc[ai][bj][m][1] * scale; }
                asm volatile("" : "+v"(acc[ai][0][m][0]), "+v"(acc[ai][0][m][1]), "+v"(acc[ai][1][m][0]), "+v"(acc[ai][1][m][1]));
                __builtin_amdgcn_sched_barrier(0); }
#pragma unroll
            for (int k = 0; k < 8; ++k) { const int ai = k >> 2, m = k & 3; const int r = row0 + ai * HALF + m * 16; float sq = 0.f; u32x4 w[2];
#pragma unroll
                for (int bj = 0; bj < 2; ++bj) { const f32x4 v0 = acc[ai][bj][m][0], v1 = acc[ai][bj][m][1];
                    sq += (v0[0] * v0[0] + v0[1] * v0[1]) + (v0[2] * v0[2] + v0[3] * v0[3]) + (v1[0] * v1[0] + v1[1] * v1[1]) + (v1[2] * v1[2] + v1[3] * v1[3]);
                    w[bj].x = cvt_pk_bf16(v0[0], v0[1]); w[bj].y = cvt_pk_bf16(v0[2], v0[3]); w[bj].z = cvt_pk_bf16(v1[0], v1[1]); w[bj].w = cvt_pk_bf16(v1[2], v1[3]); }
                u32x4 d1, d2; pair_to_lines(w[0], w[1], lo8, d1, d2);
                const size_t o_ = lane_off + (size_t)(ai * HALF + m * 16) * 4096; *(u32x4*)(ob + o_) = d1; *(u32x4*)(ob + o_ + 8 * 4096) = d2;
                sq += __shfl_xor(sq, 16); sq += __shfl_xor(sq, 32);
                if (fq == 0) __hip_atomic_fetch_add(ss + r, sq, __ATOMIC_RELAXED, __HIP_MEMORY_SCOPE_AGENT); }
            return;
        }
        const int row0 = u.pm * BM + wr * 64 + fr, col0 = u.pn * BM + wc * 32 + 8 * fq;
        if constexpr (BASE_BF16) {
            const bf16_t* bb = (const bf16_t*)((u.pm * BM < split_row) ? base_lo : base_hi) - ((u.pm * BM < split_row) ? (size_t)0 : (size_t)split_row * 4096);
            u32x4 tb[RES_DEPTH][2];
#define RES_LOAD(k) do { const size_t off_ = (size_t)(row0 + ((k) >> 2) * HALF + ((k) & 3) * 16) * 4096 + col0; \
                tb[(k) % RES_DEPTH][0] = *(const u32x4*)(bb + off_); tb[(k) % RES_DEPTH][1] = *(const u32x4*)(bb + off_ + HALF); } while (0)
#pragma unroll
            for (int k = 0; k < RES_DEPTH - 1; ++k) RES_LOAD(k);
#pragma unroll
            for (int k = 0; k < 8; ++k) { const int ai = k >> 2, m = k & 3;
                if (k + RES_DEPTH - 1 < 8) RES_LOAD(k + RES_DEPTH - 1);
#pragma unroll
                for (int bj = 0; bj < 2; ++bj) { const u32x4 w = tb[k % RES_DEPTH][bj];
                    acc[ai][bj][m][0] = (f32x4){bf_lo(w.x), bf_hi(w.x), bf_lo(w.y), bf_hi(w.y)} + acc[ai][bj][m][0] * scale;
                    acc[ai][bj][m][1] = (f32x4){bf_lo(w.z), bf_hi(w.z), bf_lo(w.w), bf_hi(w.w)} + acc[ai][bj][m][1] * scale; }
                asm volatile("" : "+v"(acc[ai][0][m][0]), "+v"(acc[ai][0][m][1]), "+v"(acc[ai][1][m][0]), "+v"(acc[ai][1][m][1]));
                __builtin_amdgcn_sched_barrier(0); }
#undef RES_LOAD
        } else {
            const float* bb = (const float*)((u.pm * BM < split_row) ? base_lo : base_hi) - ((u.pm * BM < split_row) ? (size_t)0 : (size_t)split_row * 4096);
            f32x4 tb[RES_DEPTH_F][4];
#define RES_LOAD(k) do { const size_t off_ = (size_t)(row0 + ((k) >> 2) * HALF + ((k) & 3) * 16) * 4096 + col0; \
                tb[(k) % RES_DEPTH_F][0] = __builtin_nontemporal_load((const f32x4*)(bb + off_)); tb[(k) % RES_DEPTH_F][1] = __builtin_nontemporal_load((const f32x4*)(bb + off_ + 4)); tb[(k) % RES_DEPTH_F][2] = __builtin_nontemporal_load((const f32x4*)(bb + off_ + HALF)); tb[(k) % RES_DEPTH_F][3] = __builtin_nontemporal_load((const f32x4*)(bb + off_ + HALF + 4)); } while (0)
#pragma unroll
            for (int k = 0; k < RES_DEPTH_F - 1; ++k) RES_LOAD(k);
#pragma unroll
            for (int k = 0; k < 8; ++k) { const int ai = k >> 2, m = k & 3;
                if (k + RES_DEPTH_F - 1 < 8) RES_LOAD(k + RES_DEPTH_F - 1);
                acc[ai][0][m][0] = tb[k % RES_DEPTH_F][0] + acc[ai][0][m][0] * scale; acc[ai][0][m][1] = tb[k % RES_DEPTH_F][1] + acc[ai][0][m][1] * scale;
                acc[ai][1][m][0] = tb[k % RES_DEPTH_F][2] + acc[ai][1][m][0] * scale; acc[ai][1][m][1] = tb[k % RES_DEPTH_F][3] + acc[ai][1][m][1] * scale;
                asm volatile("" : "+v"(acc[ai][0][m][0]), "+v"(acc[ai][0][m][1]), "+v"(acc[ai][1][m][0]), "+v"(acc[ai][1][m][1]));
                __builtin_amdgcn_sched_barrier(0); }
#undef RES_LOAD
        }
#pragma unroll
        for (int ai = 0; ai < 2; ++ai)
#pragma unroll
            for (int m = 0; m < 4; ++m) { const int r = row0 + ai * HALF + m * 16; const size_t off = (size_t)r * 4096 + col0; float sq = 0.f;
#pragma unroll
                for (int bj = 0; bj < 2; ++bj) { const f32x4 v0 = acc[ai][bj][m][0], v1 = acc[ai][bj][m][1];
                    if (OUT_F32) { *(f32x4*)(out + off + bj * HALF) = v0; *(f32x4*)(out + off + bj * HALF + 4) = v1; }
                    sq += (v0[0] * v0[0] + v0[1] * v0[1]) + (v0[2] * v0[2] + v0[3] * v0[3]) + (v1[0] * v1[0] + v1[1] * v1[1]) + (v1[2] * v1[2] + v1[3] * v1[3]);
                    if (HAS_OB) { u32x4 w; w.x = cvt_pk_bf16(v0[0], v0[1]); w.y = cvt_pk_bf16(v0[2], v0[3]); w.z = cvt_pk_bf16(v1[0], v1[1]); w.w = cvt_pk_bf16(v1[2], v1[3]); *(u32x4*)(ob + off + bj * HALF) = w; } }
                sq += __shfl_xor(sq, 16); sq += __shfl_xor(sq, 32);
                if (fq == 0) __hip_atomic_fetch_add(ss + r, sq, __ATOMIC_RELAXED, __HIP_MEMORY_SCOPE_AGENT); }
    }
};

struct EpiProj {
    static constexpr bool PERM = true, AFTER_DRAIN = false, HAS_MID = false, SS_LDS = true, ADJ = true; static constexpr int MID_T = 0, VM_TAIL = 16;
    bf16_t* qkv; bf16_t* gates; const float* ss; const float* rope; PG8_LAS unsigned char* ssl;
    __device__ __forceinline__ void mid(f32x4 (&)[2][2][4][2], const Unit&, int, int, int, int) const {}
    __device__ __forceinline__ void operator()(f32x4 (&acc)[2][2][4][2], const Unit& u, int wr, int wc, int fr, int fq) const {
        const int pn = u.pn; const bool is_gate = pn >= 48, is_rope = (pn < 24) || (pn >= 36 && pn < 46);
        const int rb = u.pm * BM + wr * 64, row0 = rb + fr; const bool lo8 = fr < 8;
        const bool do_rope = is_rope && ((wc & 1) == 0); const float sgn = fq < 2 ? -1.0f : 1.0f;
        float rs[2][4];
#pragma unroll
        for (int ai = 0; ai < 2; ++ai)
#pragma unroll
            for (int m = 0; m < 4; ++m) rs[ai][m] = ss_lds(ssl, wr, wc, fr, ai, m);
#pragma unroll
        for (int ai = 0; ai < 2; ++ai)
#pragma unroll
            for (int m = 0; m < 4; ++m) { const int r = row0 + ai * HALF + m * 16; const float rr = __builtin_amdgcn_rsqf(rs[ai][m] * (1.0f / 4096.0f) + 1e-6f);
#pragma unroll
                for (int bj = 0; bj < 2; ++bj) { acc[ai][bj][m][0] *= rr; acc[ai][bj][m][1] *= rr; }
                if (do_rope) { const int pos = r < 8192 ? (r & 4095) : r - 8192; const float* tp = rope + (size_t)pos * 32 + 8 * (fq & 1);
                    const f32x4 c0 = *(const f32x4*)tp, c1 = *(const f32x4*)(tp + 4), s0 = *(const f32x4*)(tp + 16), s1 = *(const f32x4*)(tp + 20);
                    f32x4 v0 = acc[ai][0][m][0], v1 = acc[ai][0][m][1];
#pragma unroll
                    for (int j = 0; j < 4; ++j) { const float p0 = __shfl_xor(v0[j], 32), p1 = __shfl_xor(v1[j], 32); v0[j] = v0[j] * c0[j] + sgn * p0 * s0[j]; v1[j] = v1[j] * c1[j] + sgn * p1 * s1[j]; }
                    acc[ai][0][m][0] = v0; acc[ai][0][m][1] = v1; } }
#pragma unroll
        for (int ai = 0; ai < 2; ++ai)
#pragma unroll
            for (int m = 0; m < 4; ++m) {
                if (is_gate) {
                    bf16_t* gd = gates + (size_t)(row0 + ai * HALF + m * 16) * 8192 + (pn - 48) * HALF + wc * 32 + 8 * fq; f32x4 uu[2], sbv[2];
#pragma unroll
                    for (int n = 0; n < 2; ++n)
#pragma unroll
                        for (int j = 0; j < 4; ++j) { const float sa = sigmoid_f(acc[ai][0][m][n][j]), sb = sigmoid_f(acc[ai][1][m][n][j]); sbv[n][j] = sb; uu[n][j] = sa * __builtin_amdgcn_rcpf(fmaxf(sb, 1e-20f)); }
                    u32x4 w; w.x = cvt_pk_bf16(uu[0][0], uu[0][1]); w.y = cvt_pk_bf16(uu[0][2], uu[0][3]); w.z = cvt_pk_bf16(uu[1][0], uu[1][1]); w.w = cvt_pk_bf16(uu[1][2], uu[1][3]);
                    *(u32x4*)gd = w;
                    w.x = cvt_pk_bf16(sbv[0][0], sbv[0][1]); w.y = cvt_pk_bf16(sbv[0][2], sbv[0][3]); w.z = cvt_pk_bf16(sbv[1][0], sbv[1][1]); w.w = cvt_pk_bf16(sbv[1][2], sbv[1][3]);
                    *(u32x4*)(gd + 4096) = w;
                } else {
                    u32x4 w[2];
#pragma unroll
                    for (int bj = 0; bj < 2; ++bj) { const f32x4 v0 = acc[ai][bj][m][0], v1 = acc[ai][bj][m][1];
                        w[bj].x = cvt_pk_bf16(v0[0], v0[1]); w[bj].y = cvt_pk_bf16(v0[2], v0[3]); w[bj].z = cvt_pk_bf16(v1[0], v1[1]); w[bj].w = cvt_pk_bf16(v1[2], v1[3]); }
                    u32x4 d1, d2; pair_to_lines(w[0], w[1], lo8, d1, d2);
                    bf16_t* op = qkv + (size_t)(rb + (fr & 7) + ai * HALF + m * 16) * 12288 + pn * BM + wc * 64 + 32 * (fr >> 3) + 8 * fq; *(u32x4*)op = d1; *(u32x4*)(op + 8 * 12288) = d2; } }
    }
};

struct EpiMerge {
    static constexpr bool PERM = true, AFTER_DRAIN = false, HAS_MID = true, SS_LDS = false, ADJ = false; static constexpr int MID_T = 16, VM_TAIL = 16;
    const bf16_t* gates; bf16_t* O;
    static constexpr int MID_DEPTH = 4, END_DEPTH = 8;
    __device__ __forceinline__ void mid(f32x4 (&acc)[2][2][4][2], const Unit& u, int wr, int wc, int fr, int fq) const {
        const __amdgpu_buffer_rsrc_t rsG = __builtin_amdgcn_make_buffer_rsrc((void*)gates, (short)0, (int)0xffffffffu, 0x00020000);
        int vo = ((u.pm * BM + wr * 64 + fr) * 8192 + u.pn * BM + wc * 32 + 8 * fq) * 2; asm volatile("" : "+v"(vo));
        u32x4 ta[MID_DEPTH][2];
#define MG_LOAD(k) do { const int o_ = vo + (((k) >> 2) * HALF + ((k) & 3) * 16) * 16384; _Pragma("unroll") for (int bj = 0; bj < 2; ++bj) ta[(k) % MID_DEPTH][bj] = __builtin_amdgcn_raw_buffer_load_b128(rsG, o_ + bj * 256, 0, 0); } while (0)
#pragma unroll
        for (int k = 0; k < MID_DEPTH - 1; ++k) MG_LOAD(k);
#pragma unroll
        for (int k = 0; k < 8; ++k) { const int ai = k >> 2, m = k & 3;
            if (k + MID_DEPTH - 1 < 8) MG_LOAD(k + MID_DEPTH - 1);
#pragma unroll
            for (int bj = 0; bj < 2; ++bj) { const u32x4 a = ta[k % MID_DEPTH][bj];
                acc[ai][bj][m][0] *= (f32x4){bf_lo(a.x), bf_hi(a.x), bf_lo(a.y), bf_hi(a.y)}; acc[ai][bj][m][1] *= (f32x4){bf_lo(a.z), bf_hi(a.z), bf_lo(a.w), bf_hi(a.w)}; }
            asm volatile("" : "+v"(acc[ai][0][m][0]), "+v"(acc[ai][0][m][1]), "+v"(acc[ai][1][m][0]), "+v"(acc[ai][1][m][1]));
            __builtin_amdgcn_sched_barrier(0); }
#undef MG_LOAD
    }
    __device__ __forceinline__ void operator()(f32x4 (&acc)[2][2][4][2], const Unit& u, int wr, int wc, int fr, int fq) const {
        const int row0 = u.pm * BM + wr * 64 + fr, col0 = u.pn * BM + wc * 32 + 8 * fq;
        { const __amdgpu_buffer_rsrc_t rsG = __builtin_amdgcn_make_buffer_rsrc((void*)gates, (short)0, (int)0xffffffffu, 0x00020000);
          const int vo = (row0 * 8192 + col0) * 2;
          u32x4 tb[END_DEPTH][2];
#define MG_LOAD(k) do { const int o_ = vo + (((k) >> 2) * HALF + ((k) & 3) * 16) * 16384; _Pragma("unroll") for (int bj = 0; bj < 2; ++bj) tb[(k) % END_DEPTH][bj] = __builtin_amdgcn_raw_buffer_load_b128(rsG, o_ + bj * 256, 8192, 0); } while (0)
#pragma unroll
          for (int k = 0; k < END_DEPTH - 1; ++k) MG_LOAD(k);
#pragma unroll
          for (int k = 0; k < 8; ++k) { const int ai = k >> 2, m = k & 3;
              if (k + END_DEPTH - 1 < 8) MG_LOAD(k + END_DEPTH - 1);
#pragma unroll
              for (int bj = 0; bj < 2; ++bj) { const u32x4 b = tb[k % END_DEPTH][bj]; f32x4 g0, g1;
                  g0[0] = fmaxf(bf_lo(b.x), 1e-20f); g0[1] = fmaxf(bf_hi(b.x), 1e-20f); g0[2] = fmaxf(bf_lo(b.y), 1e-20f); g0[3] = fmaxf(bf_hi(b.y), 1e-20f);
                  g1[0] = fmaxf(bf_lo(b.z), 1e-20f); g1[1] = fmaxf(bf_hi(b.z), 1e-20f); g1[2] = fmaxf(bf_lo(b.w), 1e-20f); g1[3] = fmaxf(bf_hi(b.w), 1e-20f);
                  acc[ai][bj][m][0] *= g0; acc[ai][bj][m][1] *= g1; }
              asm volatile("" : "+v"(acc[ai][0][m][0]), "+v"(acc[ai][0][m][1]), "+v"(acc[ai][1][m][0]), "+v"(acc[ai][1][m][1]));
              __builtin_amdgcn_sched_barrier(0); }
#undef MG_LOAD
        }
#pragma unroll
        for (int ai = 0; ai < 2; ++ai)
#pragma unroll
            for (int m = 0; m < 4; ++m) { const int r = row0 + ai * HALF + m * 16;
#pragma unroll
                for (int bj = 0; bj < 2; ++bj) { const f32x4 a0 = acc[ai][bj][m][0], a1 = acc[ai][bj][m][1];
                    u32x4 w; w.x = cvt_pk_bf16(a0[0], a0[1]); w.y = cvt_pk_bf16(a0[2], a0[3]); w.z = cvt_pk_bf16(a1[0], a1[1]); w.w = cvt_pk_bf16(a1[2], a1[3]);
                    *(u32x4*)(O + (size_t)r * 4096 + col0 + bj * HALF) = w; } }
    }
};

template <class Epi, class Sched, bool ALIGN_EPI = false, bool SP2 = false>
__device__ __forceinline__ void gemm_phase(PG8_LAS unsigned char* lds, const Gemm g, const Sched& S, const Epi& E) {
    const int tid = threadIdx.x, wid = __builtin_amdgcn_readfirstlane(tid >> 6), lane = tid & 63, wr = wid >> 2, wc = wid & 3, fr = lane & 15, fq = lane >> 4;
    const int K = g.K, nt = K / BK;
    unsigned voffA[2], voffB[2];
#pragma unroll
    for (int i = 0; i < 2; ++i) { int R, C; stage_rc(tid * 16 + i * 8192, R, C); const int Rb = Epi::PERM ? ((R & ~31) + perm32(R & 31)) : R;
        const int Rj = Epi::ADJ ? 64 * (R >> 5) + perm32(R & 31) : Rb;
        voffA[i] = (unsigned)(R * K + C) * 2u; voffB[i] = (unsigned)(Rj * K + C) * 2u; }
    const unsigned kstep = (unsigned)(BK * 2);
    const unsigned hstep = (unsigned)HALF * (unsigned)K * 2u;
    const unsigned tstep = 2u * hstep;
    const unsigned hB = Epi::ADJ ? 32u * (unsigned)K * 2u : hstep;
    const __amdgpu_buffer_rsrc_t rsA = __builtin_amdgcn_make_buffer_rsrc((void*)g.A, (short)0, (int)0xffffffffu, 0x00020000);
    const __amdgpu_buffer_rsrc_t rsB = __builtin_amdgcn_make_buffer_rsrc((void*)g.Bt, (short)0, (int)0xffffffffu, 0x00020000);
    const unsigned ldsw = (unsigned)wid * 1024u;
    const int aoff = lds_byte(wr * 64 + fr, fq * 8), boff = lds_byte(wc * 32 + fr, fq * 8);
#define PG8_SA(b, h) (((b) * 2 + (h)) * HTB)
#define PG8_SB(b, h) ((4 + (b) * 2 + (h)) * HTB)
#define PG8_STAGE(bufoff, rs, soff, voff) do { _Pragma("unroll") for (int _i = 0; _i < 2; ++_i) \
        __builtin_amdgcn_raw_ptr_buffer_load_lds(rs, (PG8_LAS unsigned*)(lds + (bufoff) + ldsw + _i * 8192), 16, (int)(voff)[_i], (int)(soff), 0, 0); } while (0)
#define PG8_LDA(dst, b, h) do { _Pragma("unroll") for (int m = 0; m < 4; ++m) _Pragma("unroll") for (int k = 0; k < 2; ++k) dst[m][k] = *(const PG8_LAS bf16x8*)(lds + PG8_SA(b, h) + aoff + m * 2048 + k * 1024); } while (0)
#define PG8_LDB(dst, b, h) do { _Pragma("unroll") for (int n = 0; n < 2; ++n) _Pragma("unroll") for (int k = 0; k < 2; ++k) dst[n][k] = *(const PG8_LAS bf16x8*)(lds + PG8_SB(b, h) + boff + n * 2048 + k * 1024); } while (0)
#define PG8_MMA(ai, bj, At, Bt) do { __builtin_amdgcn_s_setprio(1); _Pragma("unroll") for (int m = 0; m < 4; ++m) _Pragma("unroll") for (int n = 0; n < 2; ++n) _Pragma("unroll") for (int k = 0; k < 2; ++k) \
        acc[ai][bj][m][n] = __builtin_amdgcn_mfma_f32_16x16x32_bf16(Bt[n][k], At[m][k], acc[ai][bj][m][n], 0, 0, 0); __builtin_amdgcn_s_setprio(0); } while (0)
#define PG8_WAIT_V(n) asm volatile("s_waitcnt vmcnt(" #n ")" ::: "memory")
#define PG8_WAIT_VN(N) asm volatile("s_waitcnt vmcnt(%0)" :: "n"(N) : "memory")
#define PG8_WAIT_L(n) asm volatile("s_waitcnt lgkmcnt(" #n ")" ::: "memory")
#define PG8_BAR __builtin_amdgcn_s_barrier()
#define PG8_SCHED __builtin_amdgcn_sched_barrier(0)
    Unit cur, nxt; int ui = 0;
    if (!S.next(0, cur)) return;
    f32x4 acc[2][2][4][2];
#pragma unroll
    for (int a = 0; a < 2; ++a)
#pragma unroll
        for (int b = 0; b < 2; ++b)
#pragma unroll
            for (int m = 0; m < 4; ++m)
#pragma unroll
                for (int n = 0; n < 2; ++n) acc[a][b][m][n] = (f32x4){0.f, 0.f, 0.f, 0.f};
    bf16x8 At[4][2], B0[2][2], B1[2][2];
    unsigned cA = __builtin_amdgcn_readfirstlane((unsigned)cur.pm * tstep), cB = __builtin_amdgcn_readfirstlane((unsigned)cur.pn * tstep);
    S.a_ready(cur);
    if constexpr (Epi::SS_LDS) ss_prefetch(E.ss, E.ssl, cur.pm, wid, lane);
    if constexpr (SP2) {
        PG8_STAGE(PG8_SB(0, 0), rsB, cB, voffB); PG8_STAGE(PG8_SB(0, 1), rsB, cB + hB, voffB); PG8_STAGE(PG8_SA(0, 0), rsA, cA, voffA); PG8_STAGE(PG8_SA(0, 1), rsA, cA + hstep, voffA);
        if (wr == 1) PG8_BAR;
        PG8_WAIT_V(2); PG8_BAR;
        PG8_STAGE(PG8_SB(1, 0), rsB, cB + kstep, voffB); PG8_STAGE(PG8_SA(1, 0), rsA, cA + kstep, voffA); PG8_STAGE(PG8_SB(1, 1), rsB, cB + hB + kstep, voffB);
        PG8_WAIT_V(0); PG8_BAR;
    } else {
        PG8_STAGE(PG8_SB(0, 0), rsB, cB, voffB); PG8_STAGE(PG8_SA(0, 0), rsA, cA, voffA); PG8_STAGE(PG8_SB(0, 1), rsB, cB + hB, voffB); PG8_STAGE(PG8_SA(0, 1), rsA, cA + hstep, voffA);
        if (wr == 1) PG8_BAR;
        PG8_WAIT_V(4); PG8_BAR;
        PG8_STAGE(PG8_SB(1, 0), rsB, cB + kstep, voffB); PG8_STAGE(PG8_SA(1, 0), rsA, cA + kstep, voffA); PG8_STAGE(PG8_SB(1, 1), rsB, cB + hB + kstep, voffB);
        PG8_WAIT_V(6); PG8_BAR;
    }
    for (;;) {
        const bool has_next = S.next(ui + 1, nxt);
        const unsigned nA = __builtin_amdgcn_readfirstlane(has_next ? (unsigned)nxt.pm * tstep : cA), nB = __builtin_amdgcn_readfirstlane(has_next ? (unsigned)nxt.pn * tstep : cB);
#define PG8_KADDR const bool last = (t == nt - 2); const unsigned a1 = cA + (unsigned)(t + 1) * kstep; \
            const unsigned a2 = last ? nA : cA + (unsigned)(t + 2) * kstep, b2 = last ? nB : cB + (unsigned)(t + 2) * kstep, a3 = a2 + kstep, b3 = b2 + kstep; \
            if (last && has_next) S.a_ready(nxt); \
            if constexpr (Epi::HAS_MID) { if (t == Epi::MID_T) E.mid(acc, cur, wr, wc, fr, fq); }
#define PG8_KPAIR_SP2(W12) do { \
            PG8_LDB(B0, 0, 0); PG8_LDB(B1, 0, 1); PG8_SCHED; PG8_LDA(At, 0, 0); PG8_STAGE(PG8_SA(1, 1), rsA, a1 + hstep, voffA); \
            PG8_WAIT_VN(W12); PG8_WAIT_L(0); PG8_BAR; PG8_MMA(0, 0, At, B0); PG8_MMA(0, 1, At, B1); PG8_BAR; PG8_SCHED; \
            PG8_LDA(At, 0, 1); PG8_STAGE(PG8_SB(0, 0), rsB, b2, voffB); PG8_STAGE(PG8_SB(0, 1), rsB, b2 + hB, voffB); PG8_STAGE(PG8_SA(0, 0), rsA, a2, voffA); \
            PG8_WAIT_VN(W12); PG8_WAIT_L(0); PG8_BAR; PG8_MMA(1, 0, At, B0); PG8_MMA(1, 1, At, B1); PG8_BAR; PG8_SCHED; \
            PG8_LDB(B0, 1, 0); PG8_LDB(B1, 1, 1); PG8_SCHED; PG8_LDA(At, 1, 0); PG8_STAGE(PG8_SA(0, 1), rsA, a2 + hstep, voffA); \
            PG8_WAIT_V(8); PG8_WAIT_L(0); PG8_BAR; PG8_MMA(0, 0, At, B0); PG8_MMA(0, 1, At, B1); PG8_BAR; PG8_SCHED; \
            PG8_LDA(At, 1, 1); PG8_STAGE(PG8_SB(1, 0), rsB, b3, voffB); PG8_STAGE(PG8_SB(1, 1), rsB, b3 + hB, voffB); PG8_STAGE(PG8_SA(1, 0), rsA, a3, voffA); \
            PG8_WAIT_V(8); PG8_WAIT_L(0); PG8_BAR; PG8_MMA(1, 0, At, B0); PG8_MMA(1, 1, At, B1); PG8_BAR; PG8_SCHED; } while (0)
        if constexpr (SP2) {
            { const int t = 0; PG8_KADDR; PG8_KPAIR_SP2(8 + Epi::VM_TAIL); }
            for (int t = 2; t < nt; t += 2) { PG8_KADDR; PG8_KPAIR_SP2(8); }
        } else {
        for (int t = 0; t < nt; t += 2) {
            PG8_KADDR;
            PG8_LDB(B0, 0, 0); PG8_SCHED; PG8_LDA(At, 0, 0); PG8_STAGE(PG8_SA(1, 1), rsA, a1 + hstep, voffA);
            PG8_WAIT_L(8); PG8_BAR; PG8_WAIT_L(0); PG8_MMA(0, 0, At, B0); PG8_BAR; PG8_SCHED;
            PG8_LDB(B1, 0, 1); PG8_STAGE(PG8_SB(0, 0), rsB, b2, voffB);
            PG8_BAR; PG8_WAIT_L(0); PG8_MMA(0, 1, At, B1); PG8_BAR;
            PG8_LDA(At, 0, 1); PG8_STAGE(PG8_SA(0, 0), rsA, a2, voffA);
            PG8_BAR; PG8_WAIT_L(0); PG8_MMA(1, 0, At, B0); PG8_BAR; PG8_SCHED;
            PG8_STAGE(PG8_SB(0, 1), rsB, b2 + hB, voffB);
            PG8_WAIT_V(6); PG8_BAR; PG8_MMA(1, 1, At, B1); PG8_BAR;
            PG8_LDB(B0, 1, 0); PG8_SCHED; PG8_LDA(At, 1, 0); PG8_STAGE(PG8_SA(0, 1), rsA, a2 + hstep, voffA);
            PG8_WAIT_L(8); PG8_BAR; PG8_WAIT_L(0); PG8_MMA(0, 0, At, B0); PG8_BAR; PG8_SCHED;
            PG8_LDB(B1, 1, 1); PG8_STAGE(PG8_SB(1, 0), rsB, b3, voffB);
            PG8_BAR; PG8_WAIT_L(0); PG8_MMA(0, 1, At, B1); PG8_BAR;
            PG8_LDA(At, 1, 1); PG8_STAGE(PG8_SA(1, 0), rsA, a3, voffA);
            PG8_BAR; PG8_WAIT_L(0); PG8_MMA(1, 0, At, B0); PG8_BAR; PG8_SCHED;
            PG8_STAGE(PG8_SB(1, 1), rsB, b3 + hB, voffB);
            PG8_WAIT_V(6); PG8_BAR; PG8_MMA(1, 1, At, B1); PG8_BAR;
        }
        }
        if constexpr (ALIGN_EPI) { if (wr == 0) PG8_BAR; }
        if constexpr (!Epi::AFTER_DRAIN) { E(acc, cur, wr, wc, fr, fq); S.done(cur); }
        if (!has_next) break;
#pragma unroll
        for (int a = 0; a < 2; ++a)
#pragma unroll
            for (int b = 0; b < 2; ++b)
#pragma unroll
                for (int m = 0; m < 4; ++m)
#pragma unroll
                    for (int n = 0; n < 2; ++n) acc[a][b][m][n] = (f32x4){0.f, 0.f, 0.f, 0.f};
        cur = nxt; cA = nA; cB = nB; ++ui;
        if constexpr (Epi::SS_LDS) ss_prefetch(E.ss, E.ssl, cur.pm, wid, lane);
        if constexpr (ALIGN_EPI) { if (wr == 1) PG8_BAR; }
    }
    PG8_WAIT_V(0);
    if constexpr (!ALIGN_EPI) { if (wr == 0) PG8_BAR; }
    PG8_BAR;
#undef PG8_SA
#undef PG8_SB
#undef PG8_STAGE
#undef PG8_LDA
#undef PG8_LDB
#undef PG8_MMA
#undef PG8_WAIT_V
#undef PG8_WAIT_L
#undef PG8_WAIT_VN
#undef PG8_KADDR
#undef PG8_KPAIR_SP2
#undef PG8_BAR
#undef PG8_SCHED
}
}

#ifndef PG8_SP2
#define PG8_SP2 true
#endif
#ifndef PG8_ALIGN
#define PG8_ALIGN true
#endif

constexpr int NWAVES = 8;
constexpr int N_LAUNCHES = MK_N_LAUNCHES;
constexpr int PER_PHASE = 10;
constexpr int D = 4096, FF = 11008, NIN = 20480, QKVW = 12288, GATEW = 8192, YABW = 3072;
constexpr int M_P = 8192, M_S = 16384, M = M_P + M_S;
constexpr float QSCALE = 0.08838834764831845f * 1.4426950408889634f;

constexpr size_t MiB = 1u << 20;
constexpr size_t WS_CTL = 0, CTL_ZERO_BYTES = 1 * MiB;
constexpr size_t WS_SS0 = 1 * MiB;
constexpr size_t WS_ROPE = 2 * MiB;
constexpr size_t WS_WIN = 4 * MiB;
constexpr size_t WS_WAB = WS_WIN + (size_t)NIN * D * 2;
constexpr size_t WS_WOUT = WS_WAB + (size_t)D * YABW * 2;
constexpr size_t WS_WGU = WS_WOUT + (size_t)D * D * 2;
constexpr size_t WS_WD = WS_WGU + (size_t)2 * FF * D * 2;
constexpr size_t WS_AB1 = WS_WD + (size_t)D * FF * 2;
constexpr size_t WS_ACT = WS_AB1 + (size_t)M * D * 2;
constexpr size_t WS_QKV = WS_ACT + (size_t)M * FF * 2;
constexpr size_t WS_END = WS_QKV + (size_t)M * QKVW * 2;
constexpr int CW_BAR = 4096;
constexpr int CW_SS1 = 16384, CW_SS2 = CW_SS1 + M, CW_SS3 = CW_SS2 + M;
static_assert((size_t)(CW_SS3 + M) * 4 <= CTL_ZERO_BYTES, "CTL words inside the memset region");
static_assert(WS_SS0 + (size_t)M * 4 <= WS_ROPE && WS_ROPE + (size_t)16384 * 32 * 4 <= WS_WIN, "ws map");

constexpr int RING_OFF = 0, RING_BYTES = 131072;
constexpr int LDSCTL_OFF = RING_BYTES, MISC_OFF = LDSCTL_OFF + 320;
constexpr int SSL_OFF = MISC_OFF + 1024;
constexpr int LDS_BYTES = 147456;

#define GAS __attribute__((address_space(1)))
#define LAS __attribute__((address_space(3)))
typedef unsigned short bf16;
typedef unsigned v4u __attribute__((ext_vector_type(4)));
typedef unsigned v2u __attribute__((ext_vector_type(2)));
typedef float f32x4 __attribute__((ext_vector_type(4)));
typedef short bf16x8 __attribute__((ext_vector_type(8)));
typedef short s16x4 __attribute__((ext_vector_type(4)));
typedef GAS unsigned gu32;
#define RLX_AGENT __ATOMIC_RELAXED, __HIP_MEMORY_SCOPE_AGENT
#define LDS_WAIT() asm volatile("s_waitcnt lgkmcnt(0)" ::: "memory")
#define VM_WAIT() asm volatile("s_waitcnt vmcnt(0)" ::: "memory")
__device__ __forceinline__ unsigned pk2(float lo, float hi) { return pg8::cvt_pk_bf16(lo, hi); }

#define XB_TMO      128
#define XB_XCNT(j)  (256  + 64 * (j))
#define XB_XSUB(j)  (1280 + 64 * (j))
#define XB_XGEN(j)  (2304 + 64 * (j))
#define XB_TOP      3328
#define XB_TOPGEN   3392
#define XCD_BAR_WORDS 3456
#define XB_SPIN_CAP (1u << 18)

__device__ __forceinline__ unsigned xb_ld(unsigned* p)              { return __hip_atomic_load(p, __ATOMIC_RELAXED, __HIP_MEMORY_SCOPE_AGENT); }
__device__ __forceinline__ unsigned xb_add(unsigned* p, unsigned v) { return __hip_atomic_fetch_add(p, v, __ATOMIC_RELAXED, __HIP_MEMORY_SCOPE_AGENT); }
__device__ __forceinline__ unsigned xb_xcc_id() { return (unsigned)__builtin_amdgcn_s_getreg((3 << 11) | 20) & 0xFu; }
#define XB_SPIN(cond, bar) do { unsigned _sp = 0; while (cond) { __builtin_amdgcn_s_sleep(1); \
    if ((++_sp & 255u) == 0u) { if (xb_ld(&(bar)[XB_TMO])) break; if (_sp > XB_SPIN_CAP) { atomicAdd(&(bar)[XB_TMO], 1u); break; } } } } while (0)

struct XcdBarrier {
    unsigned* bar; unsigned x;
    volatile LAS unsigned* st;
};
__device__ __forceinline__ XcdBarrier xcd_barrier_post(unsigned* bar, volatile LAS unsigned* st) {
    XcdBarrier b; b.bar = bar; b.x = xb_xcc_id(); b.st = st;
    if (threadIdx.x == 0) (void)xb_add(&bar[XB_XCNT(b.x)], 1u);
    return b;
}
__device__ __forceinline__ void xcd_barrier_complete(unsigned* bar, unsigned x, unsigned& nloc, unsigned& nx) {
    const unsigned G = gridDim.x * gridDim.y * gridDim.z;
    unsigned sum, cnt, mine, sp = 0u;
    for (;;) {
        sum = 0u; cnt = 0u; mine = 0u;
#pragma unroll
        for (unsigned j = 0; j < 16; ++j) { const unsigned c = xb_ld(&bar[XB_XCNT(j)]); sum += c; cnt += (c > 0u) ? 1u : 0u; mine = (j == x) ? c : mine; }
        if (sum == G) break;
        __builtin_amdgcn_s_sleep(1);
        if ((++sp & 255u) == 0u) { if (xb_ld(&bar[XB_TMO])) break; if (sp > XB_SPIN_CAP) { atomicAdd(&bar[XB_TMO], 1u); break; } }
    }
    nloc = mine > 0u ? mine : 1u; nx = cnt > 0u ? cnt : 1u;
}
__device__ __forceinline__ void xcd_barrier(const XcdBarrier& b) {
    asm volatile("s_waitcnt vmcnt(0)" ::: "memory");
    __syncthreads();
    if (threadIdx.x == 0) {
        unsigned* bar = b.bar;
        __builtin_amdgcn_s_waitcnt(0);
        unsigned nloc = b.st[0], nx = b.st[1];
        if (nloc == 0u) { xcd_barrier_complete(bar, b.x, nloc, nx); b.st[0] = nloc; b.st[1] = nx; }
        const unsigned old = xb_add(&bar[XB_XSUB(b.x)], 1u);
        const unsigned gen = old / nloc;
        if (old + 1u == (gen + 1u) * nloc) {
            __builtin_amdgcn_fence(__ATOMIC_RELEASE, "agent");
            asm volatile("s_waitcnt vmcnt(0)" ::: "memory");
            const unsigned og = xb_add(&bar[XB_TOP], 1u);
            const unsigned tg = og / nx;
            if (og + 1u == (tg + 1u) * nx) xb_add(&bar[XB_TOPGEN], 1u);
            else XB_SPIN(xb_ld(&bar[XB_TOPGEN]) == tg, bar);
            __builtin_amdgcn_fence(__ATOMIC_ACQUIRE, "agent");
            xb_add(&bar[XB_XGEN(b.x)], 1u);
            asm volatile("s_waitcnt vmcnt(0)" ::: "memory");
        } else {
            XB_SPIN(xb_ld(&bar[XB_XGEN(b.x)]) == gen, bar);
            __builtin_amdgcn_fence(__ATOMIC_ACQUIRE, "agent");
            asm volatile("s_waitcnt vmcnt(0)" ::: "memory");
        }
    }
    __syncthreads();
}

__device__ __forceinline__ void xcd_stagger(unsigned ticks) {
    const unsigned long long dt = (unsigned long long)(xb_xcc_id() & 7u) * ticks, t0 = __builtin_amdgcn_s_memrealtime();
    while (__builtin_amdgcn_s_memrealtime() - t0 < dt) __builtin_amdgcn_s_sleep(8);
}

struct Frame {
    LAS unsigned char* lds;
    volatile LAS unsigned* MISC;
    gu32* ctl;
    int tid, lane, wave;
    int vcu, G;
};

__device__ __forceinline__ float wave_sum(float v) {
#pragma unroll
    for (int o = 1; o < 64; o <<= 1) v += __shfl_xor(v, o);
    return v;
}

struct CvtJob { const float* W; const float* gain; bf16* WT; int N, ldT, drow, kcol0, k0, n0, split; float cs; };
__device__ __forceinline__ void cvt_job(CvtJob& J, const float* W, int N, const float* gain, bf16* WT, int ldT, int koff, int mode, int item) {
    const int nblk = N / 64, kb = item / nblk, nb = item % nblk, k0 = 64 * kb, n0 = 64 * nb;
    J.W = W; J.gain = gain; J.WT = WT; J.N = N; J.ldT = ldT; J.k0 = k0; J.n0 = n0; J.kcol0 = koff + k0;
    J.cs = (mode == 3 && (n0 < 3072 || (n0 >= 9216 && n0 < 11264))) ? QSCALE : 1.0f;
    J.drow = (mode == 1 || mode == 2) ? 256 * (n0 >> 7) + (n0 & 127) + (mode == 2 ? 128 : 0) : n0;
    J.split = 0;
    if (mode == 3 && n0 >= 12288) { const int c = n0 - 12288, c2 = c & 4095;
        J.drow = 12288 + 2 * c2 + (c >= 4096 ? 32 : 0); J.split = 1; }
}
__device__ __forceinline__ void cvt_load(const CvtJob& J, int lane, f32x4 (&v)[16]) {
    const float* p = J.W + (size_t)(J.k0 + 16 * (lane >> 4)) * J.N + J.n0 + 4 * (lane & 15);
#pragma unroll
    for (int i = 0; i < 16; ++i) v[i] = __builtin_nontemporal_load((const f32x4*)(p + (size_t)i * J.N));
}
__device__ __forceinline__ void cvt_store(const CvtJob& J, const f32x4 (&v)[16], LAS unsigned char* img, int lane) {
    const int g = lane >> 4, i15 = lane & 15;
    f32x4 gq[4];
#pragma unroll
    for (int j = 0; j < 4; ++j) gq[j] = J.gain ? *(const f32x4*)(J.gain + J.k0 + 16 * g + 4 * j) * J.cs : (f32x4){J.cs, J.cs, J.cs, J.cs};
#pragma unroll
    for (int e = 0; e < 4; ++e) { v4u lo, hi;
        lo.x = pk2(v[0][e] * gq[0][0], v[1][e] * gq[0][1]);   lo.y = pk2(v[2][e] * gq[0][2], v[3][e] * gq[0][3]);   lo.z = pk2(v[4][e] * gq[1][0], v[5][e] * gq[1][1]);   lo.w = pk2(v[6][e] * gq[1][2], v[7][e] * gq[1][3]);
        hi.x = pk2(v[8][e] * gq[2][0], v[9][e] * gq[2][1]);   hi.y = pk2(v[10][e] * gq[2][2], v[11][e] * gq[2][3]); hi.z = pk2(v[12][e] * gq[3][0], v[13][e] * gq[3][1]); hi.w = pk2(v[14][e] * gq[3][2], v[15][e] * gq[3][3]);
        LAS unsigned char* wp = img + (4 * i15 + e) * 144 + 32 * g;
        *(LAS v4u*)wp = lo; *(LAS v4u*)(wp + 16) = hi; }
    const int r = lane >> 3, c = lane & 7;
    bf16* op = J.WT + (size_t)(J.drow + r) * J.ldT + J.kcol0 + 8 * c;
#pragma unroll
    for (int j = 0; j < 8; ++j) {
        const v4u o = *(const LAS v4u*)(img + (8 * j + r) * 144 + 16 * c);
        *(v4u*)(op + (size_t)(8 * j + (J.split ? 32 * (j >> 2) : 0)) * J.ldT) = o;
    }
}
struct Ptrs;
template <int SET> __device__ __forceinline__ void cvt_decode(const Ptrs& P, int it, CvtJob& J);

__device__ __forceinline__ void sincos_acc(float a, float& s, float& c) {
    const double x = (double)a;
    const double kq = __builtin_rint(x * 0.63661977236758134308);
    double r = __builtin_fma(-kq, 1.57079632679489655800e+00, x);
    r = __builtin_fma(-kq, 6.12323399573676603587e-17, r);
    const int q = (int)((long long)kq) & 3;
    const double r2 = r * r;
    const double sp = r * (1.0 + r2 * (-1.0 / 6.0 + r2 * (1.0 / 120.0 + r2 * (-1.0 / 5040.0 + r2 * (1.0 / 362880.0 + r2 * (-1.0 / 39916800.0 + r2 * (1.0 / 6227020800.0)))))));
    const double cp = 1.0 + r2 * (-0.5 + r2 * (1.0 / 24.0 + r2 * (-1.0 / 720.0 + r2 * (1.0 / 40320.0 + r2 * (-1.0 / 3628800.0 + r2 * (1.0 / 479001600.0))))));
    const double ss = (q & 1) ? cp : sp, cc = (q & 1) ? sp : cp;
    s = (float)((q & 2) ? -ss : ss);
    c = (float)(((q + 1) & 2) ? -cc : cc);
}

struct Ptrs {
    const float* xp; const float* xs; const float* g1; const float* w1g; const float* w1u; const float* w1d; const float* gmix; const float* win; const float* sink;
    const float* wa; const float* wb; const float* wout; const float* g2; const float* w2g; const float* w2u; const float* w2d; const float* gfin;
    float* out; unsigned char* ws;
};

constexpr int CI_GU = (D / 64) * (FF / 64), CI_D = (FF / 64) * (D / 64), CI_IN = (D / 64) * (NIN / 64), CI_A = (1024 / 64) * (D / 64), CI_B = (2048 / 64) * (D / 64), CI_O = (D / 64) * (D / 64);
constexpr int CI_IN0 = CI_IN / 2;
template <> __device__ __forceinline__ void cvt_decode<0>(const Ptrs& P, int it, CvtJob& J) {
    bf16* WGU = (bf16*)(P.ws + WS_WGU); bf16* WD = (bf16*)(P.ws + WS_WD); bf16* WIN = (bf16*)(P.ws + WS_WIN);
    int r = it;
    if (r < CI_GU) { cvt_job(J, P.w1g, FF, P.g1, WGU, D, 0, 1, r); return; } r -= CI_GU;
    if (r < CI_GU) { cvt_job(J, P.w1u, FF, P.g1, WGU, D, 0, 2, r); return; } r -= CI_GU;
    if (r < CI_D)  { cvt_job(J, P.w1d, D, nullptr, WD, FF, 0, 0, r); return; } r -= CI_D;
    cvt_job(J, P.win, NIN, P.gmix, WIN, D, 0, 3, r);
}
template <> __device__ __forceinline__ void cvt_decode<2>(const Ptrs& P, int it, CvtJob& J) {
    bf16* WIN = (bf16*)(P.ws + WS_WIN); bf16* WAB = (bf16*)(P.ws + WS_WAB); bf16* WOUT = (bf16*)(P.ws + WS_WOUT);
    int r = it;
    if (r < CI_IN - CI_IN0) { cvt_job(J, P.win, NIN, P.gmix, WIN, D, 0, 3, r + CI_IN0); return; } r -= CI_IN - CI_IN0;
    if (r < CI_A)  { cvt_job(J, P.wa, D, nullptr, WAB, YABW, 0, 0, r); return; } r -= CI_A;
    if (r < CI_B)  { cvt_job(J, P.wb, D, nullptr, WAB, YABW, 1024, 0, r); return; } r -= CI_B;
    cvt_job(J, P.wout, D, nullptr, WOUT, D, 0, 0, r);
}
template <> __device__ __forceinline__ void cvt_decode<1>(const Ptrs& P, int it, CvtJob& J) {
    bf16* WGU = (bf16*)(P.ws + WS_WGU); bf16* WD = (bf16*)(P.ws + WS_WD);
    int r = it;
    if (r < CI_GU) { cvt_job(J, P.w2g, FF, P.g2, WGU, D, 0, 1, r); return; } r -= CI_GU;
    cvt_job(J, P.w2u, FF, P.g2, WGU, D, 0, 2, r);
}
template <> __device__ __forceinline__ void cvt_decode<3>(const Ptrs& P, int it, CvtJob& J) { cvt_job(J, P.w2d, D, nullptr, (bf16*)(P.ws + WS_WD), FF, 0, 0, it); }
template <int SET> __device__ __forceinline__ void cvt_run(Frame& F, const Ptrs& P, int gw, int NGW) {
    constexpr int NITEMS = SET == 0 ? 2 * CI_GU + CI_D + CI_IN0 : (SET == 1 ? 2 * CI_GU : (SET == 3 ? CI_D : (CI_IN - CI_IN0) + CI_A + CI_B + CI_O));
    LAS unsigned char* img = F.lds + RING_OFF + F.wave * 16384;
    const int lane = F.lane;
    f32x4 va[16], vb[16]; CvtJob Ja, Jb;
    int it = gw;
    if (it >= NITEMS) return;
    cvt_decode<SET>(P, it, Ja); cvt_load(Ja, lane, va);
    for (;;) {
        int nx = it + NGW;
        cvt_decode<SET>(P, nx < NITEMS ? nx : NITEMS - 1, Jb); cvt_load(Jb, lane, vb);
        cvt_store(Ja, va, img, lane);
        it = nx; if (it >= NITEMS) break;
        nx = it + NGW;
        cvt_decode<SET>(P, nx < NITEMS ? nx : NITEMS - 1, Ja); cvt_load(Ja, lane, va);
        cvt_store(Jb, vb, img, lane);
        it = nx; if (it >= NITEMS) break;
    }
}
__device__ __forceinline__ void p0_prologue(Frame& F, const Ptrs& P) {
    const int gw = F.vcu * NWAVES + F.wave, NGW = F.G * NWAVES;
    { float* tab = (float*)(P.ws + WS_ROPE);
      const float inv[16] = {1.000000000e+00f, 4.403665960e-01f, 1.939227432e-01f, 8.539710194e-02f, 3.760603070e-02f, 1.656044088e-02f, 7.292664610e-03f, 3.211446106e-03f,
                             1.414213562e-03f, 6.227724371e-04f, 2.742481884e-04f, 1.207697351e-04f, 5.318295734e-05f, 2.341999971e-05f, 1.031338525e-05f, 4.541670478e-06f};
      for (int pos = gw * 64 + F.lane; pos < 16384; pos += NGW * 64) {
#pragma unroll
          for (int i = 0; i < 16; ++i) { const float ang = (float)pos * inv[i]; float s, c; sincos_acc(ang, s, c); tab[(size_t)pos * 32 + i] = c; tab[(size_t)pos * 32 + 16 + i] = s; } } }
    { bf16* XB = (bf16*)(P.ws + WS_AB1); float* ss0 = (float*)(P.ws + WS_SS0);
      for (int m = gw; m < M; m += NGW) { const float* xrow = (m < M_P) ? P.xp + (size_t)m * D : P.xs + (size_t)(m - M_P) * D;
          const GAS f32x4* xr = (const GAS f32x4*)xrow + F.lane; GAS v2u* o8 = (GAS v2u*)(XB + (size_t)m * D) + F.lane; float s = 0.f;
#pragma unroll
          for (int j = 0; j < 16; ++j) { const f32x4 v = __builtin_nontemporal_load(xr + 64 * j); s += (v.x * v.x + v.y * v.y) + (v.z * v.z + v.w * v.w); v2u w; w.x = pk2(v.x, v.y); w.y = pk2(v.z, v.w); o8[64 * j] = w; }
          s = wave_sum(s); if (F.lane == 0) ss0[m] = s; } }
    cvt_run<0>(F, P, gw, NGW);
}
__device__ __forceinline__ void p4_convert_w2(Frame& F, const Ptrs& P) { cvt_run<1>(F, P, F.vcu * NWAVES + F.wave, F.G * NWAVES); }

__device__ __forceinline__ unsigned off_b(unsigned row, unsigned ch) { return 256u * row + 16u * (ch ^ (((row & 3) << 2) | ((row >> 2) & 3))); }
struct AttState2 { float m[2], l[2]; f32x4 O[2][8]; };

struct AttLane { unsigned choff[4]; };
__device__ __forceinline__ void att_lane_init(AttLane& L, int lane) {
    const unsigned i = lane & 15, g = lane >> 4;
#pragma unroll
    for (int j = 0; j < 4; ++j) L.choff[j] = 16u * (i ^ ((g << 2) | (unsigned)j));
}
__device__ __forceinline__ void k_load(bf16x8 (&kf)[2][4], const bf16* Kb, int S, int tb, int dil, int lane) {
    const int i = lane & 15, g = lane >> 4;
    const int kk_a = 8 * (i >> 2) + (i & 3);
#pragma unroll
    for (int t = 0; t < 2; ++t) { int tk = tb + dil * (kk_a + 4 * t); tk = max(0, min(tk, S - 1)); const bf16* kp = Kb + (size_t)tk * QKVW + 8 * g;
#pragma unroll
        for (int s = 0; s < 4; ++s) kf[t][s] = *(const bf16x8*)(kp + 32 * s); }
}
__device__ __forceinline__ void v_dma(LAS unsigned char* vbuf, const bf16* Vb, int S, int tb, int dil, int lane, const AttLane& L) {
    const int g = lane >> 4;
    if (tb >= 0 && tb + 31 * dil < S) {
        const char* p0 = (const char*)(Vb + (size_t)(tb + dil * g) * QKVW); const size_t rstep = (size_t)(4 * dil) * QKVW * 2;
#pragma unroll
        for (int c = 0; c < 8; ++c) __builtin_amdgcn_global_load_lds((const unsigned*)(p0 + c * rstep + L.choff[c & 3]), (LAS unsigned*)(vbuf + 1024 * c), 16, 0, 0);
    } else {
#pragma unroll
        for (int c = 0; c < 8; ++c) { int tk = tb + dil * (4 * c + g); tk = max(0, min(tk, S - 1));
            __builtin_amdgcn_global_load_lds((const unsigned*)((const char*)(Vb + (size_t)tk * QKVW) + L.choff[c & 3]), (LAS unsigned*)(vbuf + 1024 * c), 16, 0, 0); }
    }
    asm volatile("" ::: "memory");
}
template <int BUF>
__device__ __forceinline__ void kv_compute2(AttState2& st, bf16x8 (&kf)[2][4], const bf16x8 (&qf)[2][4], int S, int tb, int dil, const int (&mlo)[2], const unsigned (&mspan)[2],
                                            LAS unsigned char* vl, int lane, const AttLane& L, bool pf, const bf16* Kb, const bf16* Vb, int tbn) {
    const int g = lane >> 4;
    f32x4 sc[2][2];
#pragma unroll
    for (int q = 0; q < 2; ++q)
#pragma unroll
        for (int t = 0; t < 2; ++t) { sc[q][t] = (f32x4){0.f, 0.f, 0.f, 0.f};
#pragma unroll
            for (int s = 0; s < 4; ++s) sc[q][t] = __builtin_amdgcn_mfma_f32_16x16x32_bf16(kf[t][s], qf[q][s], sc[q][t], 0, 0, 0); }
    if (pf) v_dma(vl + (BUF ? 0 : 8192), Vb, S, tbn, dil, lane, L);
    bf16x8 pf16[2];
#pragma unroll
    for (int q = 0; q < 2; ++q) {
        const int x0 = tb + dil * 8 * g - mlo[q];
        float mx = -__builtin_inff();
#pragma unroll
        for (int t = 0; t < 2; ++t)
#pragma unroll
            for (int r = 0; r < 4; ++r) { const bool ok = (unsigned)(x0 + dil * (4 * t + r)) <= mspan[q]; sc[q][t][r] = ok ? sc[q][t][r] : -__builtin_inff(); mx = fmaxf(mx, sc[q][t][r]); }
        mx = fmaxf(mx, __shfl_xor(mx, 16)); mx = fmaxf(mx, __shfl_xor(mx, 32));
        if (__builtin_amdgcn_ballot_w64(mx > st.m[q] + 8.0f) != 0ull) {
            const float mn = fmaxf(st.m[q], mx), alpha = __builtin_amdgcn_exp2f(st.m[q] - mn);
            st.l[q] *= alpha; st.m[q] = mn;
#pragma unroll
            for (int dt = 0; dt < 8; ++dt) st.O[q][dt] *= alpha;
        }
        float ps = 0.f; float p[8];
#pragma unroll
        for (int t = 0; t < 2; ++t)
#pragma unroll
            for (int r = 0; r < 4; ++r) { p[4 * t + r] = __builtin_amdgcn_exp2f(sc[q][t][r] - st.m[q]); ps += p[4 * t + r]; }
        st.l[q] += ps;
        v4u pw; pw.x = pk2(p[0], p[1]); pw.y = pk2(p[2], p[3]); pw.z = pk2(p[4], p[5]); pw.w = pk2(p[6], p[7]);
        pf16[q] = __builtin_bit_cast(bf16x8, pw);
    }
    if (pf) asm volatile("s_waitcnt vmcnt(8)" ::: "memory"); else asm volatile("s_waitcnt vmcnt(0)" ::: "memory");
    const unsigned vb = (unsigned)(uintptr_t)vl;
#define TR4(k) asm volatile("ds_read_b64_tr_b16 %0, %4 offset:%8\n\tds_read_b64_tr_b16 %1, %5 offset:%8\n\tds_read_b64_tr_b16 %2, %6 offset:%8\n\tds_read_b64_tr_b16 %3, %7 offset:%8" \
        : "=&v"(f[k]), "=&v"(f[k + 1]), "=&v"(f[k + 2]), "=&v"(f[k + 3]) : "v"(a[k]), "v"(a[k + 1]), "v"(a[k + 2]), "v"(a[k + 3]), "i"(BUF ? 8192 : 0) : "memory")
#pragma unroll
    for (int hf = 0; hf < 2; ++hf) {
        unsigned a[8]; s16x4 f[8];
        int ln = lane; asm volatile("" : "+v"(ln));
        const unsigned g2 = ln >> 4, q2 = (ln & 15) >> 2, pp = ln & 3;
#pragma unroll
        for (int k = 0; k < 4; ++k) { const int dt = 4 * hf + k; a[2 * k] = vb + off_b(8 * g2 + q2, 2 * dt + (pp >> 1)) + 8 * (pp & 1); a[2 * k + 1] = vb + off_b(8 * g2 + 4 + q2, 2 * dt + (pp >> 1)) + 8 * (pp & 1); }
        TR4(0); TR4(4);
        asm volatile("s_waitcnt lgkmcnt(0)" : "+v"(f[0]), "+v"(f[1]), "+v"(f[2]), "+v"(f[3]), "+v"(f[4]), "+v"(f[5]), "+v"(f[6]), "+v"(f[7]) :: "memory");
#pragma unroll
        for (int k = 0; k < 4; ++k) { const int dt = 4 * hf + k;
            const bf16x8 vf = __builtin_shufflevector(f[2 * k], f[2 * k + 1], 0, 1, 2, 3, 4, 5, 6, 7);
            st.O[0][dt] = __builtin_amdgcn_mfma_f32_16x16x32_bf16(vf, pf16[0], st.O[0][dt], 0, 0, 0);
            st.O[1][dt] = __builtin_amdgcn_mfma_f32_16x16x32_bf16(vf, pf16[1], st.O[1][dt], 0, 0, 0); }
    }
#undef TR4
    if (pf) { asm volatile("" ::: "memory"); k_load(kf, Kb, S, tbn, dil, lane); }
}
__device__ __forceinline__ void attn_keys2(AttState2& st, const bf16x8 (&qf)[2][4], const bf16* Kb, const bf16* Vb, int S, const int (&tq)[2], int kstart, int dil, int ntiles, int W,
                                           LAS unsigned char* vl, int lane, const AttLane& L) {
    bf16x8 kf[2][4]; const int tstep = 32 * dil;
    int mlo[2]; unsigned mspan[2];
#pragma unroll
    for (int q = 0; q < 2; ++q) { mlo[q] = max(tq[q] - W, 0); mspan[q] = (unsigned)(min(tq[q] + W, S - 1) - mlo[q]); }
    v_dma(vl, Vb, S, kstart, dil, lane, L); k_load(kf, Kb, S, kstart, dil, lane);
    for (int tile = 0; tile < ntiles; tile += 2) {
        const int tb = kstart + tile * tstep;
        const bool m1 = tile + 1 < ntiles;
        kv_compute2<0>(st, kf, qf, S, tb, dil, mlo, mspan, vl, lane, L, m1, Kb, Vb, tb + tstep);
        if (!m1) break;
        const bool m2 = tile + 2 < ntiles;
        kv_compute2<1>(st, kf, qf, S, tb + tstep, dil, mlo, mspan, vl, lane, L, m2, Kb, Vb, tb + 2 * tstep);
    }
}

template <int HALFW> __device__ __forceinline__ void attn_phase(Frame& F, const Ptrs& P) {
    if (HALFW && F.wave >= 4) return;
    const bf16* QKV = (const bf16*)(P.ws + WS_QKV); bf16* YAB = (bf16*)P.out;
    LAS unsigned char* vl = F.lds + RING_OFF + F.wave * 16384;
    const int gw = HALFW ? F.vcu * 4 + F.wave : F.vcu * NWAVES + F.wave, NGW = HALFW ? F.G * 4 : F.G * NWAVES, lane = F.lane, i = lane & 15, g = lane >> 4;
    AttLane AL; att_lane_init(AL, lane);
    { constexpr int NT = (M / 512) * 8 * 16;
      for (int id = gw; id < NT; id += NGW) {
          const int r16 = id & 15, h = (id >> 4) & 7, rb = id >> 7;
          const int row_blk = rb * 512; const int seq0 = row_blk < 4096 ? 0 : (row_blk < 8192 ? 4096 : 8192); const int S = row_blk < 8192 ? 4096 : 16384;
          const int t0 = row_blk - seq0 + r16; const int tq[2] = {t0 + 16 * i, t0 + 256 + 16 * i};
          AttState2 st;
#pragma unroll
          for (int q = 0; q < 2; ++q) { st.m[q] = -1e30f; st.l[q] = 0.f;
#pragma unroll
              for (int dt = 0; dt < 8; ++dt) st.O[q][dt] = (f32x4){0.f, 0.f, 0.f, 0.f}; }
          const bf16* seqbase = QKV + (size_t)seq0 * QKVW;
#pragma unroll 1
          for (int grp = 0; grp < 3; ++grp) {
              const int dil = grp == 0 ? 1 : (grp == 1 ? 4 : 16); const int ntiles = grp == 0 ? 20 : (grp == 1 ? 8 : 5);
              const int hc = grp * 1024 + h * 128;
              bf16x8 qf[2][4];
#pragma unroll
              for (int q = 0; q < 2; ++q) { const bf16* qp = seqbase + (size_t)tq[q] * QKVW + hc + 8 * g;
#pragma unroll
                  for (int s = 0; s < 4; ++s) qf[q][s] = *(const bf16x8*)(qp + 32 * s); }
              attn_keys2(st, qf, seqbase + 3072 + hc, seqbase + 6144 + hc, S, tq, t0 - 64 * dil, dil, ntiles, 64 * dil, vl, lane, AL);
          }
#pragma unroll
          for (int q = 0; q < 2; ++q) { float l = st.l[q]; l += __shfl_xor(l, 16); l += __shfl_xor(l, 32); const float rl = 1.0f / l;
              bf16* op = YAB + (size_t)(seq0 + tq[q]) * YABW + h * 128 + 4 * g;
#pragma unroll
              for (int dt = 0; dt < 8; ++dt) { const f32x4 o = st.O[q][dt] * rl; v2u w; w.x = pk2(o[0], o[1]); w.y = pk2(o[2], o[3]); *(v2u*)(op + 16 * dt) = w; } }
      } }
    { constexpr int NT = (M / 16) * 8;
      for (int id = gw; id < NT; id += NGW) {
          const int pair = id & 7, blk = id >> 3; const int row0 = blk * 16;
          const int seq0 = row0 < 4096 ? 0 : (row0 < 8192 ? 4096 : 8192); const int S = row0 < 8192 ? 4096 : 16384;
          const int t0 = row0 - seq0; const int tq[2] = {t0 + i, t0 + i};
          AttState2 st;
#pragma unroll
          for (int q = 0; q < 2; ++q) { st.m[q] = -1e30f; st.l[q] = 0.f;
#pragma unroll
              for (int dt = 0; dt < 8; ++dt) st.O[q][dt] = (f32x4){0.f, 0.f, 0.f, 0.f}; }
          const bf16* seqbase = QKV + (size_t)seq0 * QKVW; const int kvh = pair >> 1;
          bf16x8 qf[2][4];
#pragma unroll
          for (int q = 0; q < 2; ++q) { const bf16* qp = seqbase + (size_t)tq[q] * QKVW + 9216 + (2 * pair + q) * 128 + 8 * g;
#pragma unroll
              for (int s = 0; s < 4; ++s) qf[q][s] = *(const bf16x8*)(qp + 32 * s); }
          attn_keys2(st, qf, seqbase + 11264 + kvh * 128, seqbase + 11776 + kvh * 128, S, tq, t0 - 128, 1, 9, 128, vl, lane, AL);
#pragma unroll
          for (int q = 0; q < 2; ++q) { const int qh = 2 * pair + q; float l = st.l[q]; l += __shfl_xor(l, 16); l += __shfl_xor(l, 32);
              const float sk = P.sink[qh] * 1.4426950408889634f; const float m2 = fmaxf(st.m[q], sk); const float e1 = __builtin_amdgcn_exp2f(st.m[q] - m2);
              const float den = l * e1 + __builtin_amdgcn_exp2f(sk - m2); const float rl = e1 / den;
              bf16* op = YAB + (size_t)(seq0 + tq[q]) * YABW + 1024 + qh * 128 + 4 * g;
#pragma unroll
              for (int dt = 0; dt < 8; ++dt) { const f32x4 o = st.O[q][dt] * rl; v2u w; w.x = pk2(o[0], o[1]); w.y = pk2(o[2], o[3]); *(v2u*)(op + 16 * dt) = w; } }
      } }
}

__device__ __forceinline__ void final_norm(Frame& F, const Ptrs& P) {
    const int gw = F.vcu * NWAVES + F.wave, NGW = F.G * NWAVES; const float* ss3 = (const float*)(F.ctl + CW_SS3); const bf16* H3 = (const bf16*)(P.ws + WS_AB1);
    f32x4 gv[8][2];
#pragma unroll
    for (int j = 0; j < 8; ++j) { gv[j][0] = ((const f32x4*)P.gfin)[2 * (F.lane + 64 * j)]; gv[j][1] = ((const f32x4*)P.gfin)[2 * (F.lane + 64 * j) + 1]; }
    for (int m = gw; m < M; m += NGW) { const float rs = __builtin_amdgcn_rsqf(ss3[m] * (1.0f / 4096.0f) + 1e-6f);
        const GAS v4u* hi = (const GAS v4u*)(H3 + (size_t)m * D) + F.lane; GAS f32x4* o = (GAS f32x4*)(P.out + (size_t)m * D) + 2 * F.lane;
#pragma unroll
        for (int j = 0; j < 8; ++j) { const v4u w = hi[64 * j];
            const f32x4 v0 = {pg8::bf_lo(w.x), pg8::bf_hi(w.x), pg8::bf_lo(w.y), pg8::bf_hi(w.y)}, v1 = {pg8::bf_lo(w.z), pg8::bf_hi(w.z), pg8::bf_lo(w.w), pg8::bf_hi(w.w)};
            o[128 * j] = v0 * rs * gv[j][0]; o[128 * j + 1] = v1 * rs * gv[j][1]; } }
}

struct Args { const float* in[17]; float* out; unsigned char* ws; int ph_lo, ph_hi, li, pad; };
__global__ void __launch_bounds__(NWAVES * 64, 2) mk_fwd(Args args) {
    extern __shared__ __attribute__((aligned(16))) unsigned char lds[];
    Frame F;
    F.lds = (LAS unsigned char*)lds;
    F.MISC = (volatile LAS unsigned*)(F.lds + MISC_OFF);
    F.tid = threadIdx.x; F.lane = F.tid & 63; F.wave = __builtin_amdgcn_readfirstlane(F.tid >> 6);
    F.G = gridDim.x; { const int bx = blockIdx.x; F.vcu = (F.G % 8 == 0) ? (bx % 8) * (F.G / 8) + bx / 8 : bx; }
    unsigned char* ws = args.ws;
    F.ctl = (gu32*)(ws + WS_CTL);
    Ptrs P;
    P.xp = args.in[0]; P.xs = args.in[1]; P.g1 = args.in[2]; P.w1g = args.in[3]; P.w1u = args.in[4]; P.w1d = args.in[5]; P.gmix = args.in[6]; P.win = args.in[7]; P.sink = args.in[8];
    P.wa = args.in[9]; P.wb = args.in[10]; P.wout = args.in[11]; P.g2 = args.in[12]; P.w2g = args.in[13]; P.w2u = args.in[14]; P.w2d = args.in[15]; P.gfin = args.in[16];
    P.out = args.out; P.ws = ws;
    for (int u = F.tid; u < (LDS_BYTES - LDSCTL_OFF) / 4; u += NWAVES * 64) ((LAS unsigned*)(F.lds + LDSCTL_OFF))[u] = 0u;
    __syncthreads();
    XcdBarrier bar; bar.bar = (unsigned*)(F.ctl + CW_BAR); bar.x = 0; bar.st = nullptr;
    if (N_LAUNCHES != PER_PHASE) bar = xcd_barrier_post((unsigned*)(F.ctl + CW_BAR), F.MISC + 8);
#define GRID_BAR(seam) do { if (N_LAUNCHES != PER_PHASE) xcd_barrier(bar); } while (0)
    const int lo = args.ph_lo, hi = args.ph_hi;
#define IN(k) (lo <= (k) && (k) < hi)
#define BOTH(k) (IN(k) && IN((k) + 1))
    bf16* AB1 = (bf16*)(ws + WS_AB1); bf16* ACT = (bf16*)(ws + WS_ACT); bf16* QKVB = (bf16*)(ws + WS_QKV);
    bf16* WGU = (bf16*)(ws + WS_WGU); bf16* WDN = (bf16*)(ws + WS_WD); bf16* WIN = (bf16*)(ws + WS_WIN); bf16* WAB = (bf16*)(ws + WS_WAB); bf16* WOUT = (bf16*)(ws + WS_WOUT);
    float* ss0 = (float*)(ws + WS_SS0); float* ss1 = (float*)(F.ctl + CW_SS1); float* ss2 = (float*)(F.ctl + CW_SS2); float* ss3 = (float*)(F.ctl + CW_SS3);
    const float* rope = (const float*)(ws + WS_ROPE);

    if (IN(0)) { for (int rep = 0; rep < NREP(0); ++rep) p0_prologue(F, P); if (BOTH(0)) GRID_BAR(0); }
    if (IN(1)) { pg8::Gemm g{AB1, WGU, M, 2 * FF, D}; pg8::StaticOrder S; S.init(M, 2 * FF, F.G, (int)blockIdx.x, WGM_UP);
        pg8::EpiSwiglu E{ACT, FF, ss0, F.lds + SSL_OFF};
        for (int rep = 0; rep < NREP(1); ++rep)
        pg8::gemm_phase<pg8::EpiSwiglu, pg8::StaticOrder, PG8_ALIGN, PG8_SP2>(F.lds + RING_OFF, g, S, E);
        {
          const int nwg = (M / 256) * (2 * FF / 256), rem = nwg % F.G, c = (int)blockIdx.x;
          if (rem == 0) cvt_run<2>(F, P, c * NWAVES + F.wave, F.G * NWAVES);
          else if (c >= rem) cvt_run<2>(F, P, (c - rem) * NWAVES + F.wave, (F.G - rem) * NWAVES); }
        if (PROBE_REPEAT == 21) { pg8::FixedOrder S2; S2.init(M, 2 * FF, F.G, (int)blockIdx.x); pg8::EpiSwiglu E2{QKVB, FF, ss0, F.lds + SSL_OFF};
            pg8::gemm_phase<pg8::EpiSwiglu, pg8::FixedOrder, PG8_ALIGN, PG8_SP2>(F.lds + RING_OFF, g, S2, E2); }
        if (BOTH(1)) GRID_BAR(1); }
    if (IN(2) && PROBE_REPEAT >= 100 && PROBE_REPEAT < 104) {
        pg8::Gemm g{AB1, WGU, M, 2 * FF, D}; pg8::StaticOrder S; S.init(M, 2 * FF, F.G, (int)blockIdx.x, WGM_UP);
        pg8::EpiSwigluT<(PROBE_REPEAT >= 100 ? PROBE_REPEAT - 100 : 0)> E{QKVB, FF, ss0, F.lds + SSL_OFF};
        pg8::gemm_phase<pg8::EpiSwigluT<(PROBE_REPEAT >= 100 ? PROBE_REPEAT - 100 : 0)>, pg8::StaticOrder, PG8_ALIGN, PG8_SP2>(F.lds + RING_OFF, g, S, E);
        GRID_BAR(1); }
    if (IN(2)) { if (STAGGER_TICKS) xcd_stagger(STAGGER_TICKS); pg8::Gemm g{ACT, WDN, M, D, FF}; pg8::StaticOrder S; S.init(M, D, F.G, (int)blockIdx.x, WGM_DOWN);
        pg8::EpiResid<true, false, true, true> E{AB1, AB1, M, nullptr, AB1, ss1, 0.5f};
        pg8::gemm_phase<pg8::EpiResid<true, false, true, true>, pg8::StaticOrder, PG8_ALIGN, PG8_SP2>(F.lds + RING_OFF, g, S, E);
        if (BOTH(2)) GRID_BAR(2); }
    if (IN(3)) { pg8::Gemm g{AB1, WIN, M, NIN, D}; pg8::StaticOrder S; S.init(M, NIN, F.G, (int)blockIdx.x, WGM_IN);
        pg8::EpiProj E{QKVB, ACT, ss1, rope, F.lds + SSL_OFF};
        pg8::gemm_phase<pg8::EpiProj, pg8::StaticOrder, PG8_ALIGN, PG8_SP2>(F.lds + RING_OFF, g, S, E);
        if (NREP(3) == 2) pg8::gemm_phase<pg8::EpiProj, pg8::StaticOrder, PG8_ALIGN, PG8_SP2>(F.lds + RING_OFF, g, S, E);
        if (BOTH(3)) GRID_BAR(3); }
    if (IN(4)) { for (int rep = 0; rep < NREP(4); ++rep) attn_phase<(PROBE_REPEAT == 42) ? 1 : 0>(F, P); for (int rep = 0; rep < NREP(14); ++rep) p4_convert_w2(F, P); if (BOTH(4)) GRID_BAR(4); }
    if (IN(5)) { pg8::Gemm g{(const bf16*)P.out, WAB, M, D, YABW}; pg8::StaticOrder S; S.init(M, D, F.G, (int)blockIdx.x, WGM_DOWN);
        pg8::EpiMerge E{ACT, QKVB};
        for (int rep = 0; rep < NREP(5); ++rep)
        pg8::gemm_phase<pg8::EpiMerge, pg8::StaticOrder, PG8_ALIGN, PG8_SP2>(F.lds + RING_OFF, g, S, E);
        if (BOTH(5)) GRID_BAR(5); }
    if (IN(6)) { if (STAGGER_TICKS) xcd_stagger(STAGGER_TICKS); pg8::Gemm g{QKVB, WOUT, M, D, D}; pg8::StaticOrder S; S.init(M, D, F.G, (int)blockIdx.x, WGM_DOWN);
        pg8::EpiResid<true, false, true, true> E{AB1, AB1, M, nullptr, AB1, ss2, 1.0f};
        pg8::gemm_phase<pg8::EpiResid<true, false, true, true>, pg8::StaticOrder, PG8_ALIGN, PG8_SP2>(F.lds + RING_OFF, g, S, E);
        if (BOTH(6)) GRID_BAR(6); }
    if (IN(7)) { pg8::Gemm g{AB1, WGU, M, 2 * FF, D}; pg8::StaticOrder S; S.init(M, 2 * FF, F.G, (int)blockIdx.x, WGM_UP);
        pg8::EpiSwiglu E{ACT, FF, ss2, F.lds + SSL_OFF};
        pg8::gemm_phase<pg8::EpiSwiglu, pg8::StaticOrder, PG8_ALIGN, PG8_SP2>(F.lds + RING_OFF, g, S, E);
        {
          const int nwg = (M / 256) * (2 * FF / 256), rem = nwg % F.G, c = (int)blockIdx.x;
          if (rem == 0) cvt_run<3>(F, P, c * NWAVES + F.wave, F.G * NWAVES);
          else if (c >= rem) cvt_run<3>(F, P, (c - rem) * NWAVES + F.wave, (F.G - rem) * NWAVES); }
        if (BOTH(7)) GRID_BAR(7); }
    if (IN(8)) { if (STAGGER_TICKS) xcd_stagger(STAGGER_TICKS); pg8::Gemm g{ACT, WDN, M, D, FF}; pg8::StaticOrder S; S.init(M, D, F.G, (int)blockIdx.x, WGM_DOWN);
        pg8::EpiResid<true, false, true, true> E{AB1, AB1, M, nullptr, AB1, ss3, 0.5f};
        pg8::gemm_phase<pg8::EpiResid<true, false, true, true>, pg8::StaticOrder, PG8_ALIGN, PG8_SP2>(F.lds + RING_OFF, g, S, E);
        if (BOTH(8)) GRID_BAR(8); }
    if (IN(9)) { final_norm(F, P); }
#undef IN
#undef BOTH
#undef GRID_BAR
}

extern "C" void kernel_launch(void* const* d_in, const int* in_sizes, int n_in, void* d_out, int out_size, void* d_ws, size_t ws_size, hipStream_t stream) {
    static int grid = 0;
    if (grid == 0) {
        if (n_in != 17 || out_size != M * D || ws_size < WS_END) { fprintf(stderr, "kernel_launch: unexpected shapes (n_in %d, out %d, ws %zu, need %zu)\n", n_in, out_size, ws_size, (size_t)WS_END); grid = -1; return; }
        int dev = 0, cus = 0, per_cu = 0;
        if (hipGetDevice(&dev) != hipSuccess || hipDeviceGetAttribute(&cus, hipDeviceAttributeMultiprocessorCount, dev) != hipSuccess) { grid = -1; return; }
        if (hipFuncSetAttribute((const void*)mk_fwd, hipFuncAttributeMaxDynamicSharedMemorySize, LDS_BYTES) != hipSuccess) { fprintf(stderr, "kernel_launch: hipFuncSetAttribute failed\n"); grid = -1; return; }
        if (hipOccupancyMaxActiveBlocksPerMultiprocessor(&per_cu, (const void*)mk_fwd, NWAVES * 64, LDS_BYTES) != hipSuccess || per_cu < 1) { fprintf(stderr, "kernel_launch: occupancy query says %d\n", per_cu); }
        (void)hipGetLastError();
        grid = cus;
    }
    if (grid < 0) return;
    (void)hipMemsetAsync((char*)d_ws + WS_CTL, 0, CTL_ZERO_BYTES, stream);
    Args a{};
    for (int i = 0; i < 17; ++i) a.in[i] = (const float*)d_in[i];
    a.out = (float*)d_out; a.ws = (unsigned char*)d_ws; a.pad = 0;
    for (int li = 0; li < N_LAUNCHES; ++li) {
        a.ph_lo = (N_LAUNCHES == PER_PHASE) ? li : 0; a.ph_hi = (N_LAUNCHES == PER_PHASE) ? li + 1 : PER_PHASE; a.li = li;
        hipLaunchKernelGGL(mk_fwd, dim3(grid), dim3(NWAVES * 64), LDS_BYTES, stream, a);
    }
}
```

```cpp
#include <hip/hip_runtime.h>
#include <cstdio>
#include <cstdint>

#ifndef MK_N_LAUNCHES
#define MK_N_LAUNCHES 1
#endif
#ifndef PROBE_REPEAT
#define PROBE_REPEAT -1
#endif
#define NREP(k) ((PROBE_REPEAT == (k)) ? 2 : 1)
#ifndef WGM_DOWN
#define WGM_DOWN 4
#endif
#ifndef WGM_UP
#define WGM_UP 8
#endif
#ifndef WGM_IN
#define WGM_IN 8
#endif
#ifndef RES_DEPTH
#define RES_DEPTH 8
#endif
#ifndef RES_DEPTH_F
#define RES_DEPTH_F 4
#endif
#ifndef STAGGER_TICKS
#define STAGGER_TICKS 0
#endif

namespace pg8 {
#define PG8_LAS __attribute__((address_space(3)))
typedef unsigned short bf16_t;
typedef short bf16x8 __attribute__((ext_vector_type(8)));
typedef float f32x4 __attribute__((ext_vector_type(4)));
typedef unsigned u32x4 __attribute__((ext_vector_type(4)));
constexpr int BM = 256, BK = 64, HALF = 128, HTB = HALF * BK * 2, STAGE_BYTES = 8 * HTB, NXCD = 8, WGM = 8;

__host__ __device__ __forceinline__ int lds_byte(int r, int c) { const int st = (r >> 4) * 2 + (c >> 5), rr = r & 15, cc = c & 31, ob = rr * 64 + cc * 2; return st * 1024 + (ob ^ (((ob >> 9) & 1) << 5)); }
__host__ __device__ __forceinline__ void stage_rc(int b, int& R, int& C) { const int st = b / 1024, sb = b % 1024, swz = sb ^ (((sb >> 9) & 1) << 5); R = (st >> 1) * 16 + swz / 64; C = (st & 1) * 32 + (swz % 64) / 2; }
__host__ __device__ __forceinline__ int perm32(int rho) { const int n = rho >> 4, i = rho & 15; return 8 * (i >> 2) + 4 * n + (i & 3); }

struct Unit { int pm, pn; };
__device__ __forceinline__ void ss_prefetch(const float* ss, PG8_LAS unsigned char* ssl, int pm, int wid, int lane) {
    const float* src = ss + pm * 256 + (wid >> 2) * 64 + lane;
    __builtin_amdgcn_global_load_lds((const unsigned*)src, (PG8_LAS unsigned*)(ssl + wid * 512), 4, 0, 0);
    __builtin_amdgcn_global_load_lds((const unsigned*)(src + 128), (PG8_LAS unsigned*)(ssl + wid * 512 + 256), 4, 0, 0);
}
__device__ __forceinline__ float ss_lds(PG8_LAS unsigned char* ssl, int wr, int wc, int fr, int ai, int m) { return *(const PG8_LAS float*)(ssl + (wr * 4 + wc) * 512 + ai * 256 + (m * 16 + fr) * 4); }
struct Gemm { const bf16_t* A; const bf16_t* Bt; int M, N, K; };

struct StaticOrder {
    int nM, nN, nwg, G, c, wgm;
    __host__ __device__ void init(int M, int N, int G_, int c_, int wgm_ = WGM) { nM = M / BM; nN = N / BM; nwg = nM * nN; G = G_; c = c_; wgm = wgm_; }
    __host__ __device__ bool next(int i, Unit& u) const {
        const long L = (long)i * G + c; if (L >= nwg) return false;
        int wgid = (int)L; { const int q = nwg / NXCD, r = nwg % NXCD, xcd = wgid % NXCD, off = wgid / NXCD; wgid = (xcd < r ? xcd * (q + 1) : r * (q + 1) + (xcd - r) * q) + off; }
        const int nig = wgm * nN, gid = wgid / nig, fm = gid * wgm, gsz = (nM - fm) < wgm ? (nM - fm) : wgm;
        u.pm = fm + ((wgid % nig) % gsz); u.pn = (wgid % nig) / gsz; return true;
    }
    __device__ __forceinline__ void a_ready(const Unit&) const {}
    __device__ __forceinline__ void done(const Unit&) const {}
};

struct FixedOrder : StaticOrder {
    __host__ __device__ bool next(int i, Unit& u) const { Unit t; if (!StaticOrder::next(i, t)) return false; u.pm = 0; u.pn = 0; return true; }
};
__device__ __forceinline__ unsigned cvt_pk_bf16(float lo, float hi) { unsigned r; asm volatile("v_cvt_pk_bf16_f32 %0, %1, %2" : "=v"(r) : "v"(lo), "v"(hi)); return r; }
__device__ __forceinline__ float bf_lo(unsigned w) { return __uint_as_float(w << 16); }
__device__ __forceinline__ float bf_hi(unsigned w) { return __uint_as_float(w & 0xffff0000u); }
__device__ __forceinline__ float xsum_16_32(float x) {
    auto r = __builtin_amdgcn_permlane16_swap(__float_as_uint(x), __float_as_uint(x), false, false); x = __uint_as_float(r[0]) + __uint_as_float(r[1]);
    auto q = __builtin_amdgcn_permlane32_swap(__float_as_uint(x), __float_as_uint(x), false, false); return __uint_as_float(q[0]) + __uint_as_float(q[1]); }
__device__ __forceinline__ float xmax_16_32(float x) {
    auto r = __builtin_amdgcn_permlane16_swap(__float_as_uint(x), __float_as_uint(x), false, false); x = fmaxf(__uint_as_float(r[0]), __uint_as_float(r[1]));
    auto q = __builtin_amdgcn_permlane32_swap(__float_as_uint(x), __float_as_uint(x), false, false); return fmaxf(__uint_as_float(q[0]), __uint_as_float(q[1])); }
__device__ __forceinline__ float sigmoid_f(float x) { return __builtin_amdgcn_rcpf(1.0f + __builtin_amdgcn_exp2f(-1.44269504089f * x)); }

__device__ __forceinline__ unsigned ror8(unsigned x) { return (unsigned)__builtin_amdgcn_mov_dpp((int)x, 0x128, 0xf, 0xf, true); }
__device__ __forceinline__ u32x4 ror8(const u32x4 v) { u32x4 r; r.x = ror8(v.x); r.y = ror8(v.y); r.z = ror8(v.z); r.w = ror8(v.w); return r; }
__device__ __forceinline__ u32x4 sel4(bool c, const u32x4 a, const u32x4 b) { u32x4 r; r.x = c ? a.x : b.x; r.y = c ? a.y : b.y; r.z = c ? a.z : b.z; r.w = c ? a.w : b.w; return r; }
__device__ __forceinline__ void pair_to_lines(const u32x4 X, const u32x4 Y, bool lo8, u32x4& D1, u32x4& D2) { D1 = sel4(lo8, X, ror8(Y)); D2 = sel4(lo8, ror8(X), Y); }
__device__ __forceinline__ void lines_to_pair(const u32x4 L1, const u32x4 L2, bool lo8, u32x4& X, u32x4& Y) { X = sel4(lo8, L1, ror8(L2)); Y = sel4(lo8, ror8(L1), L2); }


template <int MODE> struct EpiSwigluT {
    static constexpr bool PERM = true, AFTER_DRAIN = false, HAS_MID = false, SS_LDS = true, ADJ = false; static constexpr int MID_T = 0, VM_TAIL = (MODE & 1) ? 0 : 8;
    bf16_t* O; int ldc; const float* ss; PG8_LAS unsigned char* ssl;
    __device__ __forceinline__ void mid(f32x4 (&)[2][2][4][2], const Unit&, int, int, int, int) const {}
    __device__ __forceinline__ void operator()(f32x4 (&acc)[2][2][4][2], const Unit& u, int wr, int wc, int fr, int fq) const {
        const int row0 = u.pm * BM + wr * 64 + fr, col0 = u.pn * HALF + wc * 32 + 8 * fq;
        float rs[2][4];
#pragma unroll
        for (int ai = 0; ai < 2; ++ai)
#pragma unroll
            for (int m = 0; m < 4; ++m) rs[ai][m] = (MODE & 2) ? 4096.0f * (float)(fr + 1) : ss_lds(ssl, wr, wc, fr, ai, m);
#pragma unroll
        for (int ai = 0; ai < 2; ++ai)
#pragma unroll
            for (int m = 0; m < 4; ++m) { const int r = row0 + ai * HALF + m * 16; const float rr = __builtin_amdgcn_rsqf(rs[ai][m] * (1.0f / 4096.0f) + 1e-6f);
                const float c1 = -1.44269504089f * rr, rr2 = rr * rr; f32x4 o[2];
#pragma unroll
                for (int n = 0; n < 2; ++n) { const f32x4 g = acc[ai][0][m][n], up = acc[ai][1][m][n]; const f32x4 t = g * c1;
                    f32x4 d = {__builtin_amdgcn_exp2f(t[0]), __builtin_amdgcn_exp2f(t[1]), __builtin_amdgcn_exp2f(t[2]), __builtin_amdgcn_exp2f(t[3])}; d = d + 1.0f;
                    const f32x4 q = {__builtin_amdgcn_rcpf(d[0]), __builtin_amdgcn_rcpf(d[1]), __builtin_amdgcn_rcpf(d[2]), __builtin_amdgcn_rcpf(d[3])};
                    o[n] = ((g * up) * rr2) * q; }
                u32x4 w; w.x = cvt_pk_bf16(o[0][0], o[0][1]); w.y = cvt_pk_bf16(o[0][2], o[0][3]); w.z = cvt_pk_bf16(o[1][0], o[1][1]); w.w = cvt_pk_bf16(o[1][2], o[1][3]);
                if (MODE & 1) asm volatile("" :: "v"(w.x), "v"(w.y), "v"(w.z), "v"(w.w)); else *(u32x4*)(O + (size_t)r * ldc + col0) = w; }
    }
};
using EpiSwiglu = EpiSwigluT<0>;

template <bool BASE_BF16, bool OUT_F32, bool HAS_OB, bool ADJ_ = false> struct EpiResid {
    static constexpr bool PERM = true, AFTER_DRAIN = false, HAS_MID = false, SS_LDS = false, ADJ = ADJ_; static constexpr int MID_T = 0, VM_TAIL = (HAS_OB || OUT_F32) ? 16 : 0;
    const void* base_lo; const void* base_hi; int split_row; float* out; bf16_t* ob; float* ss; float scale;
    __device__ __forceinline__ void mid(f32x4 (&)[2][2][4][2], const Unit&, int, int, int, int) const {}
    __device__ __forceinline__ void operator()(f32x4 (&acc)[2][2][4][2], const Unit& u, int wr, int wc, int fr, int fq) const {
        if constexpr (ADJ_) {
            static_assert(BASE_BF16 && HAS_OB && !OUT_F32, "ADJ residual epilogue: bf16 base, bf16 output");
            const bool lo8 = fr < 8; const int rb = u.pm * BM + wr * 64, row0 = rb + fr;
            const size_t lane_off = (size_t)(rb + (fr & 7)) * 4096 + u.pn * BM + wc * 64 + 32 * (fr >> 3) + 8 * fq;
            const bf16_t* bb = (const bf16_t*)((u.pm * BM < split_row) ? base_lo : base_hi) - ((u.pm * BM < split_row) ? (size_t)0 : (size_t)split_row * 4096);
            u32x4 tb[8][2];
#pragma unroll
            for (int k = 0; k < 8; ++k) { const size_t o_ = lane_off + (size_t)((k >> 2) * HALF + (k & 3) * 16) * 4096; tb[k][0] = *(const u32x4*)(bb + o_); tb[k][1] = *(const u32x4*)(bb + o_ + 8 * 4096); }
#pragma unroll
            for (int k = 0; k < 8; ++k) { const int ai = k >> 2, m = k & 3; u32x4 w[2]; lines_to_pair(tb[k][0], tb[k][1], lo8, w[0], w[1]);
#pragma unroll
                for (int bj = 0; bj < 2; ++bj) {
                    acc[ai][bj][m][0] = (f32x4){bf_lo(w[bj].x), bf_hi(w[bj].x), bf_lo(w[bj].y), bf_hi(w[bj].y)} + acc[ai][bj][m][0] * scale;
                    acc[ai][bj][m][1] = (f32x4){bf_lo(w[bj].z), bf_hi(w[bj].z), bf_lo(w[bj].w), bf_hi(w[bj].w)} + acc[ai][bj][m][1] * scale; }
                asm volatile("" : "+v"(acc[ai][0][m][0]), "+v"(acc[ai][0][m][1]), "+v"(acc[ai][1][m][0]), "+v"(acc[ai][1][m][1]));
                __builtin_amdgcn_sched_barrier(0); }
#pragma unroll
            for (int k = 0; k < 8; ++k) { const int ai = k >> 2, m = k & 3; const int r = row0 + ai * HALF + m * 16; float sq = 0.f; u32x4 w[2];
#pragma unroll
                for (int bj = 0; bj < 2; ++bj) { const f32x4 v0 = acc[ai][bj][m][0], v1 = acc[ai][bj][m][1];
                    sq += (v0[0] * v0[0] + v0[1] * v0[1]) + (v0[2] * v0[2] + v0[3] * v0[3]) + (v1[0] * v1[0] + v1[1] * v1[1]) + (v1[2] * v1[2] + v1[3] * v1[3]);
                    w[bj].x = cvt_pk_bf16(v0[0], v0[1]); w[bj].y = cvt_pk_bf16(v0[2], v0[3]); w[bj].z = cvt_pk_bf16(v1[0], v1[1]); w[bj].w = cvt_pk_bf16(v1[2], v1[3]); }
                u32x4 d1, d2; pair_to_lines(w[0], w[1], lo8, d1, d2);
                const size_t o_ = lane_off + (size_t)(ai * HALF + m * 16) * 4096; *(u32x4*)(ob + o_) = d1; *(u32x4*)(ob + o_ + 8 * 4096) = d2;
                sq = xsum_16_32(sq);
                if (fq == 0) __hip_atomic_fetch_add(ss + r, sq, __ATOMIC_RELAXED, __HIP_MEMORY_SCOPE_AGENT); }
            return;
        }
        const int row0 = u.pm * BM + wr * 64 + fr, col0 = u.pn * BM + wc * 32 + 8 * fq;
        if constexpr (BASE_BF16) {
            const bf16_t* bb = (const bf16_t*)((u.pm * BM < split_row) ? base_lo : base_hi) - ((u.pm * BM < split_row) ? (size_t)0 : (size_t)split_row * 4096);
            u32x4 tb[RES_DEPTH][2];
#define RES_LOAD(k) do { const size_t off_ = (size_t)(row0 + ((k) >> 2) * HALF + ((k) & 3) * 16) * 4096 + col0; \
                tb[(k) % RES_DEPTH][0] = *(const u32x4*)(bb + off_); tb[(k) % RES_DEPTH][1] = *(const u32x4*)(bb + off_ + HALF); } while (0)
#pragma unroll
            for (int k = 0; k < RES_DEPTH - 1; ++k) RES_LOAD(k);
#pragma unroll
            for (int k = 0; k < 8; ++k) { const int ai = k >> 2, m = k & 3;
                if (k + RES_DEPTH - 1 < 8) RES_LOAD(k + RES_DEPTH - 1);
#pragma unroll
                for (int bj = 0; bj < 2; ++bj) { const u32x4 w = tb[k % RES_DEPTH][bj];
                    acc[ai][bj][m][0] = (f32x4){bf_lo(w.x), bf_hi(w.x), bf_lo(w.y), bf_hi(w.y)} + acc[ai][bj][m][0] * scale;
                    acc[ai][bj][m][1] = (f32x4){bf_lo(w.z), bf_hi(w.z), bf_lo(w.w), bf_hi(w.w)} + acc[ai][bj][m][1] * scale; }
                asm volatile("" : "+v"(acc[ai][0][m][0]), "+v"(acc[ai][0][m][1]), "+v"(acc[ai][1][m][0]), "+v"(acc[ai][1][m][1]));
                __builtin_amdgcn_sched_barrier(0); }
#undef RES_LOAD
        } else {
            const float* bb = (const float*)((u.pm * BM < split_row) ? base_lo : base_hi) - ((u.pm * BM < split_row) ? (size_t)0 : (size_t)split_row * 4096);
            f32x4 tb[RES_DEPTH_F][4];
#define RES_LOAD(k) do { const size_t off_ = (size_t)(row0 + ((k) >> 2) * HALF + ((k) & 3) * 16) * 4096 + col0; \
                tb[(k) % RES_DEPTH_F][0] = __builtin_nontemporal_load((const f32x4*)(bb + off_)); tb[(k) % RES_DEPTH_F][1] = __builtin_nontemporal_load((const f32x4*)(bb + off_ + 4)); tb[(k) % RES_DEPTH_F][2] = __builtin_nontemporal_load((const f32x4*)(bb + off_ + HALF)); tb[(k) % RES_DEPTH_F][3] = __builtin_nontemporal_load((const f32x4*)(bb + off_ + HALF + 4)); } while (0)
#pragma unroll
            for (int k = 0; k < RES_DEPTH_F - 1; ++k) RES_LOAD(k);
#pragma unroll
            for (int k = 0; k < 8; ++k) { const int ai = k >> 2, m = k & 3;
                if (k + RES_DEPTH_F - 1 < 8) RES_LOAD(k + RES_DEPTH_F - 1);
                acc[ai][0][m][0] = tb[k % RES_DEPTH_F][0] + acc[ai][0][m][0] * scale; acc[ai][0][m][1] = tb[k % RES_DEPTH_F][1] + acc[ai][0][m][1] * scale;
                acc[ai][1][m][0] = tb[k % RES_DEPTH_F][2] + acc[ai][1][m][0] * scale; acc[ai][1][m][1] = tb[k % RES_DEPTH_F][3] + acc[ai][1][m][1] * scale;
                asm volatile("" : "+v"(acc[ai][0][m][0]), "+v"(acc[ai][0][m][1]), "+v"(acc[ai][1][m][0]), "+v"(acc[ai][1][m][1]));
                __builtin_amdgcn_sched_barrier(0); }
#undef RES_LOAD
        }
#pragma unroll
        for (int ai = 0; ai < 2; ++ai)
#pragma unroll
            for (int m = 0; m < 4; ++m) { const int r = row0 + ai * HALF + m * 16; const size_t off = (size_t)r * 4096 + col0; float sq = 0.f;
#pragma unroll
                for (int bj = 0; bj < 2; ++bj) { const f32x4 v0 = acc[ai][bj][m][0], v1 = acc[ai][bj][m][1];
                    if (OUT_F32) { *(f32x4*)(out + off + bj * HALF) = v0; *(f32x4*)(out + off + bj * HALF + 4) = v1; }
                    sq += (v0[0] * v0[0] + v0[1] * v0[1]) + (v0[2] * v0[2] + v0[3] * v0[3]) + (v1[0] * v1[0] + v1[1] * v1[1]) + (v1[2] * v1[2] + v1[3] * v1[3]);
                    if (HAS_OB) { u32x4 w; w.x = cvt_pk_bf16(v0[0], v0[1]); w.y = cvt_pk_bf16(v0[2], v0[3]); w.z = cvt_pk_bf16(v1[0], v1[1]); w.w = cvt_pk_bf16(v1[2], v1[3]); *(u32x4*)(ob + off + bj * HALF) = w; } }
                sq = xsum_16_32(sq);
                if (fq == 0) __hip_atomic_fetch_add(ss + r, sq, __ATOMIC_RELAXED, __HIP_MEMORY_SCOPE_AGENT); }
    }
};

struct EpiProj {
    static constexpr bool PERM = true, AFTER_DRAIN = false, HAS_MID = false, SS_LDS = true, ADJ = true; static constexpr int MID_T = 0, VM_TAIL = 16;
    bf16_t* qkv; bf16_t* gates; const float* ss; const float* rope; PG8_LAS unsigned char* ssl;
    __device__ __forceinline__ void mid(f32x4 (&)[2][2][4][2], const Unit&, int, int, int, int) const {}
    __device__ __forceinline__ void operator()(f32x4 (&acc)[2][2][4][2], const Unit& u, int wr, int wc, int fr, int fq) const {
        const int pn = u.pn; const bool is_gate = pn >= 48, is_rope = (pn < 24) || (pn >= 36 && pn < 46);
        const int rb = u.pm * BM + wr * 64, row0 = rb + fr; const bool lo8 = fr < 8;
        const bool do_rope = is_rope && ((wc & 1) == 0); const float sgn = fq < 2 ? -1.0f : 1.0f;
        float rs[2][4];
#pragma unroll
        for (int ai = 0; ai < 2; ++ai)
#pragma unroll
            for (int m = 0; m < 4; ++m) rs[ai][m] = ss_lds(ssl, wr, wc, fr, ai, m);
#pragma unroll
        for (int ai = 0; ai < 2; ++ai)
#pragma unroll
            for (int m = 0; m < 4; ++m) { const int r = row0 + ai * HALF + m * 16; const float rr = __builtin_amdgcn_rsqf(rs[ai][m] * (1.0f / 4096.0f) + 1e-6f);
#pragma unroll
                for (int bj = 0; bj < 2; ++bj) { acc[ai][bj][m][0] *= rr; acc[ai][bj][m][1] *= rr; }
                if (do_rope) { const int pos = r < 8192 ? (r & 4095) : r - 8192; const float* tp = rope + (size_t)pos * 32 + 8 * (fq & 1);
                    const f32x4 c0 = *(const f32x4*)tp, c1 = *(const f32x4*)(tp + 4), s0 = *(const f32x4*)(tp + 16), s1 = *(const f32x4*)(tp + 20);
                    f32x4 v0 = acc[ai][0][m][0], v1 = acc[ai][0][m][1];
#pragma unroll
                    for (int j = 0; j < 4; ++j) { const float p0 = __shfl_xor(v0[j], 32), p1 = __shfl_xor(v1[j], 32); v0[j] = v0[j] * c0[j] + sgn * p0 * s0[j]; v1[j] = v1[j] * c1[j] + sgn * p1 * s1[j]; }
                    acc[ai][0][m][0] = v0; acc[ai][0][m][1] = v1; } }
#pragma unroll
        for (int ai = 0; ai < 2; ++ai)
#pragma unroll
            for (int m = 0; m < 4; ++m) {
                if (is_gate) {
                    bf16_t* gd = gates + (size_t)(row0 + ai * HALF + m * 16) * 8192 + (pn - 48) * HALF + wc * 32 + 8 * fq; f32x4 uu[2], sbv[2];
#pragma unroll
                    for (int n = 0; n < 2; ++n)
#pragma unroll
                        for (int j = 0; j < 4; ++j) { const float sa = sigmoid_f(acc[ai][0][m][n][j]), sb = sigmoid_f(acc[ai][1][m][n][j]); sbv[n][j] = sb; uu[n][j] = sa * __builtin_amdgcn_rcpf(fmaxf(sb, 1e-20f)); }
                    u32x4 w; w.x = cvt_pk_bf16(uu[0][0], uu[0][1]); w.y = cvt_pk_bf16(uu[0][2], uu[0][3]); w.z = cvt_pk_bf16(uu[1][0], uu[1][1]); w.w = cvt_pk_bf16(uu[1][2], uu[1][3]);
                    *(u32x4*)gd = w;
                    w.x = cvt_pk_bf16(sbv[0][0], sbv[0][1]); w.y = cvt_pk_bf16(sbv[0][2], sbv[0][3]); w.z = cvt_pk_bf16(sbv[1][0], sbv[1][1]); w.w = cvt_pk_bf16(sbv[1][2], sbv[1][3]);
                    *(u32x4*)(gd + 4096) = w;
                } else {
                    u32x4 w[2];
#pragma unroll
                    for (int bj = 0; bj < 2; ++bj) { const f32x4 v0 = acc[ai][bj][m][0], v1 = acc[ai][bj][m][1];
                        w[bj].x = cvt_pk_bf16(v0[0], v0[1]); w[bj].y = cvt_pk_bf16(v0[2], v0[3]); w[bj].z = cvt_pk_bf16(v1[0], v1[1]); w[bj].w = cvt_pk_bf16(v1[2], v1[3]); }
                    u32x4 d1, d2; pair_to_lines(w[0], w[1], lo8, d1, d2);
                    bf16_t* op = qkv + (size_t)(rb + (fr & 7) + ai * HALF + m * 16) * 12288 + pn * BM + wc * 64 + 32 * (fr >> 3) + 8 * fq; *(u32x4*)op = d1; *(u32x4*)(op + 8 * 12288) = d2; } }
    }
};

struct EpiMerge {
    static constexpr bool PERM = true, AFTER_DRAIN = false, HAS_MID = true, SS_LDS = false, ADJ = false; static constexpr int MID_T = 16, VM_TAIL = 16;
    const bf16_t* gates; bf16_t* O;
    static constexpr int MID_DEPTH = 4, END_DEPTH = 8;
    __device__ __forceinline__ void mid(f32x4 (&acc)[2][2][4][2], const Unit& u, int wr, int wc, int fr, int fq) const {
        const __amdgpu_buffer_rsrc_t rsG = __builtin_amdgcn_make_buffer_rsrc((void*)gates, (short)0, (int)0xffffffffu, 0x00020000);
        int vo = ((u.pm * BM + wr * 64 + fr) * 8192 + u.pn * BM + wc * 32 + 8 * fq) * 2; asm volatile("" : "+v"(vo));
        u32x4 ta[MID_DEPTH][2];
#define MG_LOAD(k) do { const int o_ = vo + (((k) >> 2) * HALF + ((k) & 3) * 16) * 16384; _Pragma("unroll") for (int bj = 0; bj < 2; ++bj) ta[(k) % MID_DEPTH][bj] = __builtin_amdgcn_raw_buffer_load_b128(rsG, o_ + bj * 256, 0, 0); } while (0)
#pragma unroll
        for (int k = 0; k < MID_DEPTH - 1; ++k) MG_LOAD(k);
#pragma unroll
        for (int k = 0; k < 8; ++k) { const int ai = k >> 2, m = k & 3;
            if (k + MID_DEPTH - 1 < 8) MG_LOAD(k + MID_DEPTH - 1);
#pragma unroll
            for (int bj = 0; bj < 2; ++bj) { const u32x4 a = ta[k % MID_DEPTH][bj];
                acc[ai][bj][m][0] *= (f32x4){bf_lo(a.x), bf_hi(a.x), bf_lo(a.y), bf_hi(a.y)}; acc[ai][bj][m][1] *= (f32x4){bf_lo(a.z), bf_hi(a.z), bf_lo(a.w), bf_hi(a.w)}; }
            asm volatile("" : "+v"(acc[ai][0][m][0]), "+v"(acc[ai][0][m][1]), "+v"(acc[ai][1][m][0]), "+v"(acc[ai][1][m][1]));
            __builtin_amdgcn_sched_barrier(0); }
#undef MG_LOAD
    }
    __device__ __forceinline__ void operator()(f32x4 (&acc)[2][2][4][2], const Unit& u, int wr, int wc, int fr, int fq) const {
        const int row0 = u.pm * BM + wr * 64 + fr, col0 = u.pn * BM + wc * 32 + 8 * fq;
        { const __amdgpu_buffer_rsrc_t rsG = __builtin_amdgcn_make_buffer_rsrc((void*)gates, (short)0, (int)0xffffffffu, 0x00020000);
          const int vo = (row0 * 8192 + col0) * 2;
          u32x4 tb[END_DEPTH][2];
#define MG_LOAD(k) do { const int o_ = vo + (((k) >> 2) * HALF + ((k) & 3) * 16) * 16384; _Pragma("unroll") for (int bj = 0; bj < 2; ++bj) tb[(k) % END_DEPTH][bj] = __builtin_amdgcn_raw_buffer_load_b128(rsG, o_ + bj * 256, 8192, 0); } while (0)
#pragma unroll
          for (int k = 0; k < END_DEPTH - 1; ++k) MG_LOAD(k);
#pragma unroll
          for (int k = 0; k < 8; ++k) { const int ai = k >> 2, m = k & 3;
              if (k + END_DEPTH - 1 < 8) MG_LOAD(k + END_DEPTH - 1);
#pragma unroll
              for (int bj = 0; bj < 2; ++bj) { const u32x4 b = tb[k % END_DEPTH][bj]; f32x4 g0, g1;
                  g0[0] = fmaxf(bf_lo(b.x), 1e-20f); g0[1] = fmaxf(bf_hi(b.x), 1e-20f); g0[2] = fmaxf(bf_lo(b.y), 1e-20f); g0[3] = fmaxf(bf_hi(b.y), 1e-20f);
                  g1[0] = fmaxf(bf_lo(b.z), 1e-20f); g1[1] = fmaxf(bf_hi(b.z), 1e-20f); g1[2] = fmaxf(bf_lo(b.w), 1e-20f); g1[3] = fmaxf(bf_hi(b.w), 1e-20f);
                  acc[ai][bj][m][0] *= g0; acc[ai][bj][m][1] *= g1; }
              asm volatile("" : "+v"(acc[ai][0][m][0]), "+v"(acc[ai][0][m][1]), "+v"(acc[ai][1][m][0]), "+v"(acc[ai][1][m][1]));
              __builtin_amdgcn_sched_barrier(0); }
#undef MG_LOAD
        }
#pragma unroll
        for (int ai = 0; ai < 2; ++ai)
#pragma unroll
            for (int m = 0; m < 4; ++m) { const int r = row0 + ai * HALF + m * 16;
#pragma unroll
                for (int bj = 0; bj < 2; ++bj) { const f32x4 a0 = acc[ai][bj][m][0], a1 = acc[ai][bj][m][1];
                    u32x4 w; w.x = cvt_pk_bf16(a0[0], a0[1]); w.y = cvt_pk_bf16(a0[2], a0[3]); w.z = cvt_pk_bf16(a1[0], a1[1]); w.w = cvt_pk_bf16(a1[2], a1[3]);
                    *(u32x4*)(O + (size_t)r * 4096 + col0 + bj * HALF) = w; } }
    }
};

template <class Epi, class Sched, bool ALIGN_EPI = false, bool SP2 = false>
__device__ __forceinline__ void gemm_phase(PG8_LAS unsigned char* lds, const Gemm g, const Sched& S, const Epi& E) {
    const int tid = threadIdx.x, wid = __builtin_amdgcn_readfirstlane(tid >> 6), lane = tid & 63, wr = wid >> 2, wc = wid & 3, fr = lane & 15, fq = lane >> 4;
    const int K = g.K, nt = K / BK;
    unsigned voffA[2], voffB[2];
#pragma unroll
    for (int i = 0; i < 2; ++i) { int R, C; stage_rc(tid * 16 + i * 8192, R, C); const int Rb = Epi::PERM ? ((R & ~31) + perm32(R & 31)) : R;
        const int Rj = Epi::ADJ ? 64 * (R >> 5) + perm32(R & 31) : Rb;
        voffA[i] = (unsigned)(R * K + C) * 2u; voffB[i] = (unsigned)(Rj * K + C) * 2u; }
    const unsigned kstep = (unsigned)(BK * 2);
    const unsigned hstep = (unsigned)HALF * (unsigned)K * 2u;
    const unsigned tstep = 2u * hstep;
    const unsigned hB = Epi::ADJ ? 32u * (unsigned)K * 2u : hstep;
    const __amdgpu_buffer_rsrc_t rsA = __builtin_amdgcn_make_buffer_rsrc((void*)g.A, (short)0, (int)0xffffffffu, 0x00020000);
    const __amdgpu_buffer_rsrc_t rsB = __builtin_amdgcn_make_buffer_rsrc((void*)g.Bt, (short)0, (int)0xffffffffu, 0x00020000);
    const unsigned ldsw = (unsigned)wid * 1024u;
    const int aoff = lds_byte(wr * 64 + fr, fq * 8), boff = lds_byte(wc * 32 + fr, fq * 8);
#define PG8_SA(b, h) (((b) * 2 + (h)) * HTB)
#define PG8_SB(b, h) ((4 + (b) * 2 + (h)) * HTB)
#define PG8_STAGE(bufoff, rs, soff, voff) do { _Pragma("unroll") for (int _i = 0; _i < 2; ++_i) \
        __builtin_amdgcn_raw_ptr_buffer_load_lds(rs, (PG8_LAS unsigned*)(lds + (bufoff) + ldsw + _i * 8192), 16, (int)(voff)[_i], (int)(soff), 0, 0); } while (0)
#define PG8_LDA(dst, b, h) do { _Pragma("unroll") for (int m = 0; m < 4; ++m) _Pragma("unroll") for (int k = 0; k < 2; ++k) dst[m][k] = *(const PG8_LAS bf16x8*)(lds + PG8_SA(b, h) + aoff + m * 2048 + k * 1024); } while (0)
#define PG8_LDB(dst, b, h) do { _Pragma("unroll") for (int n = 0; n < 2; ++n) _Pragma("unroll") for (int k = 0; k < 2; ++k) dst[n][k] = *(const PG8_LAS bf16x8*)(lds + PG8_SB(b, h) + boff + n * 2048 + k * 1024); } while (0)
#define PG8_MMA(ai, bj, At, Bt) do { __builtin_amdgcn_s_setprio(1); _Pragma("unroll") for (int m = 0; m < 4; ++m) _Pragma("unroll") for (int n = 0; n < 2; ++n) _Pragma("unroll") for (int k = 0; k < 2; ++k) \
        acc[ai][bj][m][n] = __builtin_amdgcn_mfma_f32_16x16x32_bf16(Bt[n][k], At[m][k], acc[ai][bj][m][n], 0, 0, 0); __builtin_amdgcn_s_setprio(0); } while (0)
#define PG8_WAIT_V(n) asm volatile("s_waitcnt vmcnt(" #n ")" ::: "memory")
#define PG8_WAIT_VN(N) asm volatile("s_waitcnt vmcnt(%0)" :: "n"(N) : "memory")
#define PG8_WAIT_L(n) asm volatile("s_waitcnt lgkmcnt(" #n ")" ::: "memory")
#define PG8_BAR __builtin_amdgcn_s_barrier()
#define PG8_SCHED __builtin_amdgcn_sched_barrier(0)
    Unit cur, nxt; int ui = 0;
    if (!S.next(0, cur)) return;
    f32x4 acc[2][2][4][2];
#pragma unroll
    for (int a = 0; a < 2; ++a)
#pragma unroll
        for (int b = 0; b < 2; ++b)
#pragma unroll
            for (int m = 0; m < 4; ++m)
#pragma unroll
                for (int n = 0; n < 2; ++n) acc[a][b][m][n] = (f32x4){0.f, 0.f, 0.f, 0.f};
    bf16x8 At[4][2], B0[2][2], B1[2][2];
    unsigned cA = __builtin_amdgcn_readfirstlane((unsigned)cur.pm * tstep), cB = __builtin_amdgcn_readfirstlane((unsigned)cur.pn * tstep);
    S.a_ready(cur);
    if constexpr (Epi::SS_LDS) ss_prefetch(E.ss, E.ssl, cur.pm, wid, lane);
    if constexpr (SP2) {
        PG8_STAGE(PG8_SB(0, 0), rsB, cB, voffB); PG8_STAGE(PG8_SB(0, 1), rsB, cB + hB, voffB); PG8_STAGE(PG8_SA(0, 0), rsA, cA, voffA); PG8_STAGE(PG8_SA(0, 1), rsA, cA + hstep, voffA);
        if (wr == 1) PG8_BAR;
        PG8_WAIT_V(2); PG8_BAR;
        PG8_STAGE(PG8_SB(1, 0), rsB, cB + kstep, voffB); PG8_STAGE(PG8_SA(1, 0), rsA, cA + kstep, voffA); PG8_STAGE(PG8_SB(1, 1), rsB, cB + hB + kstep, voffB);
        PG8_WAIT_V(0); PG8_BAR;
    } else {
        PG8_STAGE(PG8_SB(0, 0), rsB, cB, voffB); PG8_STAGE(PG8_SA(0, 0), rsA, cA, voffA); PG8_STAGE(PG8_SB(0, 1), rsB, cB + hB, voffB); PG8_STAGE(PG8_SA(0, 1), rsA, cA + hstep, voffA);
        if (wr == 1) PG8_BAR;
        PG8_WAIT_V(4); PG8_BAR;
        PG8_STAGE(PG8_SB(1, 0), rsB, cB + kstep, voffB); PG8_STAGE(PG8_SA(1, 0), rsA, cA + kstep, voffA); PG8_STAGE(PG8_SB(1, 1), rsB, cB + hB + kstep, voffB);
        PG8_WAIT_V(6); PG8_BAR;
    }
    for (;;) {
        const bool has_next = S.next(ui + 1, nxt);
        const unsigned nA = __builtin_amdgcn_readfirstlane(has_next ? (unsigned)nxt.pm * tstep : cA), nB = __builtin_amdgcn_readfirstlane(has_next ? (unsigned)nxt.pn * tstep : cB);
#define PG8_KADDR const bool last = (t == nt - 2); const unsigned a1 = cA + (unsigned)(t + 1) * kstep; \
            const unsigned a2 = last ? nA : cA + (unsigned)(t + 2) * kstep, b2 = last ? nB : cB + (unsigned)(t + 2) * kstep, a3 = a2 + kstep, b3 = b2 + kstep; \
            if (last && has_next) S.a_ready(nxt); \
            if constexpr (Epi::HAS_MID) { if (t == Epi::MID_T) E.mid(acc, cur, wr, wc, fr, fq); }
#define PG8_KPAIR_SP2(W12) do { \
            PG8_LDB(B0, 0, 0); PG8_LDB(B1, 0, 1); PG8_SCHED; PG8_LDA(At, 0, 0); PG8_STAGE(PG8_SA(1, 1), rsA, a1 + hstep, voffA); \
            PG8_WAIT_VN(W12); PG8_WAIT_L(0); PG8_BAR; PG8_MMA(0, 0, At, B0); PG8_MMA(0, 1, At, B1); PG8_BAR; PG8_SCHED; \
            PG8_LDA(At, 0, 1); PG8_STAGE(PG8_SB(0, 0), rsB, b2, voffB); PG8_STAGE(PG8_SB(0, 1), rsB, b2 + hB, voffB); PG8_STAGE(PG8_SA(0, 0), rsA, a2, voffA); \
            PG8_WAIT_VN(W12); PG8_WAIT_L(0); PG8_BAR; PG8_MMA(1, 0, At, B0); PG8_MMA(1, 1, At, B1); PG8_BAR; PG8_SCHED; \
            PG8_LDB(B0, 1, 0); PG8_LDB(B1, 1, 1); PG8_SCHED; PG8_LDA(At, 1, 0); PG8_STAGE(PG8_SA(0, 1), rsA, a2 + hstep, voffA); \
            PG8_WAIT_V(8); PG8_WAIT_L(0); PG8_BAR; PG8_MMA(0, 0, At, B0); PG8_MMA(0, 1, At, B1); PG8_BAR; PG8_SCHED; \
            PG8_LDA(At, 1, 1); PG8_STAGE(PG8_SB(1, 0), rsB, b3, voffB); PG8_STAGE(PG8_SB(1, 1), rsB, b3 + hB, voffB); PG8_STAGE(PG8_SA(1, 0), rsA, a3, voffA); \
            PG8_WAIT_V(8); PG8_WAIT_L(0); PG8_BAR; PG8_MMA(1, 0, At, B0); PG8_MMA(1, 1, At, B1); PG8_BAR; PG8_SCHED; } while (0)
        if constexpr (SP2) {
            { const int t = 0; PG8_KADDR; PG8_KPAIR_SP2(8 + Epi::VM_TAIL); }
            for (int t = 2; t < nt; t += 2) { PG8_KADDR; PG8_KPAIR_SP2(8); }
        } else {
        for (int t = 0; t < nt; t += 2) {
            PG8_KADDR;
            PG8_LDB(B0, 0, 0); PG8_SCHED; PG8_LDA(At, 0, 0); PG8_STAGE(PG8_SA(1, 1), rsA, a1 + hstep, voffA);
            PG8_WAIT_L(8); PG8_BAR; PG8_WAIT_L(0); PG8_MMA(0, 0, At, B0); PG8_BAR; PG8_SCHED;
            PG8_LDB(B1, 0, 1); PG8_STAGE(PG8_SB(0, 0), rsB, b2, voffB);
            PG8_BAR; PG8_WAIT_L(0); PG8_MMA(0, 1, At, B1); PG8_BAR;
            PG8_LDA(At, 0, 1); PG8_STAGE(PG8_SA(0, 0), rsA, a2, voffA);
            PG8_BAR; PG8_WAIT_L(0); PG8_MMA(1, 0, At, B0); PG8_BAR; PG8_SCHED;
            PG8_STAGE(PG8_SB(0, 1), rsB, b2 + hB, voffB);
            PG8_WAIT_V(6); PG8_BAR; PG8_MMA(1, 1, At, B1); PG8_BAR;
            PG8_LDB(B0, 1, 0); PG8_SCHED; PG8_LDA(At, 1, 0); PG8_STAGE(PG8_SA(0, 1), rsA, a2 + hstep, voffA);
            PG8_WAIT_L(8); PG8_BAR; PG8_WAIT_L(0); PG8_MMA(0, 0, At, B0); PG8_BAR; PG8_SCHED;
            PG8_LDB(B1, 1, 1); PG8_STAGE(PG8_SB(1, 0), rsB, b3, voffB);
            PG8_BAR; PG8_WAIT_L(0); PG8_MMA(0, 1, At, B1); PG8_BAR;
            PG8_LDA(At, 1, 1); PG8_STAGE(PG8_SA(1, 0), rsA, a3, voffA);
            PG8_BAR; PG8_WAIT_L(0); PG8_MMA(1, 0, At, B0); PG8_BAR; PG8_SCHED;
            PG8_STAGE(PG8_SB(1, 1), rsB, b3 + hB, voffB);
            PG8_WAIT_V(6); PG8_BAR; PG8_MMA(1, 1, At, B1); PG8_BAR;
        }
        }
        if constexpr (ALIGN_EPI) { if (wr == 0) PG8_BAR; }
        if constexpr (!Epi::AFTER_DRAIN) { E(acc, cur, wr, wc, fr, fq); S.done(cur); }
        if (!has_next) break;
#pragma unroll
        for (int a = 0; a < 2; ++a)
#pragma unroll
            for (int b = 0; b < 2; ++b)
#pragma unroll
                for (int m = 0; m < 4; ++m)
#pragma unroll
                    for (int n = 0; n < 2; ++n) acc[a][b][m][n] = (f32x4){0.f, 0.f, 0.f, 0.f};
        cur = nxt; cA = nA; cB = nB; ++ui;
        if constexpr (Epi::SS_LDS) ss_prefetch(E.ss, E.ssl, cur.pm, wid, lane);
        if constexpr (ALIGN_EPI) { if (wr == 1) PG8_BAR; }
    }
    PG8_WAIT_V(0);
    if constexpr (!ALIGN_EPI) { if (wr == 0) PG8_BAR; }
    PG8_BAR;
#undef PG8_SA
#undef PG8_SB
#undef PG8_STAGE
#undef PG8_LDA
#undef PG8_LDB
#undef PG8_MMA
#undef PG8_WAIT_V
#undef PG8_WAIT_L
#undef PG8_WAIT_VN
#undef PG8_KADDR
#undef PG8_KPAIR_SP2
#undef PG8_BAR
#undef PG8_SCHED
}
}

#ifndef PG8_SP2
#define PG8_SP2 true
#endif
#ifndef PG8_ALIGN
#define PG8_ALIGN true
#endif

constexpr int NWAVES = 8;
constexpr int N_LAUNCHES = MK_N_LAUNCHES;
constexpr int PER_PHASE = 10;
constexpr int D = 4096, FF = 11008, NIN = 20480, QKVW = 12288, GATEW = 8192, YABW = 3072;
constexpr int M_P = 8192, M_S = 16384, M = M_P + M_S;
constexpr float QSCALE = 0.08838834764831845f * 1.4426950408889634f;

constexpr size_t MiB = 1u << 20;
constexpr size_t WS_CTL = 0, CTL_ZERO_BYTES = 1 * MiB;
constexpr size_t WS_SS0 = 1 * MiB;
constexpr size_t WS_ROPE = 2 * MiB;
constexpr size_t WS_WIN = 4 * MiB;
constexpr size_t WS_WAB = WS_WIN + (size_t)NIN * D * 2;
constexpr size_t WS_WOUT = WS_WAB + (size_t)D * YABW * 2;
constexpr size_t WS_WGU = WS_WOUT + (size_t)D * D * 2;
constexpr size_t WS_WD = WS_WGU + (size_t)2 * FF * D * 2;
constexpr size_t WS_AB1 = WS_WD + (size_t)D * FF * 2;
constexpr size_t WS_ACT = WS_AB1 + (size_t)M * D * 2;
constexpr size_t WS_QKV = WS_ACT + (size_t)M * FF * 2;
constexpr size_t WS_END = WS_QKV + (size_t)M * QKVW * 2;
constexpr int CW_BAR = 4096;
constexpr int CW_SS1 = 16384, CW_SS2 = CW_SS1 + M, CW_SS3 = CW_SS2 + M;
static_assert((size_t)(CW_SS3 + M) * 4 <= CTL_ZERO_BYTES, "CTL words inside the memset region");
static_assert(WS_SS0 + (size_t)M * 4 <= WS_ROPE && WS_ROPE + (size_t)16384 * 32 * 4 <= WS_WIN, "ws map");

constexpr int RING_OFF = 0, RING_BYTES = 131072;
constexpr int LDSCTL_OFF = RING_BYTES, MISC_OFF = LDSCTL_OFF + 320;
constexpr int SSL_OFF = MISC_OFF + 1024;
constexpr int LDS_BYTES = 147456;

#define GAS __attribute__((address_space(1)))
#define LAS __attribute__((address_space(3)))
typedef unsigned short bf16;
typedef unsigned v4u __attribute__((ext_vector_type(4)));
typedef unsigned v2u __attribute__((ext_vector_type(2)));
typedef float f32x4 __attribute__((ext_vector_type(4)));
typedef short bf16x8 __attribute__((ext_vector_type(8)));
typedef short s16x4 __attribute__((ext_vector_type(4)));
typedef GAS unsigned gu32;
#define RLX_AGENT __ATOMIC_RELAXED, __HIP_MEMORY_SCOPE_AGENT
#define LDS_WAIT() asm volatile("s_waitcnt lgkmcnt(0)" ::: "memory")
#define VM_WAIT() asm volatile("s_waitcnt vmcnt(0)" ::: "memory")
__device__ __forceinline__ unsigned pk2(float lo, float hi) { return pg8::cvt_pk_bf16(lo, hi); }

#define XB_TMO      128
#define XB_XCNT(j)  (256  + 64 * (j))
#define XB_XSUB(j)  (1280 + 64 * (j))
#define XB_XGEN(j)  (2304 + 64 * (j))
#define XB_TOP      3328
#define XB_TOPGEN   3392
#define XCD_BAR_WORDS 3456
#define XB_SPIN_CAP (1u << 18)

__device__ __forceinline__ unsigned xb_ld(unsigned* p)              { return __hip_atomic_load(p, __ATOMIC_RELAXED, __HIP_MEMORY_SCOPE_AGENT); }
__device__ __forceinline__ unsigned xb_add(unsigned* p, unsigned v) { return __hip_atomic_fetch_add(p, v, __ATOMIC_RELAXED, __HIP_MEMORY_SCOPE_AGENT); }
__device__ __forceinline__ unsigned xb_xcc_id() { return (unsigned)__builtin_amdgcn_s_getreg((3 << 11) | 20) & 0xFu; }
#define XB_SPIN(cond, bar) do { unsigned _sp = 0; while (cond) { __builtin_amdgcn_s_sleep(1); \
    if ((++_sp & 255u) == 0u) { if (xb_ld(&(bar)[XB_TMO])) break; if (_sp > XB_SPIN_CAP) { atomicAdd(&(bar)[XB_TMO], 1u); break; } } } } while (0)

struct XcdBarrier {
    unsigned* bar; unsigned x;
    volatile LAS unsigned* st;
};
__device__ __forceinline__ XcdBarrier xcd_barrier_post(unsigned* bar, volatile LAS unsigned* st) {
    XcdBarrier b; b.bar = bar; b.x = xb_xcc_id(); b.st = st;
    if (threadIdx.x == 0) (void)xb_add(&bar[XB_XCNT(b.x)], 1u);
    return b;
}
__device__ __forceinline__ void xcd_barrier_complete(unsigned* bar, unsigned x, unsigned& nloc, unsigned& nx) {
    const unsigned G = gridDim.x * gridDim.y * gridDim.z;
    unsigned sum, cnt, mine, sp = 0u;
    for (;;) {
        sum = 0u; cnt = 0u; mine = 0u;
#pragma unroll
        for (unsigned j = 0; j < 16; ++j) { const unsigned c = xb_ld(&bar[XB_XCNT(j)]); sum += c; cnt += (c > 0u) ? 1u : 0u; mine = (j == x) ? c : mine; }
        if (sum == G) break;
        __builtin_amdgcn_s_sleep(1);
        if ((++sp & 255u) == 0u) { if (xb_ld(&bar[XB_TMO])) break; if (sp > XB_SPIN_CAP) { atomicAdd(&bar[XB_TMO], 1u); break; } }
    }
    nloc = mine > 0u ? mine : 1u; nx = cnt > 0u ? cnt : 1u;
}
__device__ __forceinline__ void xcd_barrier(const XcdBarrier& b) {
    asm volatile("s_waitcnt vmcnt(0)" ::: "memory");
    __syncthreads();
    if (threadIdx.x == 0) {
        unsigned* bar = b.bar;
        __builtin_amdgcn_s_waitcnt(0);
        unsigned nloc = b.st[0], nx = b.st[1];
        if (nloc == 0u) { xcd_barrier_complete(bar, b.x, nloc, nx); b.st[0] = nloc; b.st[1] = nx; }
        const unsigned old = xb_add(&bar[XB_XSUB(b.x)], 1u);
        const unsigned gen = old / nloc;
        if (old + 1u == (gen + 1u) * nloc) {
            __builtin_amdgcn_fence(__ATOMIC_RELEASE, "agent");
            asm volatile("s_waitcnt vmcnt(0)" ::: "memory");
            const unsigned og = xb_add(&bar[XB_TOP], 1u);
            const unsigned tg = og / nx;
            if (og + 1u == (tg + 1u) * nx) xb_add(&bar[XB_TOPGEN], 1u);
            else XB_SPIN(xb_ld(&bar[XB_TOPGEN]) == tg, bar);
            __builtin_amdgcn_fence(__ATOMIC_ACQUIRE, "agent");
            xb_add(&bar[XB_XGEN(b.x)], 1u);
            asm volatile("s_waitcnt vmcnt(0)" ::: "memory");
        } else {
            XB_SPIN(xb_ld(&bar[XB_XGEN(b.x)]) == gen, bar);
            __builtin_amdgcn_fence(__ATOMIC_ACQUIRE, "agent");
            asm volatile("s_waitcnt vmcnt(0)" ::: "memory");
        }
    }
    __syncthreads();
}

__device__ __forceinline__ void xcd_stagger(unsigned ticks) {
    const unsigned long long dt = (unsigned long long)(xb_xcc_id() & 7u) * ticks, t0 = __builtin_amdgcn_s_memrealtime();
    while (__builtin_amdgcn_s_memrealtime() - t0 < dt) __builtin_amdgcn_s_sleep(8);
}

struct Frame {
    LAS unsigned char* lds;
    volatile LAS unsigned* MISC;
    gu32* ctl;
    int tid, lane, wave;
    int vcu, G;
};

__device__ __forceinline__ float wave_sum(float v) {
#pragma unroll
    for (int o = 1; o < 64; o <<= 1) v += __shfl_xor(v, o);
    return v;
}

struct CvtJob { const float* W; const float* gain; bf16* WT; int N, ldT, drow, kcol0, k0, n0, split; float cs; };
__device__ __forceinline__ void cvt_job(CvtJob& J, const float* W, int N, const float* gain, bf16* WT, int ldT, int koff, int mode, int item) {
    const int nblk = N / 64, kb = item / nblk, nb = item % nblk, k0 = 64 * kb, n0 = 64 * nb;
    J.W = W; J.gain = gain; J.WT = WT; J.N = N; J.ldT = ldT; J.k0 = k0; J.n0 = n0; J.kcol0 = koff + k0;
    J.cs = (mode == 3 && (n0 < 3072 || (n0 >= 9216 && n0 < 11264))) ? QSCALE : 1.0f;
    J.drow = (mode == 1 || mode == 2) ? 256 * (n0 >> 7) + (n0 & 127) + (mode == 2 ? 128 : 0) : n0;
    J.split = 0;
    if (mode == 3 && n0 >= 12288) { const int c = n0 - 12288, c2 = c & 4095;
        J.drow = 12288 + 2 * c2 + (c >= 4096 ? 32 : 0); J.split = 1; }
}
__device__ __forceinline__ void cvt_load(const CvtJob& J, int lane, f32x4 (&v)[16]) {
    const float* p = J.W + (size_t)(J.k0 + 16 * (lane >> 4)) * J.N + J.n0 + 4 * (lane & 15);
#pragma unroll
    for (int i = 0; i < 16; ++i) v[i] = __builtin_nontemporal_load((const f32x4*)(p + (size_t)i * J.N));
}
__device__ __forceinline__ void cvt_store(const CvtJob& J, const f32x4 (&v)[16], LAS unsigned char* img, int lane) {
    const int g = lane >> 4, i15 = lane & 15;
    f32x4 gq[4];
#pragma unroll
    for (int j = 0; j < 4; ++j) gq[j] = J.gain ? *(const f32x4*)(J.gain + J.k0 + 16 * g + 4 * j) * J.cs : (f32x4){J.cs, J.cs, J.cs, J.cs};
#pragma unroll
    for (int e = 0; e < 4; ++e) { v4u lo, hi;
        lo.x = pk2(v[0][e] * gq[0][0], v[1][e] * gq[0][1]);   lo.y = pk2(v[2][e] * gq[0][2], v[3][e] * gq[0][3]);   lo.z = pk2(v[4][e] * gq[1][0], v[5][e] * gq[1][1]);   lo.w = pk2(v[6][e] * gq[1][2], v[7][e] * gq[1][3]);
        hi.x = pk2(v[8][e] * gq[2][0], v[9][e] * gq[2][1]);   hi.y = pk2(v[10][e] * gq[2][2], v[11][e] * gq[2][3]); hi.z = pk2(v[12][e] * gq[3][0], v[13][e] * gq[3][1]); hi.w = pk2(v[14][e] * gq[3][2], v[15][e] * gq[3][3]);
        LAS unsigned char* wp = img + (4 * i15 + e) * 144 + 32 * g;
        *(LAS v4u*)wp = lo; *(LAS v4u*)(wp + 16) = hi; }
    const int r = lane >> 3, c = lane & 7;
    bf16* op = J.WT + (size_t)(J.drow + r) * J.ldT + J.kcol0 + 8 * c;
#pragma unroll
    for (int j = 0; j < 8; ++j) {
        const v4u o = *(const LAS v4u*)(img + (8 * j + r) * 144 + 16 * c);
        *(v4u*)(op + (size_t)(8 * j + (J.split ? 32 * (j >> 2) : 0)) * J.ldT) = o;
    }
}
struct Ptrs;
template <int SET> __device__ __forceinline__ void cvt_decode(const Ptrs& P, int it, CvtJob& J);

__device__ __forceinline__ void sincos_acc(float a, float& s, float& c) {
    const double x = (double)a;
    const double kq = __builtin_rint(x * 0.63661977236758134308);
    double r = __builtin_fma(-kq, 1.57079632679489655800e+00, x);
    r = __builtin_fma(-kq, 6.12323399573676603587e-17, r);
    const int q = (int)((long long)kq) & 3;
    const double r2 = r * r;
    const double sp = r * (1.0 + r2 * (-1.0 / 6.0 + r2 * (1.0 / 120.0 + r2 * (-1.0 / 5040.0 + r2 * (1.0 / 362880.0 + r2 * (-1.0 / 39916800.0 + r2 * (1.0 / 6227020800.0)))))));
    const double cp = 1.0 + r2 * (-0.5 + r2 * (1.0 / 24.0 + r2 * (-1.0 / 720.0 + r2 * (1.0 / 40320.0 + r2 * (-1.0 / 3628800.0 + r2 * (1.0 / 479001600.0))))));
    const double ss = (q & 1) ? cp : sp, cc = (q & 1) ? sp : cp;
    s = (float)((q & 2) ? -ss : ss);
    c = (float)(((q + 1) & 2) ? -cc : cc);
}

struct Ptrs {
    const float* xp; const float* xs; const float* g1; const float* w1g; const float* w1u; const float* w1d; const float* gmix; const float* win; const float* sink;
    const float* wa; const float* wb; const float* wout; const float* g2; const float* w2g; const float* w2u; const float* w2d; const float* gfin;
    float* out; unsigned char* ws;
};

constexpr int CI_GU = (D / 64) * (FF / 64), CI_D = (FF / 64) * (D / 64), CI_IN = (D / 64) * (NIN / 64), CI_A = (1024 / 64) * (D / 64), CI_B = (2048 / 64) * (D / 64), CI_O = (D / 64) * (D / 64);
constexpr int CI_IN0 = CI_IN / 2;
template <> __device__ __forceinline__ void cvt_decode<0>(const Ptrs& P, int it, CvtJob& J) {
    bf16* WGU = (bf16*)(P.ws + WS_WGU); bf16* WD = (bf16*)(P.ws + WS_WD); bf16* WIN = (bf16*)(P.ws + WS_WIN);
    int r = it;
    if (r < CI_GU) { cvt_job(J, P.w1g, FF, P.g1, WGU, D, 0, 1, r); return; } r -= CI_GU;
    if (r < CI_GU) { cvt_job(J, P.w1u, FF, P.g1, WGU, D, 0, 2, r); return; } r -= CI_GU;
    if (r < CI_D)  { cvt_job(J, P.w1d, D, nullptr, WD, FF, 0, 0, r); return; } r -= CI_D;
    cvt_job(J, P.win, NIN, P.gmix, WIN, D, 0, 3, r);
}
template <> __device__ __forceinline__ void cvt_decode<2>(const Ptrs& P, int it, CvtJob& J) {
    bf16* WIN = (bf16*)(P.ws + WS_WIN); bf16* WAB = (bf16*)(P.ws + WS_WAB); bf16* WOUT = (bf16*)(P.ws + WS_WOUT);
    int r = it;
    if (r < CI_IN - CI_IN0) { cvt_job(J, P.win, NIN, P.gmix, WIN, D, 0, 3, r + CI_IN0); return; } r -= CI_IN - CI_IN0;
    if (r < CI_A)  { cvt_job(J, P.wa, D, nullptr, WAB, YABW, 0, 0, r); return; } r -= CI_A;
    if (r < CI_B)  { cvt_job(J, P.wb, D, nullptr, WAB, YABW, 1024, 0, r); return; } r -= CI_B;
    cvt_job(J, P.wout, D, nullptr, WOUT, D, 0, 0, r);
}
template <> __device__ __forceinline__ void cvt_decode<1>(const Ptrs& P, int it, CvtJob& J) {
    bf16* WGU = (bf16*)(P.ws + WS_WGU); bf16* WD = (bf16*)(P.ws + WS_WD);
    int r = it;
    if (r < CI_GU) { cvt_job(J, P.w2g, FF, P.g2, WGU, D, 0, 1, r); return; } r -= CI_GU;
    cvt_job(J, P.w2u, FF, P.g2, WGU, D, 0, 2, r);
}
template <> __device__ __forceinline__ void cvt_decode<3>(const Ptrs& P, int it, CvtJob& J) { cvt_job(J, P.w2d, D, nullptr, (bf16*)(P.ws + WS_WD), FF, 0, 0, it); }
template <int SET> __device__ __forceinline__ void cvt_run(Frame& F, const Ptrs& P, int gw, int NGW) {
    constexpr int NITEMS = SET == 0 ? 2 * CI_GU + CI_D + CI_IN0 : (SET == 1 ? 2 * CI_GU : (SET == 3 ? CI_D : (CI_IN - CI_IN0) + CI_A + CI_B + CI_O));
    LAS unsigned char* img = F.lds + RING_OFF + F.wave * 16384;
    const int lane = F.lane;
    f32x4 va[16], vb[16]; CvtJob Ja, Jb;
    int it = gw;
    if (it >= NITEMS) return;
    cvt_decode<SET>(P, it, Ja); cvt_load(Ja, lane, va);
    for (;;) {
        int nx = it + NGW;
        cvt_decode<SET>(P, nx < NITEMS ? nx : NITEMS - 1, Jb); cvt_load(Jb, lane, vb);
        cvt_store(Ja, va, img, lane);
        it = nx; if (it >= NITEMS) break;
        nx = it + NGW;
        cvt_decode<SET>(P, nx < NITEMS ? nx : NITEMS - 1, Ja); cvt_load(Ja, lane, va);
        cvt_store(Jb, vb, img, lane);
        it = nx; if (it >= NITEMS) break;
    }
}
__device__ __forceinline__ void p0_prologue(Frame& F, const Ptrs& P) {
    const int gw = F.vcu * NWAVES + F.wave, NGW = F.G * NWAVES;
    { float* tab = (float*)(P.ws + WS_ROPE);
      const float inv[16] = {1.000000000e+00f, 4.403665960e-01f, 1.939227432e-01f, 8.539710194e-02f, 3.760603070e-02f, 1.656044088e-02f, 7.292664610e-03f, 3.211446106e-03f,
                             1.414213562e-03f, 6.227724371e-04f, 2.742481884e-04f, 1.207697351e-04f, 5.318295734e-05f, 2.341999971e-05f, 1.031338525e-05f, 4.541670478e-06f};
      for (int pos = gw * 64 + F.lane; pos < 16384; pos += NGW * 64) {
#pragma unroll
          for (int i = 0; i < 16; ++i) { const float ang = (float)pos * inv[i]; float s, c; sincos_acc(ang, s, c); tab[(size_t)pos * 32 + i] = c; tab[(size_t)pos * 32 + 16 + i] = s; } } }
    { bf16* XB = (bf16*)(P.ws + WS_AB1); float* ss0 = (float*)(P.ws + WS_SS0);
      for (int m = gw; m < M; m += NGW) { const float* xrow = (m < M_P) ? P.xp + (size_t)m * D : P.xs + (size_t)(m - M_P) * D;
          const GAS f32x4* xr = (const GAS f32x4*)xrow + F.lane; GAS v2u* o8 = (GAS v2u*)(XB + (size_t)m * D) + F.lane; float s = 0.f;
#pragma unroll
          for (int j = 0; j < 16; ++j) { const f32x4 v = __builtin_nontemporal_load(xr + 64 * j); s += (v.x * v.x + v.y * v.y) + (v.z * v.z + v.w * v.w); v2u w; w.x = pk2(v.x, v.y); w.y = pk2(v.z, v.w); o8[64 * j] = w; }
          s = wave_sum(s); if (F.lane == 0) ss0[m] = s; } }
    cvt_run<0>(F, P, gw, NGW);
}
__device__ __forceinline__ void p4_convert_w2(Frame& F, const Ptrs& P) { cvt_run<1>(F, P, F.vcu * NWAVES + F.wave, F.G * NWAVES); }

__device__ __forceinline__ unsigned off_b(unsigned row, unsigned ch) { return 256u * row + 16u * (ch ^ (((row & 3) << 2) | ((row >> 2) & 3))); }
struct AttState2 { float m[2], l[2]; f32x4 O[2][8]; };

struct AttLane { unsigned choff[4]; };
__device__ __forceinline__ void att_lane_init(AttLane& L, int lane) {
    const unsigned i = lane & 15, g = lane >> 4;
#pragma unroll
    for (int j = 0; j < 4; ++j) L.choff[j] = 16u * (i ^ ((g << 2) | (unsigned)j));
}
__device__ __forceinline__ void k_load(bf16x8 (&kf)[2][4], const bf16* Kb, int S, int tb, int dil, int lane) {
    const int i = lane & 15, g = lane >> 4;
    const int kk_a = 8 * (i >> 2) + (i & 3);
#pragma unroll
    for (int t = 0; t < 2; ++t) { int tk = tb + dil * (kk_a + 4 * t); tk = max(0, min(tk, S - 1)); const bf16* kp = Kb + (size_t)tk * QKVW + 8 * g;
#pragma unroll
        for (int s = 0; s < 4; ++s) kf[t][s] = *(const bf16x8*)(kp + 32 * s); }
}
__device__ __forceinline__ void v_dma(LAS unsigned char* vbuf, const bf16* Vb, int S, int tb, int dil, int lane, const AttLane& L) {
    const int g = lane >> 4;
    if (tb >= 0 && tb + 31 * dil < S) {
        const char* p0 = (const char*)(Vb + (size_t)(tb + dil * g) * QKVW); const size_t rstep = (size_t)(4 * dil) * QKVW * 2;
#pragma unroll
        for (int c = 0; c < 8; ++c) __builtin_amdgcn_global_load_lds((const unsigned*)(p0 + c * rstep + L.choff[c & 3]), (LAS unsigned*)(vbuf + 1024 * c), 16, 0, 0);
    } else {
#pragma unroll
        for (int c = 0; c < 8; ++c) { int tk = tb + dil * (4 * c + g); tk = max(0, min(tk, S - 1));
            __builtin_amdgcn_global_load_lds((const unsigned*)((const char*)(Vb + (size_t)tk * QKVW) + L.choff[c & 3]), (LAS unsigned*)(vbuf + 1024 * c), 16, 0, 0); }
    }
    asm volatile("" ::: "memory");
}
template <int BUF>
__device__ __forceinline__ void kv_compute2(AttState2& st, bf16x8 (&kf)[2][4], const bf16x8 (&qf)[2][4], int S, int tb, int dil, const int (&mlo)[2], const unsigned (&mspan)[2],
                                            LAS unsigned char* vl, int lane, const AttLane& L, bool pf, const bf16* Kb, const bf16* Vb, int tbn) {
    const int g = lane >> 4;
    f32x4 sc[2][2];
#pragma unroll
    for (int q = 0; q < 2; ++q)
#pragma unroll
        for (int t = 0; t < 2; ++t) { sc[q][t] = (f32x4){0.f, 0.f, 0.f, 0.f};
#pragma unroll
            for (int s = 0; s < 4; ++s) sc[q][t] = __builtin_amdgcn_mfma_f32_16x16x32_bf16(kf[t][s], qf[q][s], sc[q][t], 0, 0, 0); }
    if (pf) v_dma(vl + (BUF ? 0 : 8192), Vb, S, tbn, dil, lane, L);
    bf16x8 pf16[2];
#pragma unroll
    for (int q = 0; q < 2; ++q) {
        const int x0 = tb + dil * 8 * g - mlo[q];
        float mx = -__builtin_inff();
#pragma unroll
        for (int t = 0; t < 2; ++t)
#pragma unroll
            for (int r = 0; r < 4; ++r) { const bool ok = (unsigned)(x0 + dil * (4 * t + r)) <= mspan[q]; sc[q][t][r] = ok ? sc[q][t][r] : -__builtin_inff(); mx = fmaxf(mx, sc[q][t][r]); }
        mx = pg8::xmax_16_32(mx);
        if (__builtin_amdgcn_ballot_w64(mx > st.m[q] + 8.0f) != 0ull) {
            const float mn = fmaxf(st.m[q], mx), alpha = __builtin_amdgcn_exp2f(st.m[q] - mn);
            st.l[q] *= alpha; st.m[q] = mn;
#pragma unroll
            for (int dt = 0; dt < 8; ++dt) st.O[q][dt] *= alpha;
        }
        float ps = 0.f; float p[8];
#pragma unroll
        for (int t = 0; t < 2; ++t)
#pragma unroll
            for (int r = 0; r < 4; ++r) { p[4 * t + r] = __builtin_amdgcn_exp2f(sc[q][t][r] - st.m[q]); ps += p[4 * t + r]; }
        st.l[q] += ps;
        v4u pw; pw.x = pk2(p[0], p[1]); pw.y = pk2(p[2], p[3]); pw.z = pk2(p[4], p[5]); pw.w = pk2(p[6], p[7]);
        pf16[q] = __builtin_bit_cast(bf16x8, pw);
    }
    if (pf) asm volatile("s_waitcnt vmcnt(8)" ::: "memory"); else asm volatile("s_waitcnt vmcnt(0)" ::: "memory");
    const unsigned vb = (unsigned)(uintptr_t)vl;
#define TR4(k) asm volatile("ds_read_b64_tr_b16 %0, %4 offset:%8\n\tds_read_b64_tr_b16 %1, %5 offset:%8\n\tds_read_b64_tr_b16 %2, %6 offset:%8\n\tds_read_b64_tr_b16 %3, %7 offset:%8" \
        : "=&v"(f[k]), "=&v"(f[k + 1]), "=&v"(f[k + 2]), "=&v"(f[k + 3]) : "v"(a[k]), "v"(a[k + 1]), "v"(a[k + 2]), "v"(a[k + 3]), "i"(BUF ? 8192 : 0) : "memory")
#pragma unroll
    for (int hf = 0; hf < 2; ++hf) {
        unsigned a[8]; s16x4 f[8];
        int ln = lane; asm volatile("" : "+v"(ln));
        const unsigned g2 = ln >> 4, q2 = (ln & 15) >> 2, pp = ln & 3;
#pragma unroll
        for (int k = 0; k < 4; ++k) { const int dt = 4 * hf + k; a[2 * k] = vb + off_b(8 * g2 + q2, 2 * dt + (pp >> 1)) + 8 * (pp & 1); a[2 * k + 1] = vb + off_b(8 * g2 + 4 + q2, 2 * dt + (pp >> 1)) + 8 * (pp & 1); }
        TR4(0); TR4(4);
        asm volatile("s_waitcnt lgkmcnt(0)" : "+v"(f[0]), "+v"(f[1]), "+v"(f[2]), "+v"(f[3]), "+v"(f[4]), "+v"(f[5]), "+v"(f[6]), "+v"(f[7]) :: "memory");
#pragma unroll
        for (int k = 0; k < 4; ++k) { const int dt = 4 * hf + k;
            const bf16x8 vf = __builtin_shufflevector(f[2 * k], f[2 * k + 1], 0, 1, 2, 3, 4, 5, 6, 7);
            st.O[0][dt] = __builtin_amdgcn_mfma_f32_16x16x32_bf16(vf, pf16[0], st.O[0][dt], 0, 0, 0);
            st.O[1][dt] = __builtin_amdgcn_mfma_f32_16x16x32_bf16(vf, pf16[1], st.O[1][dt], 0, 0, 0); }
    }
#undef TR4
    if (pf) { asm volatile("" ::: "memory"); k_load(kf, Kb, S, tbn, dil, lane); }
}
__device__ __forceinline__ void attn_keys2(AttState2& st, const bf16x8 (&qf)[2][4], const bf16* Kb, const bf16* Vb, int S, const int (&tq)[2], int kstart, int dil, int ntiles, int W,
                                           LAS unsigned char* vl, int lane, const AttLane& L) {
    bf16x8 kf[2][4]; const int tstep = 32 * dil;
    int mlo[2]; unsigned mspan[2];
#pragma unroll
    for (int q = 0; q < 2; ++q) { mlo[q] = max(tq[q] - W, 0); mspan[q] = (unsigned)(min(tq[q] + W, S - 1) - mlo[q]); }
    v_dma(vl, Vb, S, kstart, dil, lane, L); k_load(kf, Kb, S, kstart, dil, lane);
    for (int tile = 0; tile < ntiles; tile += 2) {
        const int tb = kstart + tile * tstep;
        const bool m1 = tile + 1 < ntiles;
        kv_compute2<0>(st, kf, qf, S, tb, dil, mlo, mspan, vl, lane, L, m1, Kb, Vb, tb + tstep);
        if (!m1) break;
        const bool m2 = tile + 2 < ntiles;
        kv_compute2<1>(st, kf, qf, S, tb + tstep, dil, mlo, mspan, vl, lane, L, m2, Kb, Vb, tb + 2 * tstep);
    }
}

template <int HALFW> __device__ __forceinline__ void attn_phase(Frame& F, const Ptrs& P) {
    if (HALFW && F.wave >= 4) return;
    const bf16* QKV = (const bf16*)(P.ws + WS_QKV); bf16* YAB = (bf16*)P.out;
    LAS unsigned char* vl = F.lds + RING_OFF + F.wave * 16384;
    const int gw = HALFW ? F.vcu * 4 + F.wave : F.vcu * NWAVES + F.wave, NGW = HALFW ? F.G * 4 : F.G * NWAVES, lane = F.lane, i = lane & 15, g = lane >> 4;
    AttLane AL; att_lane_init(AL, lane);
    { constexpr int NT = (M / 512) * 8 * 16;
      for (int id = gw; id < NT; id += NGW) {
          const int r16 = id & 15, h = (id >> 4) & 7, rb = id >> 7;
          const int row_blk = rb * 512; const int seq0 = row_blk < 4096 ? 0 : (row_blk < 8192 ? 4096 : 8192); const int S = row_blk < 8192 ? 4096 : 16384;
          const int t0 = row_blk - seq0 + r16; const int tq[2] = {t0 + 16 * i, t0 + 256 + 16 * i};
          AttState2 st;
#pragma unroll
          for (int q = 0; q < 2; ++q) { st.m[q] = -1e30f; st.l[q] = 0.f;
#pragma unroll
              for (int dt = 0; dt < 8; ++dt) st.O[q][dt] = (f32x4){0.f, 0.f, 0.f, 0.f}; }
          const bf16* seqbase = QKV + (size_t)seq0 * QKVW;
#pragma unroll 1
          for (int grp = 0; grp < 3; ++grp) {
              const int dil = grp == 0 ? 1 : (grp == 1 ? 4 : 16); const int ntiles = grp == 0 ? 20 : (grp == 1 ? 8 : 5);
              const int hc = grp * 1024 + h * 128;
              bf16x8 qf[2][4];
#pragma unroll
              for (int q = 0; q < 2; ++q) { const bf16* qp = seqbase + (size_t)tq[q] * QKVW + hc + 8 * g;
#pragma unroll
                  for (int s = 0; s < 4; ++s) qf[q][s] = *(const bf16x8*)(qp + 32 * s); }
              attn_keys2(st, qf, seqbase + 3072 + hc, seqbase + 6144 + hc, S, tq, t0 - 64 * dil, dil, ntiles, 64 * dil, vl, lane, AL);
          }
#pragma unroll
          for (int q = 0; q < 2; ++q) { float l = st.l[q]; l = pg8::xsum_16_32(l); const float rl = 1.0f / l;
              bf16* op = YAB + (size_t)(seq0 + tq[q]) * YABW + h * 128 + 4 * g;
#pragma unroll
              for (int dt = 0; dt < 8; ++dt) { const f32x4 o = st.O[q][dt] * rl; v2u w; w.x = pk2(o[0], o[1]); w.y = pk2(o[2], o[3]); *(v2u*)(op + 16 * dt) = w; } }
      } }
    { constexpr int NT = (M / 16) * 8;
      for (int id = gw; id < NT; id += NGW) {
          const int pair = id & 7, blk = id >> 3; const int row0 = blk * 16;
          const int seq0 = row0 < 4096 ? 0 : (row0 < 8192 ? 4096 : 8192); const int S = row0 < 8192 ? 4096 : 16384;
          const int t0 = row0 - seq0; const int tq[2] = {t0 + i, t0 + i};
          AttState2 st;
#pragma unroll
          for (int q = 0; q < 2; ++q) { st.m[q] = -1e30f; st.l[q] = 0.f;
#pragma unroll
              for (int dt = 0; dt < 8; ++dt) st.O[q][dt] = (f32x4){0.f, 0.f, 0.f, 0.f}; }
          const bf16* seqbase = QKV + (size_t)seq0 * QKVW; const int kvh = pair >> 1;
          bf16x8 qf[2][4];
#pragma unroll
          for (int q = 0; q < 2; ++q) { const bf16* qp = seqbase + (size_t)tq[q] * QKVW + 9216 + (2 * pair + q) * 128 + 8 * g;
#pragma unroll
              for (int s = 0; s < 4; ++s) qf[q][s] = *(const bf16x8*)(qp + 32 * s); }
          attn_keys2(st, qf, seqbase + 11264 + kvh * 128, seqbase + 11776 + kvh * 128, S, tq, t0 - 128, 1, 9, 128, vl, lane, AL);
#pragma unroll
          for (int q = 0; q < 2; ++q) { const int qh = 2 * pair + q; float l = st.l[q]; l = pg8::xsum_16_32(l);
              const float sk = P.sink[qh] * 1.4426950408889634f; const float m2 = fmaxf(st.m[q], sk); const float e1 = __builtin_amdgcn_exp2f(st.m[q] - m2);
              const float den = l * e1 + __builtin_amdgcn_exp2f(sk - m2); const float rl = e1 / den;
              bf16* op = YAB + (size_t)(seq0 + tq[q]) * YABW + 1024 + qh * 128 + 4 * g;
#pragma unroll
              for (int dt = 0; dt < 8; ++dt) { const f32x4 o = st.O[q][dt] * rl; v2u w; w.x = pk2(o[0], o[1]); w.y = pk2(o[2], o[3]); *(v2u*)(op + 16 * dt) = w; } }
      } }
}

__device__ __forceinline__ void final_norm(Frame& F, const Ptrs& P) {
    const int gw = F.vcu * NWAVES + F.wave, NGW = F.G * NWAVES; const float* ss3 = (const float*)(F.ctl + CW_SS3); const bf16* H3 = (const bf16*)(P.ws + WS_AB1);
    f32x4 gv[8][2];
#pragma unroll
    for (int j = 0; j < 8; ++j) { gv[j][0] = ((const f32x4*)P.gfin)[2 * (F.lane + 64 * j)]; gv[j][1] = ((const f32x4*)P.gfin)[2 * (F.lane + 64 * j) + 1]; }
    for (int m = gw; m < M; m += NGW) { const float rs = __builtin_amdgcn_rsqf(ss3[m] * (1.0f / 4096.0f) + 1e-6f);
        const GAS v4u* hi = (const GAS v4u*)(H3 + (size_t)m * D) + F.lane; GAS f32x4* o = (GAS f32x4*)(P.out + (size_t)m * D) + 2 * F.lane;
#pragma unroll
        for (int j = 0; j < 8; ++j) { const v4u w = hi[64 * j];
            const f32x4 v0 = {pg8::bf_lo(w.x), pg8::bf_hi(w.x), pg8::bf_lo(w.y), pg8::bf_hi(w.y)}, v1 = {pg8::bf_lo(w.z), pg8::bf_hi(w.z), pg8::bf_lo(w.w), pg8::bf_hi(w.w)};
            o[128 * j] = v0 * rs * gv[j][0]; o[128 * j + 1] = v1 * rs * gv[j][1]; } }
}

struct Args { const float* in[17]; float* out; unsigned char* ws; int ph_lo, ph_hi, li, pad; };
__global__ void __launch_bounds__(NWAVES * 64, 2) mk_fwd(Args args) {
    extern __shared__ __attribute__((aligned(16))) unsigned char lds[];
    Frame F;
    F.lds = (LAS unsigned char*)lds;
    F.MISC = (volatile LAS unsigned*)(F.lds + MISC_OFF);
    F.tid = threadIdx.x; F.lane = F.tid & 63; F.wave = __builtin_amdgcn_readfirstlane(F.tid >> 6);
    F.G = gridDim.x; { const int bx = blockIdx.x; F.vcu = (F.G % 8 == 0) ? (bx % 8) * (F.G / 8) + bx / 8 : bx; }
    unsigned char* ws = args.ws;
    F.ctl = (gu32*)(ws + WS_CTL);
    Ptrs P;
    P.xp = args.in[0]; P.xs = args.in[1]; P.g1 = args.in[2]; P.w1g = args.in[3]; P.w1u = args.in[4]; P.w1d = args.in[5]; P.gmix = args.in[6]; P.win = args.in[7]; P.sink = args.in[8];
    P.wa = args.in[9]; P.wb = args.in[10]; P.wout = args.in[11]; P.g2 = args.in[12]; P.w2g = args.in[13]; P.w2u = args.in[14]; P.w2d = args.in[15]; P.gfin = args.in[16];
    P.out = args.out; P.ws = ws;
    for (int u = F.tid; u < (LDS_BYTES - LDSCTL_OFF) / 4; u += NWAVES * 64) ((LAS unsigned*)(F.lds + LDSCTL_OFF))[u] = 0u;
    __syncthreads();
    XcdBarrier bar; bar.bar = (unsigned*)(F.ctl + CW_BAR); bar.x = 0; bar.st = nullptr;
    if (N_LAUNCHES != PER_PHASE) bar = xcd_barrier_post((unsigned*)(F.ctl + CW_BAR), F.MISC + 8);
#define GRID_BAR(seam) do { if (N_LAUNCHES != PER_PHASE) xcd_barrier(bar); } while (0)
    const int lo = args.ph_lo, hi = args.ph_hi;
#define IN(k) (lo <= (k) && (k) < hi)
#define BOTH(k) (IN(k) && IN((k) + 1))
    bf16* AB1 = (bf16*)(ws + WS_AB1); bf16* ACT = (bf16*)(ws + WS_ACT); bf16* QKVB = (bf16*)(ws + WS_QKV);
    bf16* WGU = (bf16*)(ws + WS_WGU); bf16* WDN = (bf16*)(ws + WS_WD); bf16* WIN = (bf16*)(ws + WS_WIN); bf16* WAB = (bf16*)(ws + WS_WAB); bf16* WOUT = (bf16*)(ws + WS_WOUT);
    float* ss0 = (float*)(ws + WS_SS0); float* ss1 = (float*)(F.ctl + CW_SS1); float* ss2 = (float*)(F.ctl + CW_SS2); float* ss3 = (float*)(F.ctl + CW_SS3);
    const float* rope = (const float*)(ws + WS_ROPE);

    if (IN(0)) { for (int rep = 0; rep < NREP(0); ++rep) p0_prologue(F, P); if (BOTH(0)) GRID_BAR(0); }
    if (IN(1)) { pg8::Gemm g{AB1, WGU, M, 2 * FF, D}; pg8::StaticOrder S; S.init(M, 2 * FF, F.G, (int)blockIdx.x, WGM_UP);
        pg8::EpiSwiglu E{ACT, FF, ss0, F.lds + SSL_OFF};
        for (int rep = 0; rep < NREP(1); ++rep)
        pg8::gemm_phase<pg8::EpiSwiglu, pg8::StaticOrder, PG8_ALIGN, PG8_SP2>(F.lds + RING_OFF, g, S, E);
        {
          const int nwg = (M / 256) * (2 * FF / 256), rem = nwg % F.G, c = (int)blockIdx.x;
          if (rem == 0) cvt_run<2>(F, P, c * NWAVES + F.wave, F.G * NWAVES);
          else if (c >= rem) cvt_run<2>(F, P, (c - rem) * NWAVES + F.wave, (F.G - rem) * NWAVES); }
        if (PROBE_REPEAT == 21) { pg8::FixedOrder S2; S2.init(M, 2 * FF, F.G, (int)blockIdx.x); pg8::EpiSwiglu E2{QKVB, FF, ss0, F.lds + SSL_OFF};
            pg8::gemm_phase<pg8::EpiSwiglu, pg8::FixedOrder, PG8_ALIGN, PG8_SP2>(F.lds + RING_OFF, g, S2, E2); }
        if (BOTH(1)) GRID_BAR(1); }
    if (IN(2) && PROBE_REPEAT >= 100 && PROBE_REPEAT < 104) {
        pg8::Gemm g{AB1, WGU, M, 2 * FF, D}; pg8::StaticOrder S; S.init(M, 2 * FF, F.G, (int)blockIdx.x, WGM_UP);
        pg8::EpiSwigluT<(PROBE_REPEAT >= 100 ? PROBE_REPEAT - 100 : 0)> E{QKVB, FF, ss0, F.lds + SSL_OFF};
        pg8::gemm_phase<pg8::EpiSwigluT<(PROBE_REPEAT >= 100 ? PROBE_REPEAT - 100 : 0)>, pg8::StaticOrder, PG8_ALIGN, PG8_SP2>(F.lds + RING_OFF, g, S, E);
        GRID_BAR(1); }
    if (IN(2)) { if (STAGGER_TICKS) xcd_stagger(STAGGER_TICKS); pg8::Gemm g{ACT, WDN, M, D, FF}; pg8::StaticOrder S; S.init(M, D, F.G, (int)blockIdx.x, WGM_DOWN);
        pg8::EpiResid<true, false, true, true> E{AB1, AB1, M, nullptr, AB1, ss1, 0.5f};
        pg8::gemm_phase<pg8::EpiResid<true, false, true, true>, pg8::StaticOrder, PG8_ALIGN, PG8_SP2>(F.lds + RING_OFF, g, S, E);
        if (BOTH(2)) GRID_BAR(2); }
    if (IN(3)) { pg8::Gemm g{AB1, WIN, M, NIN, D}; pg8::StaticOrder S; S.init(M, NIN, F.G, (int)blockIdx.x, WGM_IN);
        pg8::EpiProj E{QKVB, ACT, ss1, rope, F.lds + SSL_OFF};
        pg8::gemm_phase<pg8::EpiProj, pg8::StaticOrder, PG8_ALIGN, PG8_SP2>(F.lds + RING_OFF, g, S, E);
        if (NREP(3) == 2) pg8::gemm_phase<pg8::EpiProj, pg8::StaticOrder, PG8_ALIGN, PG8_SP2>(F.lds + RING_OFF, g, S, E);
        if (BOTH(3)) GRID_BAR(3); }
    if (IN(4)) { for (int rep = 0; rep < NREP(4); ++rep) attn_phase<(PROBE_REPEAT == 42) ? 1 : 0>(F, P); for (int rep = 0; rep < NREP(14); ++rep) p4_convert_w2(F, P); if (BOTH(4)) GRID_BAR(4); }
    if (IN(5)) { pg8::Gemm g{(const bf16*)P.out, WAB, M, D, YABW}; pg8::StaticOrder S; S.init(M, D, F.G, (int)blockIdx.x, WGM_DOWN);
        pg8::EpiMerge E{ACT, QKVB};
        for (int rep = 0; rep < NREP(5); ++rep)
        pg8::gemm_phase<pg8::EpiMerge, pg8::StaticOrder, PG8_ALIGN, PG8_SP2>(F.lds + RING_OFF, g, S, E);
        if (BOTH(5)) GRID_BAR(5); }
    if (IN(6)) { if (STAGGER_TICKS) xcd_stagger(STAGGER_TICKS); pg8::Gemm g{QKVB, WOUT, M, D, D}; pg8::StaticOrder S; S.init(M, D, F.G, (int)blockIdx.x, WGM_DOWN);
        pg8::EpiResid<true, false, true, true> E{AB1, AB1, M, nullptr, AB1, ss2, 1.0f};
        pg8::gemm_phase<pg8::EpiResid<true, false, true, true>, pg8::StaticOrder, PG8_ALIGN, PG8_SP2>(F.lds + RING_OFF, g, S, E);
        if (BOTH(6)) GRID_BAR(6); }
    if (IN(7)) { pg8::Gemm g{AB1, WGU, M, 2 * FF, D}; pg8::StaticOrder S; S.init(M, 2 * FF, F.G, (int)blockIdx.x, WGM_UP);
        pg8::EpiSwiglu E{ACT, FF, ss2, F.lds + SSL_OFF};
        pg8::gemm_phase<pg8::EpiSwiglu, pg8::StaticOrder, PG8_ALIGN, PG8_SP2>(F.lds + RING_OFF, g, S, E);
        {
          const int nwg = (M / 256) * (2 * FF / 256), rem = nwg % F.G, c = (int)blockIdx.x;
          if (rem == 0) cvt_run<3>(F, P, c * NWAVES + F.wave, F.G * NWAVES);
          else if (c >= rem) cvt_run<3>(F, P, (c - rem) * NWAVES + F.wave, (F.G - rem) * NWAVES); }
        if (BOTH(7)) GRID_BAR(7); }
    if (IN(8)) { if (STAGGER_TICKS) xcd_stagger(STAGGER_TICKS); pg8::Gemm g{ACT, WDN, M, D, FF}; pg8::StaticOrder S; S.init(M, D, F.G, (int)blockIdx.x, WGM_DOWN);
        pg8::EpiResid<true, false, true, true> E{AB1, AB1, M, nullptr, AB1, ss3, 0.5f};
        pg8::gemm_phase<pg8::EpiResid<true, false, true, true>, pg8::StaticOrder, PG8_ALIGN, PG8_SP2>(F.lds + RING_OFF, g, S, E);
        if (BOTH(8)) GRID_BAR(8); }
    if (IN(9)) { final_norm(F, P); }
#undef IN
#undef BOTH
#undef GRID_BAR
}

extern "C" void kernel_launch(void* const* d_in, const int* in_sizes, int n_in, void* d_out, int out_size, void* d_ws, size_t ws_size, hipStream_t stream) {
    static int grid = 0;
    if (grid == 0) {
        if (n_in != 17 || out_size != M * D || ws_size < WS_END) { fprintf(stderr, "kernel_launch: unexpected shapes (n_in %d, out %d, ws %zu, need %zu)\n", n_in, out_size, ws_size, (size_t)WS_END); grid = -1; return; }
        int dev = 0, cus = 0, per_cu = 0;
        if (hipGetDevice(&dev) != hipSuccess || hipDeviceGetAttribute(&cus, hipDeviceAttributeMultiprocessorCount, dev) != hipSuccess) { grid = -1; return; }
        if (hipFuncSetAttribute((const void*)mk_fwd, hipFuncAttributeMaxDynamicSharedMemorySize, LDS_BYTES) != hipSuccess) { fprintf(stderr, "kernel_launch: hipFuncSetAttribute failed\n"); grid = -1; return; }
        if (hipOccupancyMaxActiveBlocksPerMultiprocessor(&per_cu, (const void*)mk_fwd, NWAVES * 64, LDS_BYTES) != hipSuccess || per_cu < 1) { fprintf(stderr, "kernel_launch: occupancy query says %d\n", per_cu); }
        (void)hipGetLastError();
        grid = cus;
    }
    if (grid < 0) return;
    (void)hipMemsetAsync((char*)d_ws + WS_CTL, 0, CTL_ZERO_BYTES, stream);
    Args a{};
    for (int i = 0; i < 17; ++i) a.in[i] = (const float*)d_in[i];
    a.out = (float*)d_out; a.ws = (unsigned char*)d_ws; a.pad = 0;
    for (int li = 0; li < N_LAUNCHES; ++li) {
        a.ph_lo = (N_LAUNCHES == PER_PHASE) ? li : 0; a.ph_hi = (N_LAUNCHES == PER_PHASE) ? li + 1 : PER_PHASE; a.li = li;
        hipLaunchKernelGGL(mk_fwd, dim3(grid), dim3(NWAVES * 64), LDS_BYTES, stream, a);
    }
}
```

```cpp
#include <hip/hip_runtime.h>
#include <cstdio>
#include <cstdint>

#ifndef MK_N_LAUNCHES
#define MK_N_LAUNCHES 1
#endif
#ifndef PROBE_REPEAT
#define PROBE_REPEAT -1
#endif
#define NREP(k) ((PROBE_REPEAT == (k)) ? 2 : 1)
#ifndef WGM_DOWN
#define WGM_DOWN 4
#endif
#ifndef WGM_UP
#define WGM_UP 8
#endif
#ifndef WGM_IN
#define WGM_IN 8
#endif
#ifndef RES_DEPTH
#define RES_DEPTH 8
#endif
#ifndef RES_DEPTH_F
#define RES_DEPTH_F 4
#endif
#ifndef STAGGER_TICKS
#define STAGGER_TICKS 0
#endif

namespace pg8 {
#define PG8_LAS __attribute__((address_space(3)))
typedef unsigned short bf16_t;
typedef short bf16x8 __attribute__((ext_vector_type(8)));
typedef float f32x4 __attribute__((ext_vector_type(4)));
typedef unsigned u32x4 __attribute__((ext_vector_type(4)));
constexpr int BM = 256, BK = 64, HALF = 128, HTB = HALF * BK * 2, STAGE_BYTES = 8 * HTB, NXCD = 8, WGM = 8;

__host__ __device__ __forceinline__ int lds_byte(int r, int c) { const int st = (r >> 4) * 2 + (c >> 5), rr = r & 15, cc = c & 31, ob = rr * 64 + cc * 2; return st * 1024 + (ob ^ (((ob >> 9) & 1) << 5)); }
__host__ __device__ __forceinline__ void stage_rc(int b, int& R, int& C) { const int st = b / 1024, sb = b % 1024, swz = sb ^ (((sb >> 9) & 1) << 5); R = (st >> 1) * 16 + swz / 64; C = (st & 1) * 32 + (swz % 64) / 2; }
__host__ __device__ __forceinline__ int perm32(int rho) { const int n = rho >> 4, i = rho & 15; return 8 * (i >> 2) + 4 * n + (i & 3); }

struct Unit { int pm, pn; };
__device__ __forceinline__ void ss_prefetch(const float* ss, PG8_LAS unsigned char* ssl, int pm, int wid, int lane) {
    const float* src = ss + pm * 256 + (wid >> 2) * 64 + lane;
    __builtin_amdgcn_global_load_lds((const unsigned*)src, (PG8_LAS unsigned*)(ssl + wid * 512), 4, 0, 0);
    __builtin_amdgcn_global_load_lds((const unsigned*)(src + 128), (PG8_LAS unsigned*)(ssl + wid * 512 + 256), 4, 0, 0);
}
__device__ __forceinline__ float ss_lds(PG8_LAS unsigned char* ssl, int wr, int wc, int fr, int ai, int m) { return *(const PG8_LAS float*)(ssl + (wr * 4 + wc) * 512 + ai * 256 + (m * 16 + fr) * 4); }
struct Gemm { const bf16_t* A; const bf16_t* Bt; int M, N, K; };

struct StaticOrder {
    int nM, nN, nwg, G, c, wgm;
    __host__ __device__ void init(int M, int N, int G_, int c_, int wgm_ = WGM) { nM = M / BM; nN = N / BM; nwg = nM * nN; G = G_; c = c_; wgm = wgm_; }
    __host__ __device__ bool next(int i, Unit& u) const {
        const long L = (long)i * G + c; if (L >= nwg) return false;
        int wgid = (int)L; { const int q = nwg / NXCD, r = nwg % NXCD, xcd = wgid % NXCD, off = wgid / NXCD; wgid = (xcd < r ? xcd * (q + 1) : r * (q + 1) + (xcd - r) * q) + off; }
        const int nig = wgm * nN, gid = wgid / nig, fm = gid * wgm, gsz = (nM - fm) < wgm ? (nM - fm) : wgm;
        u.pm = fm + ((wgid % nig) % gsz); u.pn = (wgid % nig) / gsz; return true;
    }
    __device__ __forceinline__ void a_ready(const Unit&) const {}
    __device__ __forceinline__ void done(const Unit&) const {}
};

struct FixedOrder : StaticOrder {
    __host__ __device__ bool next(int i, Unit& u) const { Unit t; if (!StaticOrder::next(i, t)) return false; u.pm = 0; u.pn = 0; return true; }
};
__device__ __forceinline__ unsigned cvt_pk_bf16(float lo, float hi) { unsigned r; asm volatile("v_cvt_pk_bf16_f32 %0, %1, %2" : "=v"(r) : "v"(lo), "v"(hi)); return r; }
__device__ __forceinline__ float bf_lo(unsigned w) { return __uint_as_float(w << 16); }
__device__ __forceinline__ float bf_hi(unsigned w) { return __uint_as_float(w & 0xffff0000u); }
__device__ __forceinline__ float xsum_16_32(float x) {
    auto r = __builtin_amdgcn_permlane16_swap(__float_as_uint(x), __float_as_uint(x), false, false); x = __uint_as_float(r[0]) + __uint_as_float(r[1]);
    auto q = __builtin_amdgcn_permlane32_swap(__float_as_uint(x), __float_as_uint(x), false, false); return __uint_as_float(q[0]) + __uint_as_float(q[1]); }
__device__ __forceinline__ float xmax_16_32(float x) {
    auto r = __builtin_amdgcn_permlane16_swap(__float_as_uint(x), __float_as_uint(x), false, false); x = fmaxf(__uint_as_float(r[0]), __uint_as_float(r[1]));
    auto q = __builtin_amdgcn_permlane32_swap(__float_as_uint(x), __float_as_uint(x), false, false); return fmaxf(__uint_as_float(q[0]), __uint_as_float(q[1])); }
__device__ __forceinline__ float sigmoid_f(float x) { return __builtin_amdgcn_rcpf(1.0f + __builtin_amdgcn_exp2f(-1.44269504089f * x)); }

__device__ __forceinline__ unsigned ror8(unsigned x) { return (unsigned)__builtin_amdgcn_mov_dpp((int)x, 0x128, 0xf, 0xf, true); }
__device__ __forceinline__ u32x4 ror8(const u32x4 v) { u32x4 r; r.x = ror8(v.x); r.y = ror8(v.y); r.z = ror8(v.z); r.w = ror8(v.w); return r; }
__device__ __forceinline__ u32x4 sel4(bool c, const u32x4 a, const u32x4 b) { u32x4 r; r.x = c ? a.x : b.x; r.y = c ? a.y : b.y; r.z = c ? a.z : b.z; r.w = c ? a.w : b.w; return r; }
__device__ __forceinline__ void pair_to_lines(const u32x4 X, const u32x4 Y, bool lo8, u32x4& D1, u32x4& D2) { D1 = sel4(lo8, X, ror8(Y)); D2 = sel4(lo8, ror8(X), Y); }
__device__ __forceinline__ void lines_to_pair(const u32x4 L1, const u32x4 L2, bool lo8, u32x4& X, u32x4& Y) { X = sel4(lo8, L1, ror8(L2)); Y = sel4(lo8, ror8(L1), L2); }


template <int MODE> struct EpiSwigluT {
    static constexpr bool PERM = true, AFTER_DRAIN = false, HAS_MID = false, SS_LDS = true, ADJ = false; static constexpr int MID_T = 0, VM_TAIL = (MODE & 1) ? 0 : 8;
    bf16_t* O; int ldc; const float* ss; PG8_LAS unsigned char* ssl;
    __device__ __forceinline__ void mid(f32x4 (&)[2][2][4][2], const Unit&, int, int, int, int) const {}
    __device__ __forceinline__ void operator()(f32x4 (&acc)[2][2][4][2], const Unit& u, int wr, int wc, int fr, int fq) const {
        const int row0 = u.pm * BM + wr * 64 + fr, col0 = u.pn * HALF + wc * 32 + 8 * fq;
        float rs[2][4];
#pragma unroll
        for (int ai = 0; ai < 2; ++ai)
#pragma unroll
            for (int m = 0; m < 4; ++m) rs[ai][m] = (MODE & 2) ? 4096.0f * (float)(fr + 1) : ss_lds(ssl, wr, wc, fr, ai, m);
#pragma unroll
        for (int ai = 0; ai < 2; ++ai)
#pragma unroll
            for (int m = 0; m < 4; ++m) { const int r = row0 + ai * HALF + m * 16; const float rr = __builtin_amdgcn_rsqf(rs[ai][m] * (1.0f / 4096.0f) + 1e-6f);
                const float c1 = -1.44269504089f * rr, rr2 = rr * rr; f32x4 o[2];
#pragma unroll
                for (int n = 0; n < 2; ++n) { const f32x4 g = acc[ai][0][m][n], up = acc[ai][1][m][n]; const f32x4 t = g * c1;
                    f32x4 d = {__builtin_amdgcn_exp2f(t[0]), __builtin_amdgcn_exp2f(t[1]), __builtin_amdgcn_exp2f(t[2]), __builtin_amdgcn_exp2f(t[3])}; d = d + 1.0f;
                    const f32x4 q = {__builtin_amdgcn_rcpf(d[0]), __builtin_amdgcn_rcpf(d[1]), __builtin_amdgcn_rcpf(d[2]), __builtin_amdgcn_rcpf(d[3])};
                    o[n] = ((g * up) * rr2) * q; }
                u32x4 w; w.x = cvt_pk_bf16(o[0][0], o[0][1]); w.y = cvt_pk_bf16(o[0][2], o[0][3]); w.z = cvt_pk_bf16(o[1][0], o[1][1]); w.w = cvt_pk_bf16(o[1][2], o[1][3]);
                if (MODE & 1) asm volatile("" :: "v"(w.x), "v"(w.y), "v"(w.z), "v"(w.w)); else *(u32x4*)(O + (size_t)r * ldc + col0) = w; }
    }
};
using EpiSwiglu = EpiSwigluT<0>;

template <bool BASE_BF16, bool OUT_F32, bool HAS_OB, bool ADJ_ = false> struct EpiResid {
    static constexpr bool PERM = true, AFTER_DRAIN = false, HAS_MID = false, SS_LDS = false, ADJ = ADJ_; static constexpr int MID_T = 0, VM_TAIL = (HAS_OB || OUT_F32) ? 16 : 0;
    const void* base_lo; const void* base_hi; int split_row; float* out; bf16_t* ob; float* ss; float scale;
    __device__ __forceinline__ void mid(f32x4 (&)[2][2][4][2], const Unit&, int, int, int, int) const {}
    __device__ __forceinline__ void operator()(f32x4 (&acc)[2][2][4][2], const Unit& u, int wr, int wc, int fr, int fq) const {
        if constexpr (ADJ_) {
            static_assert(BASE_BF16 && HAS_OB && !OUT_F32, "ADJ residual epilogue: bf16 base, bf16 output");
            const bool lo8 = fr < 8; const int rb = u.pm * BM + wr * 64, row0 = rb + fr;
            const size_t lane_off = (size_t)(rb + (fr & 7)) * 4096 + u.pn * BM + wc * 64 + 32 * (fr >> 3) + 8 * fq;
            const bf16_t* bb = (const bf16_t*)((u.pm * BM < split_row) ? base_lo : base_hi) - ((u.pm * BM < split_row) ? (size_t)0 : (size_t)split_row * 4096);
            u32x4 tb[8][2];
#pragma unroll
            for (int k = 0; k < 8; ++k) { const size_t o_ = lane_off + (size_t)((k >> 2) * HALF + (k & 3) * 16) * 4096; tb[k][0] = *(const u32x4*)(bb + o_); tb[k][1] = *(const u32x4*)(bb + o_ + 8 * 4096); }
#pragma unroll
            for (int k = 0; k < 8; ++k) { const int ai = k >> 2, m = k & 3; u32x4 w[2]; lines_to_pair(tb[k][0], tb[k][1], lo8, w[0], w[1]);
#pragma unroll
                for (int bj = 0; bj < 2; ++bj) {
                    acc[ai][bj][m][0] = (f32x4){bf_lo(w[bj].x), bf_hi(w[bj].x), bf_lo(w[bj].y), bf_hi(w[bj].y)} + acc[ai][bj][m][0] * scale;
                    acc[ai][bj][m][1] = (f32x4){bf_lo(w[bj].z), bf_hi(w[bj].z), bf_lo(w[bj].w), bf_hi(w[bj].w)} + acc[ai][bj][m][1] * scale; }
                asm volatile("" : "+v"(acc[ai][0][m][0]), "+v"(acc[ai][0][m][1]), "+v"(acc[ai][1][m][0]), "+v"(acc[ai][1][m][1]));
                __builtin_amdgcn_sched_barrier(0); }
#pragma unroll
            for (int k = 0; k < 8; ++k) { const int ai = k >> 2, m = k & 3; const int r = row0 + ai * HALF + m * 16; float sq = 0.f; u32x4 w[2];
#pragma unroll
                for (int bj = 0; bj < 2; ++bj) { const f32x4 v0 = acc[ai][bj][m][0], v1 = acc[ai][bj][m][1];
                    sq += (v0[0] * v0[0] + v0[1] * v0[1]) + (v0[2] * v0[2] + v0[3] * v0[3]) + (v1[0] * v1[0] + v1[1] * v1[1]) + (v1[2] * v1[2] + v1[3] * v1[3]);
                    w[bj].x = cvt_pk_bf16(v0[0], v0[1]); w[bj].y = cvt_pk_bf16(v0[2], v0[3]); w[bj].z = cvt_pk_bf16(v1[0], v1[1]); w[bj].w = cvt_pk_bf16(v1[2], v1[3]); }
                u32x4 d1, d2; pair_to_lines(w[0], w[1], lo8, d1, d2);
                const size_t o_ = lane_off + (size_t)(ai * HALF + m * 16) * 4096; *(u32x4*)(ob + o_) = d1; *(u32x4*)(ob + o_ + 8 * 4096) = d2;
                sq = xsum_16_32(sq);
                if (fq == 0) __hip_atomic_fetch_add(ss + r, sq, __ATOMIC_RELAXED, __HIP_MEMORY_SCOPE_AGENT); }
            return;
        }
        const int row0 = u.pm * BM + wr * 64 + fr, col0 = u.pn * BM + wc * 32 + 8 * fq;
        if constexpr (BASE_BF16) {
            const bf16_t* bb = (const bf16_t*)((u.pm * BM < split_row) ? base_lo : base_hi) - ((u.pm * BM < split_row) ? (size_t)0 : (size_t)split_row * 4096);
            u32x4 tb[RES_DEPTH][2];
#define RES_LOAD(k) do { const size_t off_ = (size_t)(row0 + ((k) >> 2) * HALF + ((k) & 3) * 16) * 4096 + col0; \
                tb[(k) % RES_DEPTH][0] = *(const u32x4*)(bb + off_); tb[(k) % RES_DEPTH][1] = *(const u32x4*)(bb + off_ + HALF); } while (0)
#pragma unroll
            for (int k = 0; k < RES_DEPTH - 1; ++k) RES_LOAD(k);
#pragma unroll
            for (int k = 0; k < 8; ++k) { const int ai = k >> 2, m = k & 3;
                if (k + RES_DEPTH - 1 < 8) RES_LOAD(k + RES_DEPTH - 1);
#pragma unroll
                for (int bj = 0; bj < 2; ++bj) { const u32x4 w = tb[k % RES_DEPTH][bj];
                    acc[ai][bj][m][0] = (f32x4){bf_lo(w.x), bf_hi(w.x), bf_lo(w.y), bf_hi(w.y)} + acc[ai][bj][m][0] * scale;
                    acc[ai][bj][m][1] = (f32x4){bf_lo(w.z), bf_hi(w.z), bf_lo(w.w), bf_hi(w.w)} + acc[ai][bj][m][1] * scale; }
                asm volatile("" : "+v"(acc[ai][0][m][0]), "+v"(acc[ai][0][m][1]), "+v"(acc[ai][1][m][0]), "+v"(acc[ai][1][m][1]));
                __builtin_amdgcn_sched_barrier(0); }
#undef RES_LOAD
        } else {
            const float* bb = (const float*)((u.pm * BM < split_row) ? base_lo : base_hi) - ((u.pm * BM < split_row) ? (size_t)0 : (size_t)split_row * 4096);
            f32x4 tb[RES_DEPTH_F][4];
#define RES_LOAD(k) do { const size_t off_ = (size_t)(row0 + ((k) >> 2) * HALF + ((k) & 3) * 16) * 4096 + col0; \
                tb[(k) % RES_DEPTH_F][0] = __builtin_nontemporal_load((const f32x4*)(bb + off_)); tb[(k) % RES_DEPTH_F][1] = __builtin_nontemporal_load((const f32x4*)(bb + off_ + 4)); tb[(k) % RES_DEPTH_F][2] = __builtin_nontemporal_load((const f32x4*)(bb + off_ + HALF)); tb[(k) % RES_DEPTH_F][3] = __builtin_nontemporal_load((const f32x4*)(bb + off_ + HALF + 4)); } while (0)
#pragma unroll
            for (int k = 0; k < RES_DEPTH_F - 1; ++k) RES_LOAD(k);
#pragma unroll
            for (int k = 0; k < 8; ++k) { const int ai = k >> 2, m = k & 3;
                if (k + RES_DEPTH_F - 1 < 8) RES_LOAD(k + RES_DEPTH_F - 1);
                acc[ai][0][m][0] = tb[k % RES_DEPTH_F][0] + acc[ai][0][m][0] * scale; acc[ai][0][m][1] = tb[k % RES_DEPTH_F][1] + acc[ai][0][m][1] * scale;
                acc[ai][1][m][0] = tb[k % RES_DEPTH_F][2] + acc[ai][1][m][0] * scale; acc[ai][1][m][1] = tb[k % RES_DEPTH_F][3] + acc[ai][1][m][1] * scale;
                asm volatile("" : "+v"(acc[ai][0][m][0]), "+v"(acc[ai][0][m][1]), "+v"(acc[ai][1][m][0]), "+v"(acc[ai][1][m][1]));
                __builtin_amdgcn_sched_barrier(0); }
#undef RES_LOAD
        }
#pragma unroll
        for (int ai = 0; ai < 2; ++ai)
#pragma unroll
            for (int m = 0; m < 4; ++m) { const int r = row0 + ai * HALF + m * 16; const size_t off = (size_t)r * 4096 + col0; float sq = 0.f;
#pragma unroll
                for (int bj = 0; bj < 2; ++bj) { const f32x4 v0 = acc[ai][bj][m][0], v1 = acc[ai][bj][m][1];
                    if (OUT_F32) { *(f32x4*)(out + off + bj * HALF) = v0; *(f32x4*)(out + off + bj * HALF + 4) = v1; }
                    sq += (v0[0] * v0[0] + v0[1] * v0[1]) + (v0[2] * v0[2] + v0[3] * v0[3]) + (v1[0] * v1[0] + v1[1] * v1[1]) + (v1[2] * v1[2] + v1[3] * v1[3]);
                    if (HAS_OB) { u32x4 w; w.x = cvt_pk_bf16(v0[0], v0[1]); w.y = cvt_pk_bf16(v0[2], v0[3]); w.z = cvt_pk_bf16(v1[0], v1[1]); w.w = cvt_pk_bf16(v1[2], v1[3]); *(u32x4*)(ob + off + bj * HALF) = w; } }
                sq = xsum_16_32(sq);
                if (fq == 0) __hip_atomic_fetch_add(ss + r, sq, __ATOMIC_RELAXED, __HIP_MEMORY_SCOPE_AGENT); }
    }
};

struct EpiProj {
    static constexpr bool PERM = true, AFTER_DRAIN = false, HAS_MID = false, SS_LDS = true, ADJ = true; static constexpr int MID_T = 0, VM_TAIL = 16;
    bf16_t* qkv; bf16_t* gates; const float* ss; const float* rope; PG8_LAS unsigned char* ssl;
    __device__ __forceinline__ void mid(f32x4 (&)[2][2][4][2], const Unit&, int, int, int, int) const {}
    __device__ __forceinline__ void operator()(f32x4 (&acc)[2][2][4][2], const Unit& u, int wr, int wc, int fr, int fq) const {
        const int pn = u.pn; const bool is_gate = pn >= 48, is_rope = (pn < 24) || (pn >= 36 && pn < 46);
        const int rb = u.pm * BM + wr * 64, row0 = rb + fr; const bool lo8 = fr < 8;
        const bool do_rope = is_rope && ((wc & 1) == 0); const float sgn = fq < 2 ? -1.0f : 1.0f;
        float rs[2][4];
#pragma unroll
        for (int ai = 0; ai < 2; ++ai)
#pragma unroll
            for (int m = 0; m < 4; ++m) rs[ai][m] = ss_lds(ssl, wr, wc, fr, ai, m);
#pragma unroll
        for (int ai = 0; ai < 2; ++ai)
#pragma unroll
            for (int m = 0; m < 4; ++m) { const int r = row0 + ai * HALF + m * 16; const float rr = __builtin_amdgcn_rsqf(rs[ai][m] * (1.0f / 4096.0f) + 1e-6f);
#pragma unroll
                for (int bj = 0; bj < 2; ++bj) { acc[ai][bj][m][0] *= rr; acc[ai][bj][m][1] *= rr; }
                if (do_rope) { const int pos = r < 8192 ? (r & 4095) : r - 8192; const float* tp = rope + (size_t)pos * 32 + 8 * (fq & 1);
                    const f32x4 c0 = *(const f32x4*)tp, c1 = *(const f32x4*)(tp + 4), s0 = *(const f32x4*)(tp + 16), s1 = *(const f32x4*)(tp + 20);
                    f32x4 v0 = acc[ai][0][m][0], v1 = acc[ai][0][m][1];
#pragma unroll
                    for (int j = 0; j < 4; ++j) { const float p0 = __shfl_xor(v0[j], 32), p1 = __shfl_xor(v1[j], 32); v0[j] = v0[j] * c0[j] + sgn * p0 * s0[j]; v1[j] = v1[j] * c1[j] + sgn * p1 * s1[j]; }
                    acc[ai][0][m][0] = v0; acc[ai][0][m][1] = v1; } }
#pragma unroll
        for (int ai = 0; ai < 2; ++ai)
#pragma unroll
            for (int m = 0; m < 4; ++m) {
                if (is_gate) {
                    bf16_t* gd = gates + (size_t)(row0 + ai * HALF + m * 16) * 8192 + (pn - 48) * HALF + wc * 32 + 8 * fq; f32x4 uu[2], sbv[2];
#pragma unroll
                    for (int n = 0; n < 2; ++n)
#pragma unroll
                        for (int j = 0; j < 4; ++j) { const float da = 1.0f + __builtin_amdgcn_exp2f(-1.44269504089f * acc[ai][0][m][n][j]), db = 1.0f + __builtin_amdgcn_exp2f(-1.44269504089f * acc[ai][1][m][n][j]);
                            sbv[n][j] = __builtin_amdgcn_rcpf(db); uu[n][j] = __builtin_amdgcn_rcpf(da) * fminf(db, 1e20f); }
                    u32x4 w; w.x = cvt_pk_bf16(uu[0][0], uu[0][1]); w.y = cvt_pk_bf16(uu[0][2], uu[0][3]); w.z = cvt_pk_bf16(uu[1][0], uu[1][1]); w.w = cvt_pk_bf16(uu[1][2], uu[1][3]);
                    *(u32x4*)gd = w;
                    w.x = cvt_pk_bf16(sbv[0][0], sbv[0][1]); w.y = cvt_pk_bf16(sbv[0][2], sbv[0][3]); w.z = cvt_pk_bf16(sbv[1][0], sbv[1][1]); w.w = cvt_pk_bf16(sbv[1][2], sbv[1][3]);
                    *(u32x4*)(gd + 4096) = w;
                } else {
                    u32x4 w[2];
#pragma unroll
                    for (int bj = 0; bj < 2; ++bj) { const f32x4 v0 = acc[ai][bj][m][0], v1 = acc[ai][bj][m][1];
                        w[bj].x = cvt_pk_bf16(v0[0], v0[1]); w[bj].y = cvt_pk_bf16(v0[2], v0[3]); w[bj].z = cvt_pk_bf16(v1[0], v1[1]); w[bj].w = cvt_pk_bf16(v1[2], v1[3]); }
                    u32x4 d1, d2; pair_to_lines(w[0], w[1], lo8, d1, d2);
                    bf16_t* op = qkv + (size_t)(rb + (fr & 7) + ai * HALF + m * 16) * 12288 + pn * BM + wc * 64 + 32 * (fr >> 3) + 8 * fq; *(u32x4*)op = d1; *(u32x4*)(op + 8 * 12288) = d2; } }
    }
};

struct EpiMerge {
    static constexpr bool PERM = true, AFTER_DRAIN = false, HAS_MID = true, SS_LDS = false, ADJ = false; static constexpr int MID_T = 16, VM_TAIL = 16;
    const bf16_t* gates; bf16_t* O;
    static constexpr int MID_DEPTH = 4, END_DEPTH = 8;
    __device__ __forceinline__ void mid(f32x4 (&acc)[2][2][4][2], const Unit& u, int wr, int wc, int fr, int fq) const {
        const __amdgpu_buffer_rsrc_t rsG = __builtin_amdgcn_make_buffer_rsrc((void*)gates, (short)0, (int)0xffffffffu, 0x00020000);
        int vo = ((u.pm * BM + wr * 64 + fr) * 8192 + u.pn * BM + wc * 32 + 8 * fq) * 2; asm volatile("" : "+v"(vo));
        u32x4 ta[MID_DEPTH][2];
#define MG_LOAD(k) do { const int o_ = vo + (((k) >> 2) * HALF + ((k) & 3) * 16) * 16384; _Pragma("unroll") for (int bj = 0; bj < 2; ++bj) ta[(k) % MID_DEPTH][bj] = __builtin_amdgcn_raw_buffer_load_b128(rsG, o_ + bj * 256, 0, 0); } while (0)
#pragma unroll
        for (int k = 0; k < MID_DEPTH - 1; ++k) MG_LOAD(k);
#pragma unroll
        for (int k = 0; k < 8; ++k) { const int ai = k >> 2, m = k & 3;
            if (k + MID_DEPTH - 1 < 8) MG_LOAD(k + MID_DEPTH - 1);
#pragma unroll
            for (int bj = 0; bj < 2; ++bj) { const u32x4 a = ta[k % MID_DEPTH][bj];
                acc[ai][bj][m][0] *= (f32x4){bf_lo(a.x), bf_hi(a.x), bf_lo(a.y), bf_hi(a.y)}; acc[ai][bj][m][1] *= (f32x4){bf_lo(a.z), bf_hi(a.z), bf_lo(a.w), bf_hi(a.w)}; }
            asm volatile("" : "+v"(acc[ai][0][m][0]), "+v"(acc[ai][0][m][1]), "+v"(acc[ai][1][m][0]), "+v"(acc[ai][1][m][1]));
            __builtin_amdgcn_sched_barrier(0); }
#undef MG_LOAD
    }
    __device__ __forceinline__ void operator()(f32x4 (&acc)[2][2][4][2], const Unit& u, int wr, int wc, int fr, int fq) const {
        const int row0 = u.pm * BM + wr * 64 + fr, col0 = u.pn * BM + wc * 32 + 8 * fq;
        { const __amdgpu_buffer_rsrc_t rsG = __builtin_amdgcn_make_buffer_rsrc((void*)gates, (short)0, (int)0xffffffffu, 0x00020000);
          const int vo = (row0 * 8192 + col0) * 2;
          u32x4 tb[END_DEPTH][2];
#define MG_LOAD(k) do { const int o_ = vo + (((k) >> 2) * HALF + ((k) & 3) * 16) * 16384; _Pragma("unroll") for (int bj = 0; bj < 2; ++bj) tb[(k) % END_DEPTH][bj] = __builtin_amdgcn_raw_buffer_load_b128(rsG, o_ + bj * 256, 8192, 0); } while (0)
#pragma unroll
          for (int k = 0; k < END_DEPTH - 1; ++k) MG_LOAD(k);
#pragma unroll
          for (int k = 0; k < 8; ++k) { const int ai = k >> 2, m = k & 3;
              if (k + END_DEPTH - 1 < 8) MG_LOAD(k + END_DEPTH - 1);
#pragma unroll
              for (int bj = 0; bj < 2; ++bj) { const u32x4 b = tb[k % END_DEPTH][bj]; f32x4 g0, g1;
                  g0[0] = fmaxf(bf_lo(b.x), 1e-20f); g0[1] = fmaxf(bf_hi(b.x), 1e-20f); g0[2] = fmaxf(bf_lo(b.y), 1e-20f); g0[3] = fmaxf(bf_hi(b.y), 1e-20f);
                  g1[0] = fmaxf(bf_lo(b.z), 1e-20f); g1[1] = fmaxf(bf_hi(b.z), 1e-20f); g1[2] = fmaxf(bf_lo(b.w), 1e-20f); g1[3] = fmaxf(bf_hi(b.w), 1e-20f);
                  acc[ai][bj][m][0] *= g0; acc[ai][bj][m][1] *= g1; }
              asm volatile("" : "+v"(acc[ai][0][m][0]), "+v"(acc[ai][0][m][1]), "+v"(acc[ai][1][m][0]), "+v"(acc[ai][1][m][1]));
              __builtin_amdgcn_sched_barrier(0); }
#undef MG_LOAD
        }
#pragma unroll
        for (int ai = 0; ai < 2; ++ai)
#pragma unroll
            for (int m = 0; m < 4; ++m) { const int r = row0 + ai * HALF + m * 16;
#pragma unroll
                for (int bj = 0; bj < 2; ++bj) { const f32x4 a0 = acc[ai][bj][m][0], a1 = acc[ai][bj][m][1];
                    u32x4 w; w.x = cvt_pk_bf16(a0[0], a0[1]); w.y = cvt_pk_bf16(a0[2], a0[3]); w.z = cvt_pk_bf16(a1[0], a1[1]); w.w = cvt_pk_bf16(a1[2], a1[3]);
                    *(u32x4*)(O + (size_t)r * 4096 + col0 + bj * HALF) = w; } }
    }
};

template <class Epi, class Sched, bool ALIGN_EPI = false, bool SP2 = false>
__device__ __forceinline__ void gemm_phase(PG8_LAS unsigned char* lds, const Gemm g, const Sched& S, const Epi& E) {
    const int tid = threadIdx.x, wid = __builtin_amdgcn_readfirstlane(tid >> 6), lane = tid & 63, wr = wid >> 2, wc = wid & 3, fr = lane & 15, fq = lane >> 4;
    const int K = g.K, nt = K / BK;
    unsigned voffA[2], voffB[2];
#pragma unroll
    for (int i = 0; i < 2; ++i) { int R, C; stage_rc(tid * 16 + i * 8192, R, C); const int Rb = Epi::PERM ? ((R & ~31) + perm32(R & 31)) : R;
        const int Rj = Epi::ADJ ? 64 * (R >> 5) + perm32(R & 31) : Rb;
        voffA[i] = (unsigned)(R * K + C) * 2u; voffB[i] = (unsigned)(Rj * K + C) * 2u; }
    const unsigned kstep = (unsigned)(BK * 2);
    const unsigned hstep = (unsigned)HALF * (unsigned)K * 2u;
    const unsigned tstep = 2u * hstep;
    const unsigned hB = Epi::ADJ ? 32u * (unsigned)K * 2u : hstep;
    const __amdgpu_buffer_rsrc_t rsA = __builtin_amdgcn_make_buffer_rsrc((void*)g.A, (short)0, (int)0xffffffffu, 0x00020000);
    const __amdgpu_buffer_rsrc_t rsB = __builtin_amdgcn_make_buffer_rsrc((void*)g.Bt, (short)0, (int)0xffffffffu, 0x00020000);
    const unsigned ldsw = (unsigned)wid * 1024u;
    const int aoff = lds_byte(wr * 64 + fr, fq * 8), boff = lds_byte(wc * 32 + fr, fq * 8);
#define PG8_SA(b, h) (((b) * 2 + (h)) * HTB)
#define PG8_SB(b, h) ((4 + (b) * 2 + (h)) * HTB)
#define PG8_STAGE(bufoff, rs, soff, voff) do { _Pragma("unroll") for (int _i = 0; _i < 2; ++_i) \
        __builtin_amdgcn_raw_ptr_buffer_load_lds(rs, (PG8_LAS unsigned*)(lds + (bufoff) + ldsw + _i * 8192), 16, (int)(voff)[_i], (int)(soff), 0, 0); } while (0)
#define PG8_LDA(dst, b, h) do { _Pragma("unroll") for (int m = 0; m < 4; ++m) _Pragma("unroll") for (int k = 0; k < 2; ++k) dst[m][k] = *(const PG8_LAS bf16x8*)(lds + PG8_SA(b, h) + aoff + m * 2048 + k * 1024); } while (0)
#define PG8_LDB(dst, b, h) do { _Pragma("unroll") for (int n = 0; n < 2; ++n) _Pragma("unroll") for (int k = 0; k < 2; ++k) dst[n][k] = *(const PG8_LAS bf16x8*)(lds + PG8_SB(b, h) + boff + n * 2048 + k * 1024); } while (0)
#define PG8_MMA(ai, bj, At, Bt) do { __builtin_amdgcn_s_setprio(1); _Pragma("unroll") for (int m = 0; m < 4; ++m) _Pragma("unroll") for (int n = 0; n < 2; ++n) _Pragma("unroll") for (int k = 0; k < 2; ++k) \
        acc[ai][bj][m][n] = __builtin_amdgcn_mfma_f32_16x16x32_bf16(Bt[n][k], At[m][k], acc[ai][bj][m][n], 0, 0, 0); __builtin_amdgcn_s_setprio(0); } while (0)
#define PG8_WAIT_V(n) asm volatile("s_waitcnt vmcnt(" #n ")" ::: "memory")
#define PG8_WAIT_VN(N) asm volatile("s_waitcnt vmcnt(%0)" :: "n"(N) : "memory")
#define PG8_WAIT_L(n) asm volatile("s_waitcnt lgkmcnt(" #n ")" ::: "memory")
#define PG8_BAR __builtin_amdgcn_s_barrier()
#define PG8_SCHED __builtin_amdgcn_sched_barrier(0)
    Unit cur, nxt; int ui = 0;
    if (!S.next(0, cur)) return;
    f32x4 acc[2][2][4][2];
#pragma unroll
    for (int a = 0; a < 2; ++a)
#pragma unroll
        for (int b = 0; b < 2; ++b)
#pragma unroll
            for (int m = 0; m < 4; ++m)
#pragma unroll
                for (int n = 0; n < 2; ++n) acc[a][b][m][n] = (f32x4){0.f, 0.f, 0.f, 0.f};
    bf16x8 At[4][2], B0[2][2], B1[2][2];
    unsigned cA = __builtin_amdgcn_readfirstlane((unsigned)cur.pm * tstep), cB = __builtin_amdgcn_readfirstlane((unsigned)cur.pn * tstep);
    S.a_ready(cur);
    if constexpr (Epi::SS_LDS) ss_prefetch(E.ss, E.ssl, cur.pm, wid, lane);
    if constexpr (SP2) {
        PG8_STAGE(PG8_SB(0, 0), rsB, cB, voffB); PG8_STAGE(PG8_SB(0, 1), rsB, cB + hB, voffB); PG8_STAGE(PG8_SA(0, 0), rsA, cA, voffA); PG8_STAGE(PG8_SA(0, 1), rsA, cA + hstep, voffA);
        if (wr == 1) PG8_BAR;
        PG8_WAIT_V(2); PG8_BAR;
        PG8_STAGE(PG8_SB(1, 0), rsB, cB + kstep, voffB); PG8_STAGE(PG8_SA(1, 0), rsA, cA + kstep, voffA); PG8_STAGE(PG8_SB(1, 1), rsB, cB + hB + kstep, voffB);
        PG8_WAIT_V(0); PG8_BAR;
    } else {
        PG8_STAGE(PG8_SB(0, 0), rsB, cB, voffB); PG8_STAGE(PG8_SA(0, 0), rsA, cA, voffA); PG8_STAGE(PG8_SB(0, 1), rsB, cB + hB, voffB); PG8_STAGE(PG8_SA(0, 1), rsA, cA + hstep, voffA);
        if (wr == 1) PG8_BAR;
        PG8_WAIT_V(4); PG8_BAR;
        PG8_STAGE(PG8_SB(1, 0), rsB, cB + kstep, voffB); PG8_STAGE(PG8_SA(1, 0), rsA, cA + kstep, voffA); PG8_STAGE(PG8_SB(1, 1), rsB, cB + hB + kstep, voffB);
        PG8_WAIT_V(6); PG8_BAR;
    }
    for (;;) {
        const bool has_next = S.next(ui + 1, nxt);
        const unsigned nA = __builtin_amdgcn_readfirstlane(has_next ? (unsigned)nxt.pm * tstep : cA), nB = __builtin_amdgcn_readfirstlane(has_next ? (unsigned)nxt.pn * tstep : cB);
#define PG8_KADDR const bool last = (t == nt - 2); const unsigned a1 = cA + (unsigned)(t + 1) * kstep; \
            const unsigned a2 = last ? nA : cA + (unsigned)(t + 2) * kstep, b2 = last ? nB : cB + (unsigned)(t + 2) * kstep, a3 = a2 + kstep, b3 = b2 + kstep; \
            if (last && has_next) S.a_ready(nxt); \
            if constexpr (Epi::HAS_MID) { if (t == Epi::MID_T) E.mid(acc, cur, wr, wc, fr, fq); }
#define PG8_KPAIR_SP2(W12) do { \
            PG8_LDB(B0, 0, 0); PG8_LDB(B1, 0, 1); PG8_SCHED; PG8_LDA(At, 0, 0); PG8_STAGE(PG8_SA(1, 1), rsA, a1 + hstep, voffA); \
            PG8_WAIT_VN(W12); PG8_WAIT_L(0); PG8_BAR; PG8_MMA(0, 0, At, B0); PG8_MMA(0, 1, At, B1); PG8_BAR; PG8_SCHED; \
            PG8_LDA(At, 0, 1); PG8_STAGE(PG8_SB(0, 0), rsB, b2, voffB); PG8_STAGE(PG8_SB(0, 1), rsB, b2 + hB, voffB); PG8_STAGE(PG8_SA(0, 0), rsA, a2, voffA); \
            PG8_WAIT_VN(W12); PG8_WAIT_L(0); PG8_BAR; PG8_MMA(1, 0, At, B0); PG8_MMA(1, 1, At, B1); PG8_BAR; PG8_SCHED; \
            PG8_LDB(B0, 1, 0); PG8_LDB(B1, 1, 1); PG8_SCHED; PG8_LDA(At, 1, 0); PG8_STAGE(PG8_SA(0, 1), rsA, a2 + hstep, voffA); \
            PG8_WAIT_V(8); PG8_WAIT_L(0); PG8_BAR; PG8_MMA(0, 0, At, B0); PG8_MMA(0, 1, At, B1); PG8_BAR; PG8_SCHED; \
            PG8_LDA(At, 1, 1); PG8_STAGE(PG8_SB(1, 0), rsB, b3, voffB); PG8_STAGE(PG8_SB(1, 1), rsB, b3 + hB, voffB); PG8_STAGE(PG8_SA(1, 0), rsA, a3, voffA); \
            PG8_WAIT_V(8); PG8_WAIT_L(0); PG8_BAR; PG8_MMA(1, 0, At, B0); PG8_MMA(1, 1, At, B1); PG8_BAR; PG8_SCHED; } while (0)
        if constexpr (SP2) {
            { const int t = 0; PG8_KADDR; PG8_KPAIR_SP2(8 + Epi::VM_TAIL); }
            for (int t = 2; t < nt; t += 2) { PG8_KADDR; PG8_KPAIR_SP2(8); }
        } else {
        for (int t = 0; t < nt; t += 2) {
            PG8_KADDR;
            PG8_LDB(B0, 0, 0); PG8_SCHED; PG8_LDA(At, 0, 0); PG8_STAGE(PG8_SA(1, 1), rsA, a1 + hstep, voffA);
            PG8_WAIT_L(8); PG8_BAR; PG8_WAIT_L(0); PG8_MMA(0, 0, At, B0); PG8_BAR; PG8_SCHED;
            PG8_LDB(B1, 0, 1); PG8_STAGE(PG8_SB(0, 0), rsB, b2, voffB);
            PG8_BAR; PG8_WAIT_L(0); PG8_MMA(0, 1, At, B1); PG8_BAR;
            PG8_LDA(At, 0, 1); PG8_STAGE(PG8_SA(0, 0), rsA, a2, voffA);
            PG8_BAR; PG8_WAIT_L(0); PG8_MMA(1, 0, At, B0); PG8_BAR; PG8_SCHED;
            PG8_STAGE(PG8_SB(0, 1), rsB, b2 + hB, voffB);
            PG8_WAIT_V(6); PG8_BAR; PG8_MMA(1, 1, At, B1); PG8_BAR;
            PG8_LDB(B0, 1, 0); PG8_SCHED; PG8_LDA(At, 1, 0); PG8_STAGE(PG8_SA(0, 1), rsA, a2 + hstep, voffA);
            PG8_WAIT_L(8); PG8_BAR; PG8_WAIT_L(0); PG8_MMA(0, 0, At, B0); PG8_BAR; PG8_SCHED;
            PG8_LDB(B1, 1, 1); PG8_STAGE(PG8_SB(1, 0), rsB, b3, voffB);
            PG8_BAR; PG8_WAIT_L(0); PG8_MMA(0, 1, At, B1); PG8_BAR;
            PG8_LDA(At, 1, 1); PG8_STAGE(PG8_SA(1, 0), rsA, a3, voffA);
            PG8_BAR; PG8_WAIT_L(0); PG8_MMA(1, 0, At, B0); PG8_BAR; PG8_SCHED;
            PG8_STAGE(PG8_SB(1, 1), rsB, b3 + hB, voffB);
            PG8_WAIT_V(6); PG8_BAR; PG8_MMA(1, 1, At, B1); PG8_BAR;
        }
        }
        if constexpr (ALIGN_EPI) { if (wr == 0) PG8_BAR; }
        if constexpr (!Epi::AFTER_DRAIN) { E(acc, cur, wr, wc, fr, fq); S.done(cur); }
        if (!has_next) break;
#pragma unroll
        for (int a = 0; a < 2; ++a)
#pragma unroll
            for (int b = 0; b < 2; ++b)
#pragma unroll
                for (int m = 0; m < 4; ++m)
#pragma unroll
                    for (int n = 0; n < 2; ++n) acc[a][b][m][n] = (f32x4){0.f, 0.f, 0.f, 0.f};
        cur = nxt; cA = nA; cB = nB; ++ui;
        if constexpr (Epi::SS_LDS) ss_prefetch(E.ss, E.ssl, cur.pm, wid, lane);
        if constexpr (ALIGN_EPI) { if (wr == 1) PG8_BAR; }
    }
    PG8_WAIT_V(0);
    if constexpr (!ALIGN_EPI) { if (wr == 0) PG8_BAR; }
    PG8_BAR;
#undef PG8_SA
#undef PG8_SB
#undef PG8_STAGE
#undef PG8_LDA
#undef PG8_LDB
#undef PG8_MMA
#undef PG8_WAIT_V
#undef PG8_WAIT_L
#undef PG8_WAIT_VN
#undef PG8_KADDR
#undef PG8_KPAIR_SP2
#undef PG8_BAR
#undef PG8_SCHED
}
}

#ifndef PG8_SP2
#define PG8_SP2 true
#endif
#ifndef PG8_ALIGN
#define PG8_ALIGN true
#endif

constexpr int NWAVES = 8;
constexpr int N_LAUNCHES = MK_N_LAUNCHES;
constexpr int PER_PHASE = 10;
constexpr int D = 4096, FF = 11008, NIN = 20480, QKVW = 12288, GATEW = 8192, YABW = 3072;
constexpr int M_P = 8192, M_S = 16384, M = M_P + M_S;
constexpr float QSCALE = 0.08838834764831845f * 1.4426950408889634f;

constexpr size_t MiB = 1u << 20;
constexpr size_t WS_CTL = 0, CTL_ZERO_BYTES = 1 * MiB;
constexpr size_t WS_SS0 = 1 * MiB;
constexpr size_t WS_ROPE = 2 * MiB;
constexpr size_t WS_WIN = 4 * MiB;
constexpr size_t WS_WAB = WS_WIN + (size_t)NIN * D * 2;
constexpr size_t WS_WOUT = WS_WAB + (size_t)D * YABW * 2;
constexpr size_t WS_WGU = WS_WOUT + (size_t)D * D * 2;
constexpr size_t WS_WD = WS_WGU + (size_t)2 * FF * D * 2;
constexpr size_t WS_AB1 = WS_WD + (size_t)D * FF * 2;
constexpr size_t WS_ACT = WS_AB1 + (size_t)M * D * 2;
constexpr size_t WS_QKV = WS_ACT + (size_t)M * FF * 2;
constexpr size_t WS_END = WS_QKV + (size_t)M * QKVW * 2;
constexpr int CW_BAR = 4096;
constexpr int CW_SS1 = 16384, CW_SS2 = CW_SS1 + M, CW_SS3 = CW_SS2 + M;
static_assert((size_t)(CW_SS3 + M) * 4 <= CTL_ZERO_BYTES, "CTL words inside the memset region");
static_assert(WS_SS0 + (size_t)M * 4 <= WS_ROPE && WS_ROPE + (size_t)16384 * 32 * 4 <= WS_WIN, "ws map");

constexpr int RING_OFF = 0, RING_BYTES = 131072;
constexpr int LDSCTL_OFF = RING_BYTES, MISC_OFF = LDSCTL_OFF + 320;
constexpr int SSL_OFF = MISC_OFF + 1024;
constexpr int LDS_BYTES = 147456;

#define GAS __attribute__((address_space(1)))
#define LAS __attribute__((address_space(3)))
typedef unsigned short bf16;
typedef unsigned v4u __attribute__((ext_vector_type(4)));
typedef unsigned v2u __attribute__((ext_vector_type(2)));
typedef float f32x4 __attribute__((ext_vector_type(4)));
typedef short bf16x8 __attribute__((ext_vector_type(8)));
typedef short s16x4 __attribute__((ext_vector_type(4)));
typedef GAS unsigned gu32;
#define RLX_AGENT __ATOMIC_RELAXED, __HIP_MEMORY_SCOPE_AGENT
#define LDS_WAIT() asm volatile("s_waitcnt lgkmcnt(0)" ::: "memory")
#define VM_WAIT() asm volatile("s_waitcnt vmcnt(0)" ::: "memory")
__device__ __forceinline__ unsigned pk2(float lo, float hi) { return pg8::cvt_pk_bf16(lo, hi); }

#define XB_TMO      128
#define XB_XCNT(j)  (256  + 64 * (j))
#define XB_XSUB(j)  (1280 + 64 * (j))
#define XB_XGEN(j)  (2304 + 64 * (j))
#define XB_TOP      3328
#define XB_TOPGEN   3392
#define XCD_BAR_WORDS 3456
#define XB_SPIN_CAP (1u << 18)

__device__ __forceinline__ unsigned xb_ld(unsigned* p)              { return __hip_atomic_load(p, __ATOMIC_RELAXED, __HIP_MEMORY_SCOPE_AGENT); }
__device__ __forceinline__ unsigned xb_add(unsigned* p, unsigned v) { return __hip_atomic_fetch_add(p, v, __ATOMIC_RELAXED, __HIP_MEMORY_SCOPE_AGENT); }
__device__ __forceinline__ unsigned xb_xcc_id() { return (unsigned)__builtin_amdgcn_s_getreg((3 << 11) | 20) & 0xFu; }
#define XB_SPIN(cond, bar) do { unsigned _sp = 0; while (cond) { __builtin_amdgcn_s_sleep(1); \
    if ((++_sp & 255u) == 0u) { if (xb_ld(&(bar)[XB_TMO])) break; if (_sp > XB_SPIN_CAP) { atomicAdd(&(bar)[XB_TMO], 1u); break; } } } } while (0)

struct XcdBarrier {
    unsigned* bar; unsigned x;
    volatile LAS unsigned* st;
};
__device__ __forceinline__ XcdBarrier xcd_barrier_post(unsigned* bar, volatile LAS unsigned* st) {
    XcdBarrier b; b.bar = bar; b.x = xb_xcc_id(); b.st = st;
    if (threadIdx.x == 0) (void)xb_add(&bar[XB_XCNT(b.x)], 1u);
    return b;
}
__device__ __forceinline__ void xcd_barrier_complete(unsigned* bar, unsigned x, unsigned& nloc, unsigned& nx) {
    const unsigned G = gridDim.x * gridDim.y * gridDim.z;
    unsigned sum, cnt, mine, sp = 0u;
    for (;;) {
        sum = 0u; cnt = 0u; mine = 0u;
#pragma unroll
        for (unsigned j = 0; j < 16; ++j) { const unsigned c = xb_ld(&bar[XB_XCNT(j)]); sum += c; cnt += (c > 0u) ? 1u : 0u; mine = (j == x) ? c : mine; }
        if (sum == G) break;
        __builtin_amdgcn_s_sleep(1);
        if ((++sp & 255u) == 0u) { if (xb_ld(&bar[XB_TMO])) break; if (sp > XB_SPIN_CAP) { atomicAdd(&bar[XB_TMO], 1u); break; } }
    }
    nloc = mine > 0u ? mine : 1u; nx = cnt > 0u ? cnt : 1u;
}
__device__ __forceinline__ void xcd_barrier(const XcdBarrier& b) {
    asm volatile("s_waitcnt vmcnt(0)" ::: "memory");
    __syncthreads();
    if (threadIdx.x == 0) {
        unsigned* bar = b.bar;
        __builtin_amdgcn_s_waitcnt(0);
        unsigned nloc = b.st[0], nx = b.st[1];
        if (nloc == 0u) { xcd_barrier_complete(bar, b.x, nloc, nx); b.st[0] = nloc; b.st[1] = nx; }
        const unsigned old = xb_add(&bar[XB_XSUB(b.x)], 1u);
        const unsigned gen = old / nloc;
        if (old + 1u == (gen + 1u) * nloc) {
            __builtin_amdgcn_fence(__ATOMIC_RELEASE, "agent");
            asm volatile("s_waitcnt vmcnt(0)" ::: "memory");
            const unsigned og = xb_add(&bar[XB_TOP], 1u);
            const unsigned tg = og / nx;
            if (og + 1u == (tg + 1u) * nx) xb_add(&bar[XB_TOPGEN], 1u);
            else XB_SPIN(xb_ld(&bar[XB_TOPGEN]) == tg, bar);
            __builtin_amdgcn_fence(__ATOMIC_ACQUIRE, "agent");
            xb_add(&bar[XB_XGEN(b.x)], 1u);
            asm volatile("s_waitcnt vmcnt(0)" ::: "memory");
        } else {
            XB_SPIN(xb_ld(&bar[XB_XGEN(b.x)]) == gen, bar);
            __builtin_amdgcn_fence(__ATOMIC_ACQUIRE, "agent");
            asm volatile("s_waitcnt vmcnt(0)" ::: "memory");
        }
    }
    __syncthreads();
}

__device__ __forceinline__ void xcd_stagger(unsigned ticks) {
    const unsigned long long dt = (unsigned long long)(xb_xcc_id() & 7u) * ticks, t0 = __builtin_amdgcn_s_memrealtime();
    while (__builtin_amdgcn_s_memrealtime() - t0 < dt) __builtin_amdgcn_s_sleep(8);
}

struct Frame {
    LAS unsigned char* lds;
    volatile LAS unsigned* MISC;
    gu32* ctl;
    int tid, lane, wave;
    int vcu, G;
};

__device__ __forceinline__ float wave_sum(float v) {
#pragma unroll
    for (int o = 1; o < 64; o <<= 1) v += __shfl_xor(v, o);
    return v;
}

struct CvtJob { const float* W; const float* gain; bf16* WT; int N, ldT, drow, kcol0, k0, n0, split; float cs; };
__device__ __forceinline__ void cvt_job(CvtJob& J, const float* W, int N, const float* gain, bf16* WT, int ldT, int koff, int mode, int item) {
    const int nblk = N / 64, kb = item / nblk, nb = item % nblk, k0 = 64 * kb, n0 = 64 * nb;
    J.W = W; J.gain = gain; J.WT = WT; J.N = N; J.ldT = ldT; J.k0 = k0; J.n0 = n0; J.kcol0 = koff + k0;
    J.cs = (mode == 3 && (n0 < 3072 || (n0 >= 9216 && n0 < 11264))) ? QSCALE : 1.0f;
    J.drow = (mode == 1 || mode == 2) ? 256 * (n0 >> 7) + (n0 & 127) + (mode == 2 ? 128 : 0) : n0;
    J.split = 0;
    if (mode == 3 && n0 >= 12288) { const int c = n0 - 12288, c2 = c & 4095;
        J.drow = 12288 + 2 * c2 + (c >= 4096 ? 32 : 0); J.split = 1; }
}
__device__ __forceinline__ void cvt_load(const CvtJob& J, int lane, f32x4 (&v)[16]) {
    const float* p = J.W + (size_t)(J.k0 + 16 * (lane >> 4)) * J.N + J.n0 + 4 * (lane & 15);
#pragma unroll
    for (int i = 0; i < 16; ++i) v[i] = __builtin_nontemporal_load((const f32x4*)(p + (size_t)i * J.N));
}
__device__ __forceinline__ void cvt_store(const CvtJob& J, const f32x4 (&v)[16], LAS unsigned char* img, int lane) {
    const int g = lane >> 4, i15 = lane & 15;
    f32x4 gq[4];
#pragma unroll
    for (int j = 0; j < 4; ++j) gq[j] = J.gain ? *(const f32x4*)(J.gain + J.k0 + 16 * g + 4 * j) * J.cs : (f32x4){J.cs, J.cs, J.cs, J.cs};
#pragma unroll
    for (int e = 0; e < 4; ++e) { v4u lo, hi;
        lo.x = pk2(v[0][e] * gq[0][0], v[1][e] * gq[0][1]);   lo.y = pk2(v[2][e] * gq[0][2], v[3][e] * gq[0][3]);   lo.z = pk2(v[4][e] * gq[1][0], v[5][e] * gq[1][1]);   lo.w = pk2(v[6][e] * gq[1][2], v[7][e] * gq[1][3]);
        hi.x = pk2(v[8][e] * gq[2][0], v[9][e] * gq[2][1]);   hi.y = pk2(v[10][e] * gq[2][2], v[11][e] * gq[2][3]); hi.z = pk2(v[12][e] * gq[3][0], v[13][e] * gq[3][1]); hi.w = pk2(v[14][e] * gq[3][2], v[15][e] * gq[3][3]);
        LAS unsigned char* wp = img + (4 * i15 + e) * 144 + 32 * g;
        *(LAS v4u*)wp = lo; *(LAS v4u*)(wp + 16) = hi; }
    const int r = lane >> 3, c = lane & 7;
    bf16* op = J.WT + (size_t)(J.drow + r) * J.ldT + J.kcol0 + 8 * c;
#pragma unroll
    for (int j = 0; j < 8; ++j) {
        const v4u o = *(const LAS v4u*)(img + (8 * j + r) * 144 + 16 * c);
        *(v4u*)(op + (size_t)(8 * j + (J.split ? 32 * (j >> 2) : 0)) * J.ldT) = o;
    }
}
struct Ptrs;
template <int SET> __device__ __forceinline__ void cvt_decode(const Ptrs& P, int it, CvtJob& J);

__device__ __forceinline__ void sincos_acc(float a, float& s, float& c) {
    const double x = (double)a;
    const double kq = __builtin_rint(x * 0.63661977236758134308);
    double r = __builtin_fma(-kq, 1.57079632679489655800e+00, x);
    r = __builtin_fma(-kq, 6.12323399573676603587e-17, r);
    const int q = (int)((long long)kq) & 3;
    const double r2 = r * r;
    const double sp = r * (1.0 + r2 * (-1.0 / 6.0 + r2 * (1.0 / 120.0 + r2 * (-1.0 / 5040.0 + r2 * (1.0 / 362880.0 + r2 * (-1.0 / 39916800.0 + r2 * (1.0 / 6227020800.0)))))));
    const double cp = 1.0 + r2 * (-0.5 + r2 * (1.0 / 24.0 + r2 * (-1.0 / 720.0 + r2 * (1.0 / 40320.0 + r2 * (-1.0 / 3628800.0 + r2 * (1.0 / 479001600.0))))));
    const double ss = (q & 1) ? cp : sp, cc = (q & 1) ? sp : cp;
    s = (float)((q & 2) ? -ss : ss);
    c = (float)(((q + 1) & 2) ? -cc : cc);
}

struct Ptrs {
    const float* xp; const float* xs; const float* g1; const float* w1g; const float* w1u; const float* w1d; const float* gmix; const float* win; const float* sink;
    const float* wa; const float* wb; const float* wout; const float* g2; const float* w2g; const float* w2u; const float* w2d; const float* gfin;
    float* out; unsigned char* ws;
};

constexpr int CI_GU = (D / 64) * (FF / 64), CI_D = (FF / 64) * (D / 64), CI_IN = (D / 64) * (NIN / 64), CI_A = (1024 / 64) * (D / 64), CI_B = (2048 / 64) * (D / 64), CI_O = (D / 64) * (D / 64);
constexpr int CI_IN0 = CI_IN / 2;
template <> __device__ __forceinline__ void cvt_decode<0>(const Ptrs& P, int it, CvtJob& J) {
    bf16* WGU = (bf16*)(P.ws + WS_WGU); bf16* WD = (bf16*)(P.ws + WS_WD); bf16* WIN = (bf16*)(P.ws + WS_WIN);
    int r = it;
    if (r < CI_GU) { cvt_job(J, P.w1g, FF, P.g1, WGU, D, 0, 1, r); return; } r -= CI_GU;
    if (r < CI_GU) { cvt_job(J, P.w1u, FF, P.g1, WGU, D, 0, 2, r); return; } r -= CI_GU;
    if (r < CI_D)  { cvt_job(J, P.w1d, D, nullptr, WD, FF, 0, 0, r); return; } r -= CI_D;
    cvt_job(J, P.win, NIN, P.gmix, WIN, D, 0, 3, r);
}
template <> __device__ __forceinline__ void cvt_decode<2>(const Ptrs& P, int it, CvtJob& J) {
    bf16* WIN = (bf16*)(P.ws + WS_WIN); bf16* WAB = (bf16*)(P.ws + WS_WAB); bf16* WOUT = (bf16*)(P.ws + WS_WOUT);
    int r = it;
    if (r < CI_IN - CI_IN0) { cvt_job(J, P.win, NIN, P.gmix, WIN, D, 0, 3, r + CI_IN0); return; } r -= CI_IN - CI_IN0;
    if (r < CI_A)  { cvt_job(J, P.wa, D, nullptr, WAB, YABW, 0, 0, r); return; } r -= CI_A;
    if (r < CI_B)  { cvt_job(J, P.wb, D, nullptr, WAB, YABW, 1024, 0, r); return; } r -= CI_B;
    cvt_job(J, P.wout, D, nullptr, WOUT, D, 0, 0, r);
}
template <> __device__ __forceinline__ void cvt_decode<1>(const Ptrs& P, int it, CvtJob& J) {
    bf16* WGU = (bf16*)(P.ws + WS_WGU); bf16* WD = (bf16*)(P.ws + WS_WD);
    int r = it;
    if (r < CI_GU) { cvt_job(J, P.w2g, FF, P.g2, WGU, D, 0, 1, r); return; } r -= CI_GU;
    cvt_job(J, P.w2u, FF, P.g2, WGU, D, 0, 2, r);
}
template <> __device__ __forceinline__ void cvt_decode<3>(const Ptrs& P, int it, CvtJob& J) { cvt_job(J, P.w2d, D, nullptr, (bf16*)(P.ws + WS_WD), FF, 0, 0, it); }
template <int SET> __device__ __forceinline__ void cvt_run(Frame& F, const Ptrs& P, int gw, int NGW) {
    constexpr int NITEMS = SET == 0 ? 2 * CI_GU + CI_D + CI_IN0 : (SET == 1 ? 2 * CI_GU : (SET == 3 ? CI_D : (CI_IN - CI_IN0) + CI_A + CI_B + CI_O));
    LAS unsigned char* img = F.lds + RING_OFF + F.wave * 16384;
    const int lane = F.lane;
    f32x4 va[16], vb[16]; CvtJob Ja, Jb;
    int it = gw;
    if (it >= NITEMS) return;
    cvt_decode<SET>(P, it, Ja); cvt_load(Ja, lane, va);
    for (;;) {
        int nx = it + NGW;
        cvt_decode<SET>(P, nx < NITEMS ? nx : NITEMS - 1, Jb); cvt_load(Jb, lane, vb);
        cvt_store(Ja, va, img, lane);
        it = nx; if (it >= NITEMS) break;
        nx = it + NGW;
        cvt_decode<SET>(P, nx < NITEMS ? nx : NITEMS - 1, Ja); cvt_load(Ja, lane, va);
        cvt_store(Jb, vb, img, lane);
        it = nx; if (it >= NITEMS) break;
    }
}
__device__ __forceinline__ void p0_prologue(Frame& F, const Ptrs& P) {
    const int gw = F.vcu * NWAVES + F.wave, NGW = F.G * NWAVES;
    { float* tab = (float*)(P.ws + WS_ROPE);
      const float inv[16] = {1.000000000e+00f, 4.403665960e-01f, 1.939227432e-01f, 8.539710194e-02f, 3.760603070e-02f, 1.656044088e-02f, 7.292664610e-03f, 3.211446106e-03f,
                             1.414213562e-03f, 6.227724371e-04f, 2.742481884e-04f, 1.207697351e-04f, 5.318295734e-05f, 2.341999971e-05f, 1.031338525e-05f, 4.541670478e-06f};
      for (int pos = gw * 64 + F.lane; pos < 16384; pos += NGW * 64) {
#pragma unroll
          for (int i = 0; i < 16; ++i) { const float ang = (float)pos * inv[i]; float s, c; sincos_acc(ang, s, c); tab[(size_t)pos * 32 + i] = c; tab[(size_t)pos * 32 + 16 + i] = s; } } }
    { bf16* XB = (bf16*)(P.ws + WS_AB1); float* ss0 = (float*)(P.ws + WS_SS0);
      for (int m = gw; m < M; m += NGW) { const float* xrow = (m < M_P) ? P.xp + (size_t)m * D : P.xs + (size_t)(m - M_P) * D;
          const GAS f32x4* xr = (const GAS f32x4*)xrow + F.lane; GAS v2u* o8 = (GAS v2u*)(XB + (size_t)m * D) + F.lane; float s = 0.f;
#pragma unroll
          for (int j = 0; j < 16; j += 2) { const f32x4 va = __builtin_nontemporal_load(xr + 64 * j), vb = __builtin_nontemporal_load(xr + 64 * (j + 1));
              s += ((va.x * va.x + va.y * va.y) + (va.z * va.z + va.w * va.w)) + ((vb.x * vb.x + vb.y * vb.y) + (vb.z * vb.z + vb.w * vb.w));
              v2u wa, wb; wa.x = pk2(va.x, va.y); wa.y = pk2(va.z, va.w); wb.x = pk2(vb.x, vb.y); wb.y = pk2(vb.z, vb.w);
              const bool ev = (F.lane & 1) == 0; const unsigned sx = ev ? wb.x : wa.x, sy = ev ? wb.y : wa.y;
              const unsigned rx = (unsigned)__builtin_amdgcn_mov_dpp((int)sx, 0xB1, 0xf, 0xf, true), ry = (unsigned)__builtin_amdgcn_mov_dpp((int)sy, 0xB1, 0xf, 0xf, true);
              v4u o; o.x = ev ? wa.x : rx; o.y = ev ? wa.y : ry; o.z = ev ? rx : wb.x; o.w = ev ? ry : wb.y;
              *(GAS v4u*)((GAS v2u*)(XB + (size_t)m * D) + 64 * (j + (ev ? 0 : 1)) + (F.lane & ~1)) = o; }
          s = wave_sum(s); if (F.lane == 0) ss0[m] = s; } }
    cvt_run<0>(F, P, gw, NGW);
}
__device__ __forceinline__ void p4_convert_w2(Frame& F, const Ptrs& P) { cvt_run<1>(F, P, F.vcu * NWAVES + F.wave, F.G * NWAVES); }

__device__ __forceinline__ unsigned off_b(unsigned row, unsigned ch) { return 256u * row + 16u * (ch ^ (((row & 3) << 2) | ((row >> 2) & 3))); }
struct AttState2 { float m[2], l[2]; f32x4 O[2][8]; };

struct AttLane { unsigned choff[4]; };
__device__ __forceinline__ void att_lane_init(AttLane& L, int lane) {
    const unsigned i = lane & 15, g = lane >> 4;
#pragma unroll
    for (int j = 0; j < 4; ++j) L.choff[j] = 16u * (i ^ ((g << 2) | (unsigned)j));
}
__device__ __forceinline__ void k_load(bf16x8 (&kf)[2][4], const bf16* Kb, int S, int tb, int dil, int lane) {
    const int i = lane & 15, g = lane >> 4;
    const int kk_a = 8 * (i >> 2) + (i & 3);
#pragma unroll
    for (int t = 0; t < 2; ++t) { int tk = tb + dil * (kk_a + 4 * t); tk = max(0, min(tk, S - 1)); const bf16* kp = Kb + (size_t)tk * QKVW + 8 * g;
#pragma unroll
        for (int s = 0; s < 4; ++s) kf[t][s] = *(const bf16x8*)(kp + 32 * s); }
}
__device__ __forceinline__ void v_dma(LAS unsigned char* vbuf, const bf16* Vb, int S, int tb, int dil, int lane, const AttLane& L) {
    const int g = lane >> 4;
    if (tb >= 0 && tb + 31 * dil < S) {
        const char* p0 = (const char*)(Vb + (size_t)(tb + dil * g) * QKVW); const size_t rstep = (size_t)(4 * dil) * QKVW * 2;
#pragma unroll
        for (int c = 0; c < 8; ++c) __builtin_amdgcn_global_load_lds((const unsigned*)(p0 + c * rstep + L.choff[c & 3]), (LAS unsigned*)(vbuf + 1024 * c), 16, 0, 0);
    } else {
#pragma unroll
        for (int c = 0; c < 8; ++c) { int tk = tb + dil * (4 * c + g); tk = max(0, min(tk, S - 1));
            __builtin_amdgcn_global_load_lds((const unsigned*)((const char*)(Vb + (size_t)tk * QKVW) + L.choff[c & 3]), (LAS unsigned*)(vbuf + 1024 * c), 16, 0, 0); }
    }
    asm volatile("" ::: "memory");
}
template <int BUF>
__device__ __forceinline__ void kv_compute2(AttState2& st, bf16x8 (&kf)[2][4], const bf16x8 (&qf)[2][4], int S, int tb, int dil, const int (&mlo)[2], const unsigned (&mspan)[2],
                                            LAS unsigned char* vl, int lane, const AttLane& L, bool pf, const bf16* Kb, const bf16* Vb, int tbn) {
    const int g = lane >> 4;
    f32x4 sc[2][2];
#pragma unroll
    for (int q = 0; q < 2; ++q)
#pragma unroll
        for (int t = 0; t < 2; ++t) { sc[q][t] = (f32x4){0.f, 0.f, 0.f, 0.f};
#pragma unroll
            for (int s = 0; s < 4; ++s) sc[q][t] = __builtin_amdgcn_mfma_f32_16x16x32_bf16(kf[t][s], qf[q][s], sc[q][t], 0, 0, 0); }
    if (pf) v_dma(vl + (BUF ? 0 : 8192), Vb, S, tbn, dil, lane, L);
    bf16x8 pf16[2];
#pragma unroll
    for (int q = 0; q < 2; ++q) {
        const int x0 = tb + dil * 8 * g - mlo[q];
        float mx = -__builtin_inff();
#pragma unroll
        for (int t = 0; t < 2; ++t)
#pragma unroll
            for (int r = 0; r < 4; ++r) { const bool ok = (unsigned)(x0 + dil * (4 * t + r)) <= mspan[q]; sc[q][t][r] = ok ? sc[q][t][r] : -__builtin_inff(); mx = fmaxf(mx, sc[q][t][r]); }
        mx = pg8::xmax_16_32(mx);
        if (__builtin_amdgcn_ballot_w64(mx > st.m[q] + 8.0f) != 0ull) {
            const float mn = fmaxf(st.m[q], mx), alpha = __builtin_amdgcn_exp2f(st.m[q] - mn);
            st.l[q] *= alpha; st.m[q] = mn;
#pragma unroll
            for (int dt = 0; dt < 8; ++dt) st.O[q][dt] *= alpha;
        }
        float ps = 0.f; float p[8];
#pragma unroll
        for (int t = 0; t < 2; ++t)
#pragma unroll
            for (int r = 0; r < 4; ++r) { p[4 * t + r] = __builtin_amdgcn_exp2f(sc[q][t][r] - st.m[q]); ps += p[4 * t + r]; }
        st.l[q] += ps;
        v4u pw; pw.x = pk2(p[0], p[1]); pw.y = pk2(p[2], p[3]); pw.z = pk2(p[4], p[5]); pw.w = pk2(p[6], p[7]);
        pf16[q] = __builtin_bit_cast(bf16x8, pw);
    }
    if (pf) asm volatile("s_waitcnt vmcnt(8)" ::: "memory"); else asm volatile("s_waitcnt vmcnt(0)" ::: "memory");
    const unsigned vb = (unsigned)(uintptr_t)vl;
#define TR4(k) asm volatile("ds_read_b64_tr_b16 %0, %4 offset:%8\n\tds_read_b64_tr_b16 %1, %5 offset:%8\n\tds_read_b64_tr_b16 %2, %6 offset:%8\n\tds_read_b64_tr_b16 %3, %7 offset:%8" \
        : "=&v"(f[k]), "=&v"(f[k + 1]), "=&v"(f[k + 2]), "=&v"(f[k + 3]) : "v"(a[k]), "v"(a[k + 1]), "v"(a[k + 2]), "v"(a[k + 3]), "i"(BUF ? 8192 : 0) : "memory")
#pragma unroll
    for (int hf = 0; hf < 2; ++hf) {
        unsigned a[8]; s16x4 f[8];
        int ln = lane; asm volatile("" : "+v"(ln));
        const unsigned g2 = ln >> 4, q2 = (ln & 15) >> 2, pp = ln & 3;
#pragma unroll
        for (int k = 0; k < 4; ++k) { const int dt = 4 * hf + k; a[2 * k] = vb + off_b(8 * g2 + q2, 2 * dt + (pp >> 1)) + 8 * (pp & 1); a[2 * k + 1] = vb + off_b(8 * g2 + 4 + q2, 2 * dt + (pp >> 1)) + 8 * (pp & 1); }
        TR4(0); TR4(4);
        asm volatile("s_waitcnt lgkmcnt(0)" : "+v"(f[0]), "+v"(f[1]), "+v"(f[2]), "+v"(f[3]), "+v"(f[4]), "+v"(f[5]), "+v"(f[6]), "+v"(f[7]) :: "memory");
#pragma unroll
        for (int k = 0; k < 4; ++k) { const int dt = 4 * hf + k;
            const bf16x8 vf = __builtin_shufflevector(f[2 * k], f[2 * k + 1], 0, 1, 2, 3, 4, 5, 6, 7);
            st.O[0][dt] = __builtin_amdgcn_mfma_f32_16x16x32_bf16(vf, pf16[0], st.O[0][dt], 0, 0, 0);
            st.O[1][dt] = __builtin_amdgcn_mfma_f32_16x16x32_bf16(vf, pf16[1], st.O[1][dt], 0, 0, 0); }
    }
#undef TR4
    if (pf) { asm volatile("" ::: "memory"); k_load(kf, Kb, S, tbn, dil, lane); }
}
__device__ __forceinline__ void attn_keys2(AttState2& st, const bf16x8 (&qf)[2][4], const bf16* Kb, const bf16* Vb, int S, const int (&tq)[2], int kstart, int dil, int ntiles, int W,
                                           LAS unsigned char* vl, int lane, const AttLane& L) {
    bf16x8 kf[2][4]; const int tstep = 32 * dil;
    int mlo[2]; unsigned mspan[2];
#pragma unroll
    for (int q = 0; q < 2; ++q) { mlo[q] = max(tq[q] - W, 0); mspan[q] = (unsigned)(min(tq[q] + W, S - 1) - mlo[q]); }
    v_dma(vl, Vb, S, kstart, dil, lane, L); k_load(kf, Kb, S, kstart, dil, lane);
    for (int tile = 0; tile < ntiles; tile += 2) {
        const int tb = kstart + tile * tstep;
        const bool m1 = tile + 1 < ntiles;
        kv_compute2<0>(st, kf, qf, S, tb, dil, mlo, mspan, vl, lane, L, m1, Kb, Vb, tb + tstep);
        if (!m1) break;
        const bool m2 = tile + 2 < ntiles;
        kv_compute2<1>(st, kf, qf, S, tb + tstep, dil, mlo, mspan, vl, lane, L, m2, Kb, Vb, tb + 2 * tstep);
    }
}

template <int HALFW> __device__ __forceinline__ void attn_phase(Frame& F, const Ptrs& P) {
    if (HALFW && F.wave >= 4) return;
    const bf16* QKV = (const bf16*)(P.ws + WS_QKV); bf16* YAB = (bf16*)P.out;
    LAS unsigned char* vl = F.lds + RING_OFF + F.wave * 16384;
    const int gw = HALFW ? F.vcu * 4 + F.wave : F.vcu * NWAVES + F.wave, NGW = HALFW ? F.G * 4 : F.G * NWAVES, lane = F.lane, i = lane & 15, g = lane >> 4;
    AttLane AL; att_lane_init(AL, lane);
    { constexpr int NT = (M / 512) * 8 * 16;
      for (int id = gw; id < NT; id += NGW) {
          const int r16 = id & 15, h = (id >> 4) & 7, rb = id >> 7;
          const int row_blk = rb * 512; const int seq0 = row_blk < 4096 ? 0 : (row_blk < 8192 ? 4096 : 8192); const int S = row_blk < 8192 ? 4096 : 16384;
          const int t0 = row_blk - seq0 + r16; const int tq[2] = {t0 + 16 * i, t0 + 256 + 16 * i};
          AttState2 st;
#pragma unroll
          for (int q = 0; q < 2; ++q) { st.m[q] = -1e30f; st.l[q] = 0.f;
#pragma unroll
              for (int dt = 0; dt < 8; ++dt) st.O[q][dt] = (f32x4){0.f, 0.f, 0.f, 0.f}; }
          const bf16* seqbase = QKV + (size_t)seq0 * QKVW;
#pragma unroll 1
          for (int grp = 0; grp < 3; ++grp) {
              const int dil = grp == 0 ? 1 : (grp == 1 ? 4 : 16); const int ntiles = grp == 0 ? 20 : (grp == 1 ? 8 : 5);
              const int hc = grp * 1024 + h * 128;
              bf16x8 qf[2][4];
#pragma unroll
              for (int q = 0; q < 2; ++q) { const bf16* qp = seqbase + (size_t)tq[q] * QKVW + hc + 8 * g;
#pragma unroll
                  for (int s = 0; s < 4; ++s) qf[q][s] = *(const bf16x8*)(qp + 32 * s); }
              attn_keys2(st, qf, seqbase + 3072 + hc, seqbase + 6144 + hc, S, tq, t0 - 64 * dil, dil, ntiles, 64 * dil, vl, lane, AL);
          }
#pragma unroll
          for (int q = 0; q < 2; ++q) { float l = st.l[q]; l = pg8::xsum_16_32(l); const float rl = 1.0f / l;
              bf16* op = YAB + (size_t)(seq0 + tq[q]) * YABW + h * 128 + 8 * (g >> 1) + 16 * (g & 1);
#pragma unroll
              for (int k = 0; k < 4; ++k) { const f32x4 oa = st.O[q][2 * k] * rl, ob = st.O[q][2 * k + 1] * rl;
                  const auto sx = __builtin_amdgcn_permlane16_swap(pk2(oa[0], oa[1]), pk2(ob[0], ob[1]), false, false), sy = __builtin_amdgcn_permlane16_swap(pk2(oa[2], oa[3]), pk2(ob[2], ob[3]), false, false);
                  v4u w; w.x = sx[0]; w.y = sy[0]; w.z = sx[1]; w.w = sy[1]; *(v4u*)(op + 32 * k) = w; } }
      } }
    { constexpr int NT = (M / 16) * 8;
      for (int id = gw; id < NT; id += NGW) {
          const int pair = id & 7, blk = id >> 3; const int row0 = blk * 16;
          const int seq0 = row0 < 4096 ? 0 : (row0 < 8192 ? 4096 : 8192); const int S = row0 < 8192 ? 4096 : 16384;
          const int t0 = row0 - seq0; const int tq[2] = {t0 + i, t0 + i};
          AttState2 st;
#pragma unroll
          for (int q = 0; q < 2; ++q) { st.m[q] = -1e30f; st.l[q] = 0.f;
#pragma unroll
              for (int dt = 0; dt < 8; ++dt) st.O[q][dt] = (f32x4){0.f, 0.f, 0.f, 0.f}; }
          const bf16* seqbase = QKV + (size_t)seq0 * QKVW; const int kvh = pair >> 1;
          bf16x8 qf[2][4];
#pragma unroll
          for (int q = 0; q < 2; ++q) { const bf16* qp = seqbase + (size_t)tq[q] * QKVW + 9216 + (2 * pair + q) * 128 + 8 * g;
#pragma unroll
              for (int s = 0; s < 4; ++s) qf[q][s] = *(const bf16x8*)(qp + 32 * s); }
          attn_keys2(st, qf, seqbase + 11264 + kvh * 128, seqbase + 11776 + kvh * 128, S, tq, t0 - 128, 1, 9, 128, vl, lane, AL);
#pragma unroll
          for (int q = 0; q < 2; ++q) { const int qh = 2 * pair + q; float l = st.l[q]; l = pg8::xsum_16_32(l);
              const float sk = P.sink[qh] * 1.4426950408889634f; const float m2 = fmaxf(st.m[q], sk); const float e1 = __builtin_amdgcn_exp2f(st.m[q] - m2);
              const float den = l * e1 + __builtin_amdgcn_exp2f(sk - m2); const float rl = e1 / den;
              bf16* op = YAB + (size_t)(seq0 + tq[q]) * YABW + 1024 + qh * 128 + 8 * (g >> 1) + 16 * (g & 1);
#pragma unroll
              for (int k = 0; k < 4; ++k) { const f32x4 oa = st.O[q][2 * k] * rl, ob = st.O[q][2 * k + 1] * rl;
                  const auto sx = __builtin_amdgcn_permlane16_swap(pk2(oa[0], oa[1]), pk2(ob[0], ob[1]), false, false), sy = __builtin_amdgcn_permlane16_swap(pk2(oa[2], oa[3]), pk2(ob[2], ob[3]), false, false);
                  v4u w; w.x = sx[0]; w.y = sy[0]; w.z = sx[1]; w.w = sy[1]; *(v4u*)(op + 32 * k) = w; } }
      } }
}

__device__ __forceinline__ void final_norm(Frame& F, const Ptrs& P) {
    const int gw = F.vcu * NWAVES + F.wave, NGW = F.G * NWAVES; const float* ss3 = (const float*)(F.ctl + CW_SS3); const bf16* H3 = (const bf16*)(P.ws + WS_AB1);
    f32x4 gv[8][2];
#pragma unroll
    for (int j = 0; j < 8; ++j) { gv[j][0] = ((const f32x4*)P.gfin)[2 * (F.lane + 64 * j)]; gv[j][1] = ((const f32x4*)P.gfin)[2 * (F.lane + 64 * j) + 1]; }
    for (int m = gw; m < M; m += NGW) { const float rs = __builtin_amdgcn_rsqf(ss3[m] * (1.0f / 4096.0f) + 1e-6f);
        const GAS v4u* hi = (const GAS v4u*)(H3 + (size_t)m * D) + F.lane; GAS f32x4* o = (GAS f32x4*)(P.out + (size_t)m * D) + 2 * F.lane;
#pragma unroll
        for (int j = 0; j < 8; ++j) { const v4u w = hi[64 * j];
            const f32x4 v0 = {pg8::bf_lo(w.x), pg8::bf_hi(w.x), pg8::bf_lo(w.y), pg8::bf_hi(w.y)}, v1 = {pg8::bf_lo(w.z), pg8::bf_hi(w.z), pg8::bf_lo(w.w), pg8::bf_hi(w.w)};
            o[128 * j] = v0 * rs * gv[j][0]; o[128 * j + 1] = v1 * rs * gv[j][1]; } }
}

struct Args { const float* in[17]; float* out; unsigned char* ws; int ph_lo, ph_hi, li, pad; };
__global__ void __launch_bounds__(NWAVES * 64, 2) mk_fwd(Args args) {
    extern __shared__ __attribute__((aligned(16))) unsigned char lds[];
    Frame F;
    F.lds = (LAS unsigned char*)lds;
    F.MISC = (volatile LAS unsigned*)(F.lds + MISC_OFF);
    F.tid = threadIdx.x; F.lane = F.tid & 63; F.wave = __builtin_amdgcn_readfirstlane(F.tid >> 6);
    F.G = gridDim.x; { const int bx = blockIdx.x; F.vcu = (F.G % 8 == 0) ? (bx % 8) * (F.G / 8) + bx / 8 : bx; }
    unsigned char* ws = args.ws;
    F.ctl = (gu32*)(ws + WS_CTL);
    Ptrs P;
    P.xp = args.in[0]; P.xs = args.in[1]; P.g1 = args.in[2]; P.w1g = args.in[3]; P.w1u = args.in[4]; P.w1d = args.in[5]; P.gmix = args.in[6]; P.win = args.in[7]; P.sink = args.in[8];
    P.wa = args.in[9]; P.wb = args.in[10]; P.wout = args.in[11]; P.g2 = args.in[12]; P.w2g = args.in[13]; P.w2u = args.in[14]; P.w2d = args.in[15]; P.gfin = args.in[16];
    P.out = args.out; P.ws = ws;
    for (int u = F.tid; u < (LDS_BYTES - LDSCTL_OFF) / 4; u += NWAVES * 64) ((LAS unsigned*)(F.lds + LDSCTL_OFF))[u] = 0u;
    __syncthreads();
    XcdBarrier bar; bar.bar = (unsigned*)(F.ctl + CW_BAR); bar.x = 0; bar.st = nullptr;
    if (N_LAUNCHES != PER_PHASE) bar = xcd_barrier_post((unsigned*)(F.ctl + CW_BAR), F.MISC + 8);
#define GRID_BAR(seam) do { if (N_LAUNCHES != PER_PHASE) xcd_barrier(bar); } while (0)
    const int lo = args.ph_lo, hi = args.ph_hi;
#define IN(k) (lo <= (k) && (k) < hi)
#define BOTH(k) (IN(k) && IN((k) + 1))
    bf16* AB1 = (bf16*)(ws + WS_AB1); bf16* ACT = (bf16*)(ws + WS_ACT); bf16* QKVB = (bf16*)(ws + WS_QKV);
    bf16* WGU = (bf16*)(ws + WS_WGU); bf16* WDN = (bf16*)(ws + WS_WD); bf16* WIN = (bf16*)(ws + WS_WIN); bf16* WAB = (bf16*)(ws + WS_WAB); bf16* WOUT = (bf16*)(ws + WS_WOUT);
    float* ss0 = (float*)(ws + WS_SS0); float* ss1 = (float*)(F.ctl + CW_SS1); float* ss2 = (float*)(F.ctl + CW_SS2); float* ss3 = (float*)(F.ctl + CW_SS3);
    const float* rope = (const float*)(ws + WS_ROPE);

    if (IN(0)) { for (int rep = 0; rep < NREP(0); ++rep) p0_prologue(F, P); if (BOTH(0)) GRID_BAR(0); }
    if (IN(1)) { pg8::Gemm g{AB1, WGU, M, 2 * FF, D}; pg8::StaticOrder S; S.init(M, 2 * FF, F.G, (int)blockIdx.x, WGM_UP);
        pg8::EpiSwiglu E{ACT, FF, ss0, F.lds + SSL_OFF};
        for (int rep = 0; rep < NREP(1); ++rep)
        pg8::gemm_phase<pg8::EpiSwiglu, pg8::StaticOrder, PG8_ALIGN, PG8_SP2>(F.lds + RING_OFF, g, S, E);
        {
          const int nwg = (M / 256) * (2 * FF / 256), rem = nwg % F.G, c = (int)blockIdx.x;
          if (rem == 0) cvt_run<2>(F, P, c * NWAVES + F.wave, F.G * NWAVES);
          else if (c >= rem) cvt_run<2>(F, P, (c - rem) * NWAVES + F.wave, (F.G - rem) * NWAVES); }
        if (PROBE_REPEAT == 21) { pg8::FixedOrder S2; S2.init(M, 2 * FF, F.G, (int)blockIdx.x); pg8::EpiSwiglu E2{QKVB, FF, ss0, F.lds + SSL_OFF};
            pg8::gemm_phase<pg8::EpiSwiglu, pg8::FixedOrder, PG8_ALIGN, PG8_SP2>(F.lds + RING_OFF, g, S2, E2); }
        if (BOTH(1)) GRID_BAR(1); }
    if (IN(2) && PROBE_REPEAT >= 100 && PROBE_REPEAT < 104) {
        pg8::Gemm g{AB1, WGU, M, 2 * FF, D}; pg8::StaticOrder S; S.init(M, 2 * FF, F.G, (int)blockIdx.x, WGM_UP);
        pg8::EpiSwigluT<(PROBE_REPEAT >= 100 ? PROBE_REPEAT - 100 : 0)> E{QKVB, FF, ss0, F.lds + SSL_OFF};
        pg8::gemm_phase<pg8::EpiSwigluT<(PROBE_REPEAT >= 100 ? PROBE_REPEAT - 100 : 0)>, pg8::StaticOrder, PG8_ALIGN, PG8_SP2>(F.lds + RING_OFF, g, S, E);
        GRID_BAR(1); }
    if (IN(2)) { if (STAGGER_TICKS) xcd_stagger(STAGGER_TICKS); pg8::Gemm g{ACT, WDN, M, D, FF}; pg8::StaticOrder S; S.init(M, D, F.G, (int)blockIdx.x, WGM_DOWN);
        pg8::EpiResid<true, false, true, true> E{AB1, AB1, M, nullptr, AB1, ss1, 0.5f};
        pg8::gemm_phase<pg8::EpiResid<true, false, true, true>, pg8::StaticOrder, PG8_ALIGN, PG8_SP2>(F.lds + RING_OFF, g, S, E);
        if (BOTH(2)) GRID_BAR(2); }
    if (IN(3)) { pg8::Gemm g{AB1, WIN, M, NIN, D}; pg8::StaticOrder S; S.init(M, NIN, F.G, (int)blockIdx.x, WGM_IN);
        pg8::EpiProj E{QKVB, ACT, ss1, rope, F.lds + SSL_OFF};
        pg8::gemm_phase<pg8::EpiProj, pg8::StaticOrder, PG8_ALIGN, PG8_SP2>(F.lds + RING_OFF, g, S, E);
        if (NREP(3) == 2) pg8::gemm_phase<pg8::EpiProj, pg8::StaticOrder, PG8_ALIGN, PG8_SP2>(F.lds + RING_OFF, g, S, E);
        if (BOTH(3)) GRID_BAR(3); }
    if (IN(4)) { for (int rep = 0; rep < NREP(4); ++rep) attn_phase<(PROBE_REPEAT == 42) ? 1 : 0>(F, P); for (int rep = 0; rep < NREP(14); ++rep) p4_convert_w2(F, P); if (BOTH(4)) GRID_BAR(4); }
    if (IN(5)) { pg8::Gemm g{(const bf16*)P.out, WAB, M, D, YABW}; pg8::StaticOrder S; S.init(M, D, F.G, (int)blockIdx.x, WGM_DOWN);
        pg8::EpiMerge E{ACT, QKVB};
        for (int rep = 0; rep < NREP(5); ++rep)
        pg8::gemm_phase<pg8::EpiMerge, pg8::StaticOrder, PG8_ALIGN, PG8_SP2>(F.lds + RING_OFF, g, S, E);
        if (BOTH(5)) GRID_BAR(5); }
    if (IN(6)) { if (STAGGER_TICKS) xcd_stagger(STAGGER_TICKS); pg8::Gemm g{QKVB, WOUT, M, D, D}; pg8::StaticOrder S; S.init(M, D, F.G, (int)blockIdx.x, WGM_DOWN);
        pg8::EpiResid<true, false, true, true> E{AB1, AB1, M, nullptr, AB1, ss2, 1.0f};
        pg8::gemm_phase<pg8::EpiResid<true, false, true, true>, pg8::StaticOrder, PG8_ALIGN, PG8_SP2>(F.lds + RING_OFF, g, S, E);
        if (BOTH(6)) GRID_BAR(6); }
    if (IN(7)) { pg8::Gemm g{AB1, WGU, M, 2 * FF, D}; pg8::StaticOrder S; S.init(M, 2 * FF, F.G, (int)blockIdx.x, WGM_UP);
        pg8::EpiSwiglu E{ACT, FF, ss2, F.lds + SSL_OFF};
        pg8::gemm_phase<pg8::EpiSwiglu, pg8::StaticOrder, PG8_ALIGN, PG8_SP2>(F.lds + RING_OFF, g, S, E);
        {
          const int nwg = (M / 256) * (2 * FF / 256), rem = nwg % F.G, c = (int)blockIdx.x;
          if (rem == 0) cvt_run<3>(F, P, c * NWAVES + F.wave, F.G * NWAVES);
          else if (c >= rem) cvt_run<3>(F, P, (c - rem) * NWAVES + F.wave, (F.G - rem) * NWAVES); }
        if (BOTH(7)) GRID_BAR(7); }
    if (IN(8)) { if (STAGGER_TICKS) xcd_stagger(STAGGER_TICKS); pg8::Gemm g{ACT, WDN, M, D, FF}; pg8::StaticOrder S; S.init(M, D, F.G, (int)blockIdx.x, WGM_DOWN);
        pg8::EpiResid<true, false, true, true> E{AB1, AB1, M, nullptr, AB1, ss3, 0.5f};
        pg8::gemm_phase<pg8::EpiResid<true, false, true, true>, pg8::StaticOrder, PG8_ALIGN, PG8_SP2>(F.lds + RING_OFF, g, S, E);
        if (BOTH(8)) GRID_BAR(8); }
    if (IN(9)) { final_norm(F, P); }
#undef IN
#undef BOTH
#undef GRID_BAR
}

extern "C" void kernel_launch(void* const* d_in, const int* in_sizes, int n_in, void* d_out, int out_size, void* d_ws, size_t ws_size, hipStream_t stream) {
    static int grid = 0;
    if (grid == 0) {
        if (n_in != 17 || out_size != M * D || ws_size < WS_END) { fprintf(stderr, "kernel_launch: unexpected shapes (n_in %d, out %d, ws %zu, need %zu)\n", n_in, out_size, ws_size, (size_t)WS_END); grid = -1; return; }
        int dev = 0, cus = 0, per_cu = 0;
        if (hipGetDevice(&dev) != hipSuccess || hipDeviceGetAttribute(&cus, hipDeviceAttributeMultiprocessorCount, dev) != hipSuccess) { grid = -1; return; }
        if (hipFuncSetAttribute((const void*)mk_fwd, hipFuncAttributeMaxDynamicSharedMemorySize, LDS_BYTES) != hipSuccess) { fprintf(stderr, "kernel_launch: hipFuncSetAttribute failed\n"); grid = -1; return; }
        if (hipOccupancyMaxActiveBlocksPerMultiprocessor(&per_cu, (const void*)mk_fwd, NWAVES * 64, LDS_BYTES) != hipSuccess || per_cu < 1) { fprintf(stderr, "kernel_launch: occupancy query says %d\n", per_cu); }
        (void)hipGetLastError();
        grid = cus;
    }
    if (grid < 0) return;
    (void)hipMemsetAsync((char*)d_ws + WS_CTL, 0, CTL_ZERO_BYTES, stream);
    Args a{};
    for (int i = 0; i < 17; ++i) a.in[i] = (const float*)d_in[i];
    a.out = (float*)d_out; a.ws = (unsigned char*)d_ws; a.pad = 0;
    for (int li = 0; li < N_LAUNCHES; ++li) {
        a.ph_lo = (N_LAUNCHES == PER_PHASE) ? li : 0; a.ph_hi = (N_LAUNCHES == PER_PHASE) ? li + 1 : PER_PHASE; a.li = li;
        hipLaunchKernelGGL(mk_fwd, dim3(grid), dim3(NWAVES * 64), LDS_BYTES, stream, a);
    }
}
```
